# Optimizing an MI355X kernel written in HIP

```python
import jax, jax.numpy as jnp
from jax import lax
import numpy as np

D_MODEL = 1024
BATCH = 8
SEQ = 2048
DEPTH = 2

MEM_LEN = 256
POOL_GROUPS = 4
POOL_GROUP_DIM = D_MODEL // 16
POOL_WIDTH = POOL_GROUPS * POOL_GROUP_DIM
POOL_WINDOWS = (2, 4, 8, 16)
FOX_HEADS = 8
FOX_HEAD_DIM = 64
FOX_WIDTH = FOX_HEADS * FOX_HEAD_DIM
Q_BLOCK = 128
SGU_GROUPS = 4
SGU_GROUP_DIM = D_MODEL // 16
SGU_WIDTH = SGU_GROUPS * SGU_GROUP_DIM
SGU_CHUNK = 128
N_BRANCH = 3
OFF_A = 0
OFF_Q = OFF_A + POOL_WIDTH
OFF_K = OFF_Q + FOX_WIDTH
OFF_V = OFF_K + FOX_WIDTH
OFF_F = OFF_V + FOX_WIDTH
OFF_C = OFF_F + FOX_HEADS
OFF_G = OFF_C + 2 * SGU_WIDTH
N_IN = OFF_G + N_BRANCH * D_MODEL
XATTN_HEADS = 4
XATTN_HEAD_DIM = D_MODEL // XATTN_HEADS
D_FF = 4 * D_MODEL
EPS = 1e-6
NEG = -1e30

kernel_name = "hybrid_pool_fox_sgu_gated_block"


def rmsnorm(x, g):
    xf = x.astype(jnp.float32)
    y = xf * lax.rsqrt(jnp.mean(xf * xf, axis=-1, keepdims=True) + EPS)
    return (y * g.astype(jnp.float32)).astype(x.dtype)


def pool_mixer(a, w, scale):
    B, S, _ = a.shape
    af = a.astype(jnp.float32)
    c = jnp.pad(jnp.cumsum(af, axis=1), ((0, 0), (1, 0), (0, 0)))
    t = jnp.arange(S)
    outs = []
    for gi, win in enumerate(POOL_WINDOWS):
        sl = slice(gi * POOL_GROUP_DIM, (gi + 1) * POOL_GROUP_DIM)
        cg = c[..., sl]
        lo = jnp.take(cg, jnp.maximum(t + 1 - win, 0), axis=1)
        cnt = jnp.minimum(t + 1, win).astype(jnp.float32)[None, :, None]
        outs.append((cg[:, 1:] - lo) / cnt - af[..., sl])
    d = jnp.stack(outs, axis=2).astype(a.dtype)
    y = jnp.einsum('bsgc,gcd->bsgd', d, w).reshape(B, S, POOL_WIDTH)
    return y * scale


def forgetting_attention(q, k, v, logf):
    S = q.shape[1]
    F = jnp.cumsum(logf, axis=1).transpose(0, 2, 1)
    scale = FOX_HEAD_DIM ** -0.5
    outs = []
    for i in range(S // Q_BLOCK):
        q0 = i * Q_BLOCK
        kend = q0 + Q_BLOCK
        s = jnp.einsum('bqhd,bkhd->bhqk', q[:, q0:kend], k[:, :kend]).astype(jnp.float32) * scale
        s = s + F[:, :, q0:kend, None] - F[:, :, None, :kend]
        mask = (q0 + jnp.arange(Q_BLOCK))[:, None] >= jnp.arange(kend)[None, :]
        s = jnp.where(mask, s, NEG)
        p = jax.nn.softmax(s, axis=-1).astype(v.dtype)
        outs.append(jnp.einsum('bhqk,bkhd->bqhd', p, v[:, :kend]))
    return jnp.concatenate(outs, axis=1)


def spatial_gating(z, norm_g, ws, b):
    B, S, _ = z.shape
    u, v = z[..., :SGU_WIDTH], z[..., SGU_WIDTH:]
    v = rmsnorm(v, norm_g)
    vc = v.reshape(B, S // SGU_CHUNK, SGU_CHUNK, SGU_GROUPS, SGU_GROUP_DIM)
    causal = jnp.tril(jnp.ones((SGU_CHUNK, SGU_CHUNK), dtype=ws.dtype))
    w = ws * causal[None]
    mixed = jnp.einsum('gts,bcsgd->bctgd', w, vc) + b.T[None, None, :, :, None]
    return u * mixed.reshape(B, S, SGU_WIDTH)


def setup_inputs(seed: int = 0) -> dict:
    key = jax.random.key(seed)
    ks = jax.random.split(key, 24)
    L, D = DEPTH, D_MODEL
    nrm = lambda k, shape, fan_in: jax.random.normal(k, shape, jnp.float32) * (fan_in ** -0.5)
    gain = lambda k, shape: 1.0 + 0.05 * jax.random.normal(k, shape, jnp.float32)
    b_forget = jnp.linspace(1.0, 6.0, FOX_HEADS, dtype=jnp.float32)[None, :] + 0.1 * jax.random.normal(ks[3], (L, FOX_HEADS), jnp.float32)
    return {
        "x": jax.random.normal(ks[0], (BATCH, SEQ, D), jnp.float32),
        "mem": jax.random.normal(ks[1], (BATCH, MEM_LEN, D), jnp.float32),
        "norm_mix_g": gain(ks[2], (L, D)),
        "w_in": nrm(ks[4], (L, D, N_IN), D),
        "b_forget": b_forget,
        "pool_w": nrm(ks[5], (L, POOL_GROUPS, POOL_GROUP_DIM, POOL_GROUP_DIM), POOL_GROUP_DIM),
        "pool_scale": gain(ks[6], (L, POOL_WIDTH)),
        "sgu_norm_g": gain(ks[7], (L, SGU_WIDTH)),
        "sgu_w": nrm(ks[8], (L, SGU_GROUPS, SGU_CHUNK, SGU_CHUNK), SGU_CHUNK),
        "sgu_b": gain(ks[9], (L, SGU_GROUPS, SGU_CHUNK)),
        "w_branch_a": nrm(ks[10], (L, POOL_WIDTH, D), POOL_WIDTH),
        "w_branch_b": nrm(ks[11], (L, FOX_WIDTH, D), FOX_WIDTH),
        "w_branch_c": nrm(ks[12], (L, SGU_WIDTH, D), SGU_WIDTH),
        "b_gate": 0.01 * jax.random.normal(ks[13], (L, N_BRANCH * D), jnp.float32),
        "w_out": nrm(ks[14], (L, D, D), D),
        "norm_xattn_g": gain(ks[15], (L, D)),
        "norm_mem_g": gain(ks[16], (L, D)),
        "w_xq": nrm(ks[17], (L, D, D), D),
        "w_xkv": nrm(ks[18], (L, D, 2 * D), D),
        "w_xo": nrm(ks[19], (L, D, D), D),
        "norm_ffn_g": gain(ks[20], (L, D)),
        "w_ff1": nrm(ks[21], (L, D, D_FF), D),
        "w_ff2": nrm(ks[22], (L, D_FF, D), D_FF),
        "final_norm_g": gain(ks[23], (D,)),
    }


def reference(x, mem, norm_mix_g, w_in, b_forget, pool_w, pool_scale, sgu_norm_g, sgu_w, sgu_b,
              w_branch_a, w_branch_b, w_branch_c, b_gate, w_out, norm_xattn_g, norm_mem_g,
              w_xq, w_xkv, w_xo, norm_ffn_g, w_ff1, w_ff2, final_norm_g):
    B, S, D = x.shape
    M = mem.shape[1]
    for l in range(DEPTH):
        h = rmsnorm(x, norm_mix_g[l])
        proj = h @ w_in[l]
        a = proj[..., OFF_A:OFF_Q]
        q = proj[..., OFF_Q:OFF_K].reshape(B, S, FOX_HEADS, FOX_HEAD_DIM)
        k = proj[..., OFF_K:OFF_V].reshape(B, S, FOX_HEADS, FOX_HEAD_DIM)
        v = proj[..., OFF_V:OFF_F].reshape(B, S, FOX_HEADS, FOX_HEAD_DIM)
        logf = jax.nn.log_sigmoid(proj[..., OFF_F:OFF_C].astype(jnp.float32) + b_forget[l].astype(jnp.float32))
        zc = jax.nn.gelu(proj[..., OFF_C:OFF_G])
        gates = jax.nn.sigmoid(proj[..., OFF_G:] + b_gate[l])

        y_a = pool_mixer(a, pool_w[l], pool_scale[l]) @ w_branch_a[l]
        y_b = forgetting_attention(q, k, v, logf).reshape(B, S, FOX_WIDTH) @ w_branch_b[l]
        y_c = spatial_gating(zc, sgu_norm_g[l], sgu_w[l], sgu_b[l]) @ w_branch_c[l]
        merged = gates[..., :D] * y_a + gates[..., D:2 * D] * y_b + gates[..., 2 * D:] * y_c
        x = x + merged @ w_out[l]

        hx = rmsnorm(x, norm_xattn_g[l])
        hm = rmsnorm(mem, norm_mem_g[l])
        xq = (hx @ w_xq[l]).reshape(B, S, XATTN_HEADS, XATTN_HEAD_DIM)
        kv = hm @ w_xkv[l]
        xk = kv[..., :D].reshape(B, M, XATTN_HEADS, XATTN_HEAD_DIM)
        xv = kv[..., D:].reshape(B, M, XATTN_HEADS, XATTN_HEAD_DIM)
        s = jnp.einsum('bqhd,bkhd->bhqk', xq, xk).astype(jnp.float32) * (XATTN_HEAD_DIM ** -0.5)
        p = jax.nn.softmax(s, axis=-1).astype(xv.dtype)
        o = jnp.einsum('bhqk,bkhd->bqhd', p, xv).reshape(B, S, D)
        x = x + o @ w_xo[l]

        hf = rmsnorm(x, norm_ffn_g[l])
        x = x + jnp.square(jax.nn.relu(hf @ w_ff1[l])) @ w_ff2[l]
    return rmsnorm(x, final_norm_g)
```

```cpp
#include <hip/hip_runtime.h>
#include <cstdio>
#include <cstdint>
#include <cmath>

namespace {
constexpr int D_MODEL = 1024, BATCH = 8, SEQ = 2048, DEPTH = 2, MEM_LEN = 256;
constexpr int POOL_W = 256, FOX_H = 8, FOX_D = 64, FOX_W = 512, SGU_W = 256, SGU_CHUNK = 128;
constexpr int OFF_A = 0, OFF_Q = 256, OFF_K = 768, OFF_V = 1280, OFF_F = 1792, OFF_C = 1800, OFF_G = 2312, N_IN = 5384;
constexpr int XH = 4, XD = 256, D_FF = 4096;
constexpr float EPS = 1e-6f;

template <int MODE>
__global__ void __launch_bounds__(256) gemm_naive(const float* __restrict__ A, int lda, const float* __restrict__ B, int ldb, float* C, int ldc, int M, int N, int K) {
    __shared__ __attribute__((aligned(16))) float As[16][68];
    __shared__ __attribute__((aligned(16))) float Bs[16][68];
    const int tx = threadIdx.x & 15, ty = threadIdx.x >> 4;
    const int m0 = blockIdx.y * 64, n0 = blockIdx.x * 64;
    float acc[4][4] = {};
    for (int k0 = 0; k0 < K; k0 += 16) {
        for (int i = threadIdx.x; i < 64 * 16; i += 256) {
            const int r = i >> 4, c = i & 15;
            As[c][r] = A[(size_t)(m0 + r) * lda + k0 + c];
        }
        for (int i = threadIdx.x; i < 16 * 64; i += 256) {
            const int r = i >> 6, c = i & 63;
            Bs[r][c] = (n0 + c < N) ? B[(size_t)(k0 + r) * ldb + n0 + c] : 0.f;
        }
        __syncthreads();
#pragma unroll
        for (int kk = 0; kk < 16; ++kk) {
            const float4 a4 = *(const float4*)&As[kk][ty * 4], b4 = *(const float4*)&Bs[kk][tx * 4];
            const float a[4] = {a4.x, a4.y, a4.z, a4.w}, b[4] = {b4.x, b4.y, b4.z, b4.w};
#pragma unroll
            for (int i = 0; i < 4; ++i)
#pragma unroll
                for (int j = 0; j < 4; ++j) acc[i][j] += a[i] * b[j];
        }
        __syncthreads();
    }
#pragma unroll
    for (int i = 0; i < 4; ++i)
#pragma unroll
        for (int j = 0; j < 4; ++j) {
            const int r = m0 + ty * 4 + i, c = n0 + tx * 4 + j;
            if (c < N) {
                float* p = C + (size_t)r * ldc + c;
                float v = acc[i][j];
                if (MODE == 1) v += *p;
                if (MODE == 2) { v = v > 0.f ? v : 0.f; v = v * v; }
                *p = v;
            }
        }
}

template <int ACCUM>
__global__ void __launch_bounds__(256) gemm_gated(const float* __restrict__ A1, int lda1, const float* __restrict__ B1, int ldb1, int K1, const float* __restrict__ bias,
                                                   const float* __restrict__ A2, int lda2, const float* __restrict__ B2, int ldb2, int K2, float* C, int ldc) {
    __shared__ __attribute__((aligned(16))) float As[16][68];
    __shared__ __attribute__((aligned(16))) float Bs[16][68];
    const int tx = threadIdx.x & 15, ty = threadIdx.x >> 4;
    const int m0 = blockIdx.y * 64, n0 = blockIdx.x * 64;
    float accg[4][4] = {}, accy[4][4] = {};
    for (int pass = 0; pass < 2; ++pass) {
        const float* A = pass ? A2 : A1; const float* B = pass ? B2 : B1; const int lda = pass ? lda2 : lda1, ldb = pass ? ldb2 : ldb1, K = pass ? K2 : K1;
        for (int k0 = 0; k0 < K; k0 += 16) {
            for (int i = threadIdx.x; i < 64 * 16; i += 256) { const int r = i >> 4, c = i & 15; As[c][r] = A[(size_t)(m0 + r) * lda + k0 + c]; }
            for (int i = threadIdx.x; i < 16 * 64; i += 256) { const int r = i >> 6, c = i & 63; Bs[r][c] = B[(size_t)(k0 + r) * ldb + n0 + c]; }
            __syncthreads();
#pragma unroll
            for (int kk = 0; kk < 16; ++kk) {
                const float4 a4 = *(const float4*)&As[kk][ty * 4], b4 = *(const float4*)&Bs[kk][tx * 4];
                const float a[4] = {a4.x, a4.y, a4.z, a4.w}, b[4] = {b4.x, b4.y, b4.z, b4.w};
                if (pass == 0) {
#pragma unroll
                    for (int i = 0; i < 4; ++i)
#pragma unroll
                        for (int j = 0; j < 4; ++j) accg[i][j] += a[i] * b[j];
                } else {
#pragma unroll
                    for (int i = 0; i < 4; ++i)
#pragma unroll
                        for (int j = 0; j < 4; ++j) accy[i][j] += a[i] * b[j];
                }
            }
            __syncthreads();
        }
    }
#pragma unroll
    for (int i = 0; i < 4; ++i)
#pragma unroll
        for (int j = 0; j < 4; ++j) {
            const int r = m0 + ty * 4 + i, c = n0 + tx * 4 + j;
            const float g = 1.f / (1.f + expf(-(accg[i][j] + bias[c])));
            float* p = C + (size_t)r * ldc + c;
            float v = g * accy[i][j];
            if (ACCUM) v += *p;
            *p = v;
        }
}

__global__ void __launch_bounds__(256) rmsnorm_rows(const float* __restrict__ x, int ldx, const float* __restrict__ g, float* out, int ldo, int rows, int n) {
    const int row = blockIdx.x * 4 + (threadIdx.x >> 6), lane = threadIdx.x & 63;
    if (row >= rows) return;
    const float* xr = x + (size_t)row * ldx;
    float s = 0.f;
    for (int c = lane; c < n; c += 64) { const float v = xr[c]; s += v * v; }
#pragma unroll
    for (int o = 1; o < 64; o <<= 1) s += __shfl_xor(s, o);
    const float r = rsqrtf(s / (float)n + EPS);
    float* orow = out + (size_t)row * ldo;
    for (int c = lane; c < n; c += 64) orow[c] = xr[c] * r * g[c];
}

__global__ void forget_cumsum(const float* __restrict__ P, int ldp, const float* __restrict__ bf, float* F) {
    const int h = threadIdx.x;
    if (h >= FOX_H) return;
    float acc = 0.f;
    for (int t = 0; t < SEQ; ++t) {
        const float z = P[(size_t)t * ldp + OFF_F + h] + bf[h];
        const float ls = fminf(z, 0.f) - log1pf(expf(-fabsf(z)));
        acc += ls;
        F[h * SEQ + t] = acc;
    }
}

__global__ void pool_diff(const float* __restrict__ P, int ldp, float* d) {
    const int idx = blockIdx.x * blockDim.x + threadIdx.x;
    if (idx >= SEQ * POOL_W) return;
    const int t = idx / POOL_W, c = idx % POOL_W, g = c / 64;
    const int win = 2 << g;
    const int lo = (t + 1 - win) > 0 ? (t + 1 - win) : 0;
    float s = 0.f;
    for (int j = lo; j <= t; ++j) s += P[(size_t)j * ldp + OFF_A + c];
    d[idx] = s / (float)(t + 1 - lo) - P[(size_t)t * ldp + OFF_A + c];
}
__global__ void pool_mix(const float* __restrict__ d, const float* __restrict__ w, const float* __restrict__ scale, float* pm) {
    const int idx = blockIdx.x * blockDim.x + threadIdx.x;
    if (idx >= SEQ * POOL_W) return;
    const int t = idx / POOL_W, c = idx % POOL_W, g = c / 64, dd = c % 64;
    float s = 0.f;
    for (int k = 0; k < 64; ++k) s += d[t * POOL_W + g * 64 + k] * w[(g * 64 + k) * 64 + dd];
    pm[idx] = s * scale[c];
}

__global__ void __launch_bounds__(64) fox_attn(const float* __restrict__ P, int ldp, const float* __restrict__ F, float* O) {
    const int idx = blockIdx.x * blockDim.x + threadIdx.x;
    if (idx >= SEQ * FOX_H) return;
    const int h = idx / SEQ, t = idx % SEQ;
    float q[64], o[64];
    const float* qp = P + (size_t)t * ldp + OFF_Q + h * 64;
#pragma unroll
    for (int i = 0; i < 64; ++i) { q[i] = qp[i] * 0.125f; o[i] = 0.f; }
    const float Ft = F[h * SEQ + t];
    float m = -1e30f, l = 0.f;
    for (int s = 0; s <= t; ++s) {
        const float* kp = P + (size_t)s * ldp + OFF_K + h * 64;
        float sc = 0.f;
#pragma unroll
        for (int i = 0; i < 64; ++i) sc += q[i] * kp[i];
        sc += Ft - F[h * SEQ + s];
        const float mn = fmaxf(m, sc);
        const float al = expf(m - mn), p = expf(sc - mn);
        l = l * al + p;
        const float* vp = P + (size_t)s * ldp + OFF_V + h * 64;
#pragma unroll
        for (int i = 0; i < 64; ++i) o[i] = o[i] * al + p * vp[i];
        m = mn;
    }
    float* op = O + (size_t)t * FOX_W + h * 64;
    const float il = 1.f / l;
#pragma unroll
    for (int i = 0; i < 64; ++i) op[i] = o[i] * il;
}

__device__ __forceinline__ float gelu_tanh(float x) { const float u = 0.7978845608028654f * (x + 0.044715f * x * x * x); return 0.5f * x * (1.f + tanhf(u)); }

__global__ void __launch_bounds__(256) sgu_prep(const float* __restrict__ P, int ldp, const float* __restrict__ g, float* U, float* VN) {
    const int row = blockIdx.x * 4 + (threadIdx.x >> 6), lane = threadIdx.x & 63;
    if (row >= SEQ) return;
    const float* pr = P + (size_t)row * ldp + OFF_C;
    float v[4]; float s = 0.f;
#pragma unroll
    for (int j = 0; j < 4; ++j) { U[row * SGU_W + lane + 64 * j] = gelu_tanh(pr[lane + 64 * j]); v[j] = gelu_tanh(pr[256 + lane + 64 * j]); s += v[j] * v[j]; }
#pragma unroll
    for (int o = 1; o < 64; o <<= 1) s += __shfl_xor(s, o);
    const float r = rsqrtf(s / 256.f + EPS);
#pragma unroll
    for (int j = 0; j < 4; ++j) VN[row * SGU_W + lane + 64 * j] = v[j] * r * g[lane + 64 * j];
}
__global__ void sgu_mix(const float* __restrict__ U, const float* __restrict__ VN, const float* __restrict__ ws, const float* __restrict__ b, float* SG) {
    const int idx = blockIdx.x * blockDim.x + threadIdx.x;
    if (idx >= SEQ * SGU_W) return;
    const int t = idx / SGU_W, c = idx % SGU_W, g = c / 64, tt = t % SGU_CHUNK, c0 = t - tt;
    float s = 0.f;
    for (int j = 0; j <= tt; ++j) s += ws[(g * SGU_CHUNK + tt) * SGU_CHUNK + j] * VN[(c0 + j) * SGU_W + c];
    SG[idx] = U[idx] * (s + b[g * SGU_CHUNK + tt]);
}

__global__ void __launch_bounds__(256) xattn(const float* __restrict__ Q, const float* __restrict__ KV, float* O) {
    __shared__ float qs[XD];
    __shared__ float ps[MEM_LEN];
    __shared__ float red[8];
    const int t = blockIdx.x % SEQ, h = blockIdx.x / SEQ, j = threadIdx.x;
    qs[j] = Q[(size_t)t * D_MODEL + h * XD + j];
    __syncthreads();
    const float* kp = KV + (size_t)j * 2 * D_MODEL + h * XD;
    float s = 0.f;
    for (int i = 0; i < XD; ++i) s += qs[i] * kp[i];
    s *= 0.0625f;
    float m = s;
#pragma unroll
    for (int o = 1; o < 64; o <<= 1) m = fmaxf(m, __shfl_xor(m, o));
    if ((j & 63) == 0) red[j >> 6] = m;
    __syncthreads();
    m = fmaxf(fmaxf(red[0], red[1]), fmaxf(red[2], red[3]));
    const float p = expf(s - m);
    ps[j] = p;
    float l = p;
#pragma unroll
    for (int o = 1; o < 64; o <<= 1) l += __shfl_xor(l, o);
    if ((j & 63) == 0) red[4 + (j >> 6)] = l;
    __syncthreads();
    l = (red[4] + red[5]) + (red[6] + red[7]);
    float a = 0.f;
    for (int k = 0; k < MEM_LEN; ++k) a += ps[k] * KV[(size_t)k * 2 * D_MODEL + D_MODEL + h * XD + j];
    O[(size_t)t * D_MODEL + h * XD + j] = a / l;
}
}

extern "C" void kernel_launch(void* const* d_in, const int* in_sizes, int n_in, void* d_out, int out_size, void* d_ws, size_t ws_size, hipStream_t stream) {
    const float* x_in = (const float*)d_in[0]; const float* mem = (const float*)d_in[1];
    const float* norm_mix_g = (const float*)d_in[2]; const float* w_in = (const float*)d_in[3]; const float* b_forget = (const float*)d_in[4];
    const float* pool_w = (const float*)d_in[5]; const float* pool_scale = (const float*)d_in[6]; const float* sgu_norm_g = (const float*)d_in[7];
    const float* sgu_w = (const float*)d_in[8]; const float* sgu_b = (const float*)d_in[9];
    const float* w_br_a = (const float*)d_in[10]; const float* w_br_b = (const float*)d_in[11]; const float* w_br_c = (const float*)d_in[12];
    const float* b_gate = (const float*)d_in[13]; const float* w_out = (const float*)d_in[14];
    const float* norm_xattn_g = (const float*)d_in[15]; const float* norm_mem_g = (const float*)d_in[16];
    const float* w_xq = (const float*)d_in[17]; const float* w_xkv = (const float*)d_in[18]; const float* w_xo = (const float*)d_in[19];
    const float* norm_ffn_g = (const float*)d_in[20]; const float* w_ff1 = (const float*)d_in[21]; const float* w_ff2 = (const float*)d_in[22];
    const float* final_norm_g = (const float*)d_in[23];
    float* X = (float*)d_out;
    (void)hipMemcpyAsync(X, x_in, (size_t)BATCH * SEQ * D_MODEL * 4, hipMemcpyDeviceToDevice, stream);
    float* ws = (float*)d_ws; size_t off = 0;
    auto take = [&](size_t n) { float* p = ws + off; off += (n + 63) & ~(size_t)63; return p; };
    float* H = take((size_t)SEQ * D_MODEL);
    float* P = take((size_t)SEQ * OFF_G);
    float* F = take((size_t)FOX_H * SEQ);
    float* Dd = take((size_t)SEQ * POOL_W);
    float* PM = take((size_t)SEQ * POOL_W);
    float* AB = take((size_t)SEQ * FOX_W);
    float* U = take((size_t)SEQ * SGU_W);
    float* VN = take((size_t)SEQ * SGU_W);
    float* SG = take((size_t)SEQ * SGU_W);
    float* MG = take((size_t)SEQ * D_MODEL);
    float* HM = take((size_t)MEM_LEN * D_MODEL);
    float* KV = take((size_t)MEM_LEN * 2 * D_MODEL);
    float* XQ = take((size_t)SEQ * D_MODEL);
    float* XO = take((size_t)SEQ * D_MODEL);
    float* FFH = take((size_t)SEQ * D_FF);
    (void)ws_size; (void)n_in; (void)in_sizes; (void)out_size;
    for (int l = 0; l < DEPTH; ++l) {
        const float* Win = w_in + (size_t)l * D_MODEL * N_IN;
        for (int b = 0; b < BATCH; ++b) {
            float* Xb = X + (size_t)b * SEQ * D_MODEL;
            rmsnorm_rows<<<SEQ / 4, 256, 0, stream>>>(Xb, D_MODEL, norm_mix_g + l * D_MODEL, H, D_MODEL, SEQ, D_MODEL);
            gemm_naive<0><<<dim3((OFF_G + 63) / 64, SEQ / 64), 256, 0, stream>>>(H, D_MODEL, Win, N_IN, P, OFF_G, SEQ, OFF_G, D_MODEL);
            forget_cumsum<<<1, 64, 0, stream>>>(P, OFF_G, b_forget + l * FOX_H, F);
            pool_diff<<<SEQ * POOL_W / 256, 256, 0, stream>>>(P, OFF_G, Dd);
            pool_mix<<<SEQ * POOL_W / 256, 256, 0, stream>>>(Dd, pool_w + (size_t)l * 4 * 64 * 64, pool_scale + l * POOL_W, PM);
            fox_attn<<<SEQ * FOX_H / 64, 64, 0, stream>>>(P, OFF_G, F, AB);
            sgu_prep<<<SEQ / 4, 256, 0, stream>>>(P, OFF_G, sgu_norm_g + l * SGU_W, U, VN);
            sgu_mix<<<SEQ * SGU_W / 256, 256, 0, stream>>>(U, VN, sgu_w + (size_t)l * 4 * 128 * 128, sgu_b + l * 4 * 128, SG);
            const float* bg = b_gate + (size_t)l * 3 * D_MODEL;
            gemm_gated<0><<<dim3(D_MODEL / 64, SEQ / 64), 256, 0, stream>>>(H, D_MODEL, Win + OFF_G, N_IN, D_MODEL, bg, PM, POOL_W, w_br_a + (size_t)l * POOL_W * D_MODEL, D_MODEL, POOL_W, MG, D_MODEL);
            gemm_gated<1><<<dim3(D_MODEL / 64, SEQ / 64), 256, 0, stream>>>(H, D_MODEL, Win + OFF_G + D_MODEL, N_IN, D_MODEL, bg + D_MODEL, AB, FOX_W, w_br_b + (size_t)l * FOX_W * D_MODEL, D_MODEL, FOX_W, MG, D_MODEL);
            gemm_gated<1><<<dim3(D_MODEL / 64, SEQ / 64), 256, 0, stream>>>(H, D_MODEL, Win + OFF_G + 2 * D_MODEL, N_IN, D_MODEL, bg + 2 * D_MODEL, SG, SGU_W, w_br_c + (size_t)l * SGU_W * D_MODEL, D_MODEL, SGU_W, MG, D_MODEL);
            gemm_naive<1><<<dim3(D_MODEL / 64, SEQ / 64), 256, 0, stream>>>(MG, D_MODEL, w_out + (size_t)l * D_MODEL * D_MODEL, D_MODEL, Xb, D_MODEL, SEQ, D_MODEL, D_MODEL);
            rmsnorm_rows<<<SEQ / 4, 256, 0, stream>>>(Xb, D_MODEL, norm_xattn_g + l * D_MODEL, H, D_MODEL, SEQ, D_MODEL);
            rmsnorm_rows<<<MEM_LEN / 4, 256, 0, stream>>>(mem + (size_t)b * MEM_LEN * D_MODEL, D_MODEL, norm_mem_g + l * D_MODEL, HM, D_MODEL, MEM_LEN, D_MODEL);
            gemm_naive<0><<<dim3(D_MODEL / 64, SEQ / 64), 256, 0, stream>>>(H, D_MODEL, w_xq + (size_t)l * D_MODEL * D_MODEL, D_MODEL, XQ, D_MODEL, SEQ, D_MODEL, D_MODEL);
            gemm_naive<0><<<dim3(2 * D_MODEL / 64, MEM_LEN / 64), 256, 0, stream>>>(HM, D_MODEL, w_xkv + (size_t)l * D_MODEL * 2 * D_MODEL, 2 * D_MODEL, KV, 2 * D_MODEL, MEM_LEN, 2 * D_MODEL, D_MODEL);
            xattn<<<SEQ * XH, 256, 0, stream>>>(XQ, KV, XO);
            gemm_naive<1><<<dim3(D_MODEL / 64, SEQ / 64), 256, 0, stream>>>(XO, D_MODEL, w_xo + (size_t)l * D_MODEL * D_MODEL, D_MODEL, Xb, D_MODEL, SEQ, D_MODEL, D_MODEL);
            rmsnorm_rows<<<SEQ / 4, 256, 0, stream>>>(Xb, D_MODEL, norm_ffn_g + l * D_MODEL, H, D_MODEL, SEQ, D_MODEL);
            gemm_naive<2><<<dim3(D_FF / 64, SEQ / 64), 256, 0, stream>>>(H, D_MODEL, w_ff1 + (size_t)l * D_MODEL * D_FF, D_FF, FFH, D_FF, SEQ, D_FF, D_MODEL);
            gemm_naive<1><<<dim3(D_MODEL / 64, SEQ / 64), 256, 0, stream>>>(FFH, D_FF, w_ff2 + (size_t)l * D_FF * D_MODEL, D_MODEL, Xb, D_MODEL, SEQ, D_MODEL, D_FF);
        }
    }
    rmsnorm_rows<<<BATCH * SEQ / 4, 256, 0, stream>>>(X, D_MODEL, final_norm_g, X, D_MODEL, BATCH * SEQ, D_MODEL);
}
```

```cpp
#include <hip/hip_runtime.h>
#include <cstdio>
#include <cstdint>
namespace pg8 {
#define PG8_LAS __attribute__((address_space(3)))
typedef unsigned short bf16_t;
typedef short bf16x8 __attribute__((ext_vector_type(8)));
typedef float f32x4 __attribute__((ext_vector_type(4)));
typedef unsigned u32x4 __attribute__((ext_vector_type(4)));
constexpr int BM = 256, BK = 64, HALF = 128, HTB = HALF * BK * 2  , STAGE_BYTES = 8 * HTB, NXCD = 8, WGM = 8;

__host__ __device__ __forceinline__ int lds_byte(int r, int c) { const int st = (r >> 4) * 2 + (c >> 5), rr = r & 15, cc = c & 31, ob = rr * 64 + cc * 2; return st * 1024 + (ob ^ (((ob >> 9) & 1) << 5)); }
__host__ __device__ __forceinline__ void stage_rc(int b, int& R, int& C) { const int st = b / 1024, sb = b % 1024, swz = sb ^ (((sb >> 9) & 1) << 5); R = (st >> 1) * 16 + swz / 64; C = (st & 1) * 32 + (swz % 64) / 2; }
__host__ __device__ __forceinline__ int perm32(int rho) { const int n = rho >> 4, i = rho & 15; return 8 * (i >> 2) + 4 * n + (i & 3); }

struct Unit { int pm, pn; };

struct StaticOrder {
    int nM, nN, nwg, G, c;
    __host__ __device__ void init(int M, int N, int G_, int c_) { nM = M / BM; nN = N / BM; nwg = nM * nN; G = G_; c = c_; }
    __host__ __device__ bool next(int i, Unit& u) const {
        const long L = (long)i * G + c; if (L >= nwg) return false;
        int wgid = (int)L; { const int q = nwg / NXCD, r = nwg % NXCD, xcd = wgid % NXCD, off = wgid / NXCD; wgid = (xcd < r ? xcd * (q + 1) : r * (q + 1) + (xcd - r) * q) + off; }
        const int nig = WGM * nN, gid = wgid / nig, fm = gid * WGM, gsz = (nM - fm) < WGM ? (nM - fm) : WGM;
        u.pm = fm + ((wgid % nig) % gsz); u.pn = (wgid % nig) / gsz; return true;
    }
    __device__ __forceinline__ void a_ready(const Unit&) const {}
    __device__ __forceinline__ void done(const Unit&) const {}
};
__device__ __forceinline__ unsigned cvt_pk_bf16(float lo, float hi) { unsigned r; asm volatile("v_cvt_pk_bf16_f32 %0, %1, %2" : "=v"(r) : "v"(lo), "v"(hi)); return r; }
template <class Epi, class Sched, class G, bool ALIGN_EPI = false, bool SP2 = false>
__device__ __forceinline__ void gemm_phase(PG8_LAS unsigned char* lds, const G g, const Sched& S, const Epi& E) {
    int tid_ = threadIdx.x; asm volatile("" : "+v"(tid_));
    const int tid = tid_, wid = __builtin_amdgcn_readfirstlane(tid >> 6), lane = tid & 63, wr = wid >> 2, wc = wid & 3, fr = lane & 15, fq = lane >> 4;
    const int K = g.K, nt = K / BK;
    unsigned voffA[2], voffB[2];
#pragma unroll
    for (int i = 0; i < 2; ++i) { int R, C; stage_rc(tid * 16 + i * 8192, R, C); const int Rb = Epi::PERM ? ((R & ~31) + perm32(R & 31)) : R;
        voffA[i] = (unsigned)(R * g.lda + C) * 2u; voffB[i] = (unsigned)(Rb * g.ldb + C) * 2u; }
    const size_t kstep = (size_t)(BK * 2);
    const size_t hstepA = (size_t)HALF * g.lda * 2, hstepB = (size_t)HALF * g.ldb * 2;
    const unsigned ldsw = (unsigned)wid * 1024u;
    const int aoff = lds_byte(wr * 64 + fr, fq * 8), boff = lds_byte(wc * 32 + fr, fq * 8);
#define PG8_SA(b, h) (((b) * 2 + (h)) * HTB)
#define PG8_SB(b, h) ((4 + (b) * 2 + (h)) * HTB)
#define PG8_STAGE(bufoff, gbase, voff) do { _Pragma("unroll") for (int _i = 0; _i < 2; ++_i) \
        __builtin_amdgcn_global_load_lds((const unsigned*)((const char*)(gbase) + (voff)[_i]), (PG8_LAS unsigned*)(lds + (bufoff) + ldsw + _i * 8192), 16, 0, 0); } while (0)
#define PG8_LDA(dst, b, h) do { _Pragma("unroll") for (int m = 0; m < 4; ++m) _Pragma("unroll") for (int k = 0; k < 2; ++k) dst[m][k] = *(const PG8_LAS bf16x8*)(lds + PG8_SA(b, h) + aoff + m * 2048 + k * 1024); } while (0)
#define PG8_LDB(dst, b, h) do { _Pragma("unroll") for (int n = 0; n < 2; ++n) _Pragma("unroll") for (int k = 0; k < 2; ++k) dst[n][k] = *(const PG8_LAS bf16x8*)(lds + PG8_SB(b, h) + boff + n * 2048 + k * 1024); } while (0)
#define PG8_MMA(ai, bj, At, Bt) do { __builtin_amdgcn_s_setprio(1); _Pragma("unroll") for (int m = 0; m < 4; ++m) _Pragma("unroll") for (int n = 0; n < 2; ++n) _Pragma("unroll") for (int k = 0; k < 2; ++k) \
        acc[ai][bj][m][n] = __builtin_amdgcn_mfma_f32_16x16x32_bf16(Bt[n][k], At[m][k], acc[ai][bj][m][n], 0, 0, 0); __builtin_amdgcn_s_setprio(0); } while (0)
#define PG8_WAIT_V(n) asm volatile("s_waitcnt vmcnt(" #n ")" ::: "memory")
#define PG8_WAIT_L(n) asm volatile("s_waitcnt lgkmcnt(" #n ")" ::: "memory")
#define PG8_BAR __builtin_amdgcn_s_barrier()
#define PG8_SCHED __builtin_amdgcn_sched_barrier(0)
    Unit cur, nxt; int ui = 0;
    if (!S.next(0, cur)) return;
    f32x4 acc[2][2][4][2];
#pragma unroll
    for (int a = 0; a < 2; ++a)
#pragma unroll
        for (int b = 0; b < 2; ++b)
#pragma unroll
            for (int m = 0; m < 4; ++m)
#pragma unroll
                for (int n = 0; n < 2; ++n) acc[a][b][m][n] = (f32x4){0.f, 0.f, 0.f, 0.f};
    bf16x8 At[4][2], B0[2][2], B1[2][2];
    const char* cA = g.a_ptr(cur); const char* cB = g.b_ptr(cur);
    S.a_ready(cur);
    if constexpr (SP2) {
        PG8_STAGE(PG8_SB(0, 0), cB, voffB); PG8_STAGE(PG8_SB(0, 1), cB + hstepB, voffB); PG8_STAGE(PG8_SA(0, 0), cA, voffA); PG8_STAGE(PG8_SA(0, 1), cA + hstepA, voffA);
        if (wr == 1) PG8_BAR;
        PG8_WAIT_V(2); PG8_BAR;
        PG8_STAGE(PG8_SB(1, 0), cB + kstep, voffB); PG8_STAGE(PG8_SA(1, 0), cA + kstep, voffA); PG8_STAGE(PG8_SB(1, 1), cB + hstepB + kstep, voffB);
        PG8_WAIT_V(6); PG8_BAR;
    } else {
        PG8_STAGE(PG8_SB(0, 0), cB, voffB); PG8_STAGE(PG8_SA(0, 0), cA, voffA); PG8_STAGE(PG8_SB(0, 1), cB + hstepB, voffB); PG8_STAGE(PG8_SA(0, 1), cA + hstepA, voffA);
        if (wr == 1) PG8_BAR;
        PG8_WAIT_V(4); PG8_BAR;
        PG8_STAGE(PG8_SB(1, 0), cB + kstep, voffB); PG8_STAGE(PG8_SA(1, 0), cA + kstep, voffA); PG8_STAGE(PG8_SB(1, 1), cB + hstepB + kstep, voffB);
        PG8_WAIT_V(6); PG8_BAR;
    }
    for (;;) {
        const bool has_next = S.next(ui + 1, nxt);
        const char* nA = has_next ? g.a_ptr(nxt) : cA; const char* nB = has_next ? g.b_ptr(nxt) : cB;
        for (int t = 0; t < nt; t += 2) {
            const bool last = (t == nt - 2);
            const char* a1 = cA + (size_t)(t + 1) * kstep;
            const char* a2 = last ? nA : cA + (size_t)(t + 2) * kstep; const char* b2 = last ? nB : cB + (size_t)(t + 2) * kstep;
            const char* a3 = a2 + kstep; const char* b3 = b2 + kstep;
            if (last && has_next) S.a_ready(nxt);
            if constexpr (SP2) {
            PG8_LDB(B0, 0, 0); PG8_LDB(B1, 0, 1); PG8_SCHED; PG8_LDA(At, 0, 0); PG8_STAGE(PG8_SA(1, 1), a1 + hstepA, voffA);
            PG8_WAIT_V(8); PG8_WAIT_L(0); PG8_BAR; PG8_MMA(0, 0, At, B0); PG8_MMA(0, 1, At, B1); PG8_BAR; PG8_SCHED;
            PG8_LDA(At, 0, 1); PG8_STAGE(PG8_SB(0, 0), b2, voffB); PG8_STAGE(PG8_SB(0, 1), b2 + hstepB, voffB); PG8_STAGE(PG8_SA(0, 0), a2, voffA);
            PG8_WAIT_V(8); PG8_WAIT_L(0); PG8_BAR; PG8_MMA(1, 0, At, B0); PG8_MMA(1, 1, At, B1); PG8_BAR; PG8_SCHED;
            PG8_LDB(B0, 1, 0); PG8_LDB(B1, 1, 1); PG8_SCHED; PG8_LDA(At, 1, 0); PG8_STAGE(PG8_SA(0, 1), a2 + hstepA, voffA);
            PG8_WAIT_V(8); PG8_WAIT_L(0); PG8_BAR; PG8_MMA(0, 0, At, B0); PG8_MMA(0, 1, At, B1); PG8_BAR; PG8_SCHED;
            PG8_LDA(At, 1, 1); PG8_STAGE(PG8_SB(1, 0), b3, voffB); PG8_STAGE(PG8_SB(1, 1), b3 + hstepB, voffB); PG8_STAGE(PG8_SA(1, 0), a3, voffA);
            PG8_WAIT_V(8); PG8_WAIT_L(0); PG8_BAR; PG8_MMA(1, 0, At, B0); PG8_MMA(1, 1, At, B1); PG8_BAR; PG8_SCHED;
            } else {
            PG8_LDB(B0, 0, 0); PG8_SCHED; PG8_LDA(At, 0, 0); PG8_STAGE(PG8_SA(1, 1), a1 + hstepA, voffA);
            PG8_WAIT_L(8); PG8_BAR; PG8_WAIT_L(0); PG8_MMA(0, 0, At, B0); PG8_BAR; PG8_SCHED;
            PG8_LDB(B1, 0, 1); PG8_STAGE(PG8_SB(0, 0), b2, voffB);
            PG8_BAR; PG8_WAIT_L(0); PG8_MMA(0, 1, At, B1); PG8_BAR;
            PG8_LDA(At, 0, 1); PG8_STAGE(PG8_SA(0, 0), a2, voffA);
            PG8_BAR; PG8_WAIT_L(0); PG8_MMA(1, 0, At, B0); PG8_BAR; PG8_SCHED;
            PG8_STAGE(PG8_SB(0, 1), b2 + hstepB, voffB);
            PG8_WAIT_V(6); PG8_BAR; PG8_MMA(1, 1, At, B1); PG8_BAR;
            PG8_LDB(B0, 1, 0); PG8_SCHED; PG8_LDA(At, 1, 0); PG8_STAGE(PG8_SA(0, 1), a2 + hstepA, voffA);
            PG8_WAIT_L(8); PG8_BAR; PG8_WAIT_L(0); PG8_MMA(0, 0, At, B0); PG8_BAR; PG8_SCHED;
            PG8_LDB(B1, 1, 1); PG8_STAGE(PG8_SB(1, 0), b3, voffB);
            PG8_BAR; PG8_WAIT_L(0); PG8_MMA(0, 1, At, B1); PG8_BAR;
            PG8_LDA(At, 1, 1); PG8_STAGE(PG8_SA(1, 0), a3, voffA);
            PG8_BAR; PG8_WAIT_L(0); PG8_MMA(1, 0, At, B0); PG8_BAR; PG8_SCHED;
            PG8_STAGE(PG8_SB(1, 1), b3 + hstepB, voffB);
            PG8_WAIT_V(6); PG8_BAR; PG8_MMA(1, 1, At, B1); PG8_BAR;
            }
        }
        if constexpr (ALIGN_EPI) { if (wr == 0) PG8_BAR; }
        if constexpr (!Epi::AFTER_DRAIN) { int te_ = threadIdx.x; asm volatile("" : "+v"(te_)); E(acc, cur, wr, wc, te_ & 15, (te_ & 63) >> 4); S.done(cur); }
        if (!has_next) break;
#pragma unroll
        for (int a = 0; a < 2; ++a)
#pragma unroll
            for (int b = 0; b < 2; ++b)
#pragma unroll
                for (int m = 0; m < 4; ++m)
#pragma unroll
                    for (int n = 0; n < 2; ++n) acc[a][b][m][n] = (f32x4){0.f, 0.f, 0.f, 0.f};
        cur = nxt; cA = nA; cB = nB; ++ui;
        if constexpr (ALIGN_EPI) { if (wr == 1) PG8_BAR; }
    }
    PG8_WAIT_V(0);
    if constexpr (!ALIGN_EPI) { if (wr == 0) PG8_BAR; }
    PG8_BAR;
    if constexpr (Epi::AFTER_DRAIN) { int te_ = threadIdx.x; asm volatile("" : "+v"(te_)); E.fused(acc, cur, wr, wc, te_ & 15, (te_ & 63) >> 4, lds, wid, te_ & 63); S.done(cur); }
#undef PG8_SA
#undef PG8_SB
#undef PG8_STAGE
#undef PG8_LDA
#undef PG8_LDB
#undef PG8_MMA
#undef PG8_WAIT_V
#undef PG8_WAIT_L
#undef PG8_BAR
#undef PG8_SCHED
}
constexpr int TOK = 16384;
constexpr float RMS_EPS = 1e-6f;
struct GemmP { const bf16_t* A; const bf16_t* Bt; int lda, ldb, K;
    __device__ __forceinline__ const char* a_ptr(const Unit& u) const { return (const char*)(A + (size_t)u.pm * BM * lda); }
    __device__ __forceinline__ const char* b_ptr(const Unit& u) const { return (const char*)(Bt + (size_t)u.pn * BM * ldb); } };
struct GemmX { const bf16_t* A; const bf16_t* Bt; int lda, ldb, K;
    __device__ __forceinline__ const char* a_ptr(const Unit& u) const { return (const char*)(A + ((size_t)u.pn * TOK + (size_t)u.pm * BM) * 256); }
    __device__ __forceinline__ const char* b_ptr(const Unit& u) const { return (const char*)(Bt + (size_t)((u.pm >> 3) * 4 + u.pn) * 65536); } };

typedef unsigned u32x2 __attribute__((ext_vector_type(2)));
template <bool MAX> __device__ __forceinline__ float comb16(float s) { const auto r = __builtin_amdgcn_permlane16_swap(__float_as_uint(s), __float_as_uint(s), false, false);
    const float a = __uint_as_float(r[0]), b = __uint_as_float(r[1]); return MAX ? __builtin_fmaxf(a, b) : a + b; }
template <bool MAX> __device__ __forceinline__ float comb32(float s) { const auto r = __builtin_amdgcn_permlane32_swap(__float_as_uint(s), __float_as_uint(s), false, false);
    const float a = __uint_as_float(r[0]), b = __uint_as_float(r[1]); return MAX ? __builtin_fmaxf(a, b) : a + b; }
__device__ __forceinline__ float bf_lo(unsigned w) { return __uint_as_float(w << 16); }
__device__ __forceinline__ float bf_hi(unsigned w) { return __uint_as_float(w & 0xffff0000u); }
__device__ __forceinline__ float fast_sigmoid(float z) { return __builtin_amdgcn_rcpf(1.0f + __builtin_amdgcn_exp2f(-1.4426950408889634f * z)); }
__device__ __forceinline__ float gelu_tanh(float x) {
    const float u = x * (0.7978845608028654f + 0.035677408136300125f * x * x);
    return x * __builtin_amdgcn_rcpf(1.0f + __builtin_amdgcn_exp2f(-2.8853900817779268f * u)); }
__device__ __forceinline__ void load_rstd(float (&rs)[2][4], const float* SS, const Unit& u, int wr, int fr, int fq) {
#pragma unroll
    for (int ai = 0; ai < 2; ++ai)
#pragma unroll
        for (int m = 0; m < 4; ++m) { const f32x4 a = *((const f32x4*)(SS + (size_t)(u.pm * BM + ai * HALF + wr * 64 + m * 16 + fr) * 16) + fq);
            float s = (a[0] + a[1]) + (a[2] + a[3]); s = comb16<false>(s); s = comb32<false>(s);
            rs[ai][m] = __builtin_amdgcn_rsqf(s * (1.0f / 1024.0f) + RMS_EPS); }
}
struct EpiProj { static constexpr bool PERM = true, AFTER_DRAIN = false;
    bf16_t *PA, *Q, *K, *V, *ZC; const float* SS; float qscale;
    __device__ __forceinline__ void operator()(const f32x4 (&acc)[2][2][4][2], const Unit& u, int wr, int wc, int fr, int fq) const {
        const int pn = u.pn; bf16_t* base; int ldc, colt, mode;
        if (pn == 0) { base = PA; ldc = 256; colt = 0; mode = 0; }
        else if (pn <= 2) { base = Q; ldc = 512; colt = (pn - 1) * 256; mode = 1; }
        else if (pn <= 4) { base = K; ldc = 512; colt = (pn - 3) * 256; mode = 0; }
        else if (pn <= 6) { base = V; ldc = 512; colt = (pn - 5) * 256; mode = 0; }
        else { base = ZC; ldc = 512; colt = (pn - 7) * 256; mode = 2; }
        float rs[2][4]; load_rstd(rs, SS, u, wr, fr, fq);
        const float sc = (mode == 1) ? qscale : 1.0f;
        const int row0 = u.pm * BM + wr * 64 + fr, col0 = colt + wc * 32 + 8 * fq;
#pragma unroll
        for (int ai = 0; ai < 2; ++ai)
#pragma unroll
            for (int m = 0; m < 4; ++m) { bf16_t* rowp = base + (size_t)(row0 + ai * HALF + m * 16) * ldc + col0; const float r = rs[ai][m] * sc;
#pragma unroll
                for (int bj = 0; bj < 2; ++bj) { f32x4 v0 = acc[ai][bj][m][0] * r, v1 = acc[ai][bj][m][1] * r;
                    if (mode == 2) { v0 = (f32x4){gelu_tanh(v0[0]), gelu_tanh(v0[1]), gelu_tanh(v0[2]), gelu_tanh(v0[3])}; v1 = (f32x4){gelu_tanh(v1[0]), gelu_tanh(v1[1]), gelu_tanh(v1[2]), gelu_tanh(v1[3])}; }
                    u32x4 w; w.x = cvt_pk_bf16(v0[0], v0[1]); w.y = cvt_pk_bf16(v0[2], v0[3]); w.z = cvt_pk_bf16(v1[0], v1[1]); w.w = cvt_pk_bf16(v1[2], v1[3]);
                    *(u32x4*)(rowp + bj * HALF) = w; } }
    }
};
struct EpiTile { static constexpr bool PERM = true, AFTER_DRAIN = false;
    bf16_t* O; int mm, mn;
    __device__ __forceinline__ void operator()(const f32x4 (&acc)[2][2][4][2], const Unit& u, int wr, int wc, int fr, int fq) const {
        bf16_t* base = O + (size_t)(mm * u.pm + mn * u.pn) * 65536; const int row0 = wr * 64 + fr, col0 = wc * 32 + 8 * fq;
#pragma unroll
        for (int ai = 0; ai < 2; ++ai)
#pragma unroll
            for (int m = 0; m < 4; ++m) { bf16_t* rowp = base + (size_t)(row0 + ai * HALF + m * 16) * 256 + col0;
#pragma unroll
                for (int bj = 0; bj < 2; ++bj) { const f32x4 v0 = acc[ai][bj][m][0], v1 = acc[ai][bj][m][1];
                    u32x4 w; w.x = cvt_pk_bf16(v0[0], v0[1]); w.y = cvt_pk_bf16(v0[2], v0[3]); w.z = cvt_pk_bf16(v1[0], v1[1]); w.w = cvt_pk_bf16(v1[2], v1[3]);
                    *(u32x4*)(rowp + bj * HALF) = w; } }
    }
};
template <int ACT  , bool ROWSCALE, bool HEADMAJOR> struct EpiStore { static constexpr bool PERM = true, AFTER_DRAIN = false;
    bf16_t* O; int ldc; const float* SS; float scale;
    __device__ __forceinline__ void operator()(const f32x4 (&acc)[2][2][4][2], const Unit& u, int wr, int wc, int fr, int fq) const {
        float rs[2][4];
        if (ROWSCALE) load_rstd(rs, SS, u, wr, fr, fq);
        bf16_t* base = O; int colt = u.pn * BM;
        if (HEADMAJOR) { base += (size_t)u.pn * TOK * 256; colt = 0; }
        const int row0 = u.pm * BM + wr * 64 + fr, col0 = colt + wc * 32 + 8 * fq;
#pragma unroll
        for (int ai = 0; ai < 2; ++ai)
#pragma unroll
            for (int m = 0; m < 4; ++m) { bf16_t* rowp = base + (size_t)(row0 + ai * HALF + m * 16) * ldc + col0; const float r = ROWSCALE ? rs[ai][m] * scale : scale;
#pragma unroll
                for (int bj = 0; bj < 2; ++bj) { f32x4 v0 = acc[ai][bj][m][0] * r, v1 = acc[ai][bj][m][1] * r;
                    if (ACT == 1) {
#pragma unroll
                        for (int i = 0; i < 4; ++i) { const float a = __builtin_fmaxf(v0[i], 0.f), b = __builtin_fmaxf(v1[i], 0.f); v0[i] = a * a; v1[i] = b * b; } }
                    u32x4 w; w.x = cvt_pk_bf16(v0[0], v0[1]); w.y = cvt_pk_bf16(v0[2], v0[3]); w.z = cvt_pk_bf16(v1[0], v1[1]); w.w = cvt_pk_bf16(v1[2], v1[3]);
                    *(u32x4*)(rowp + bj * HALF) = w; } }
    }
};
template <bool FIRST> struct EpiGate { static constexpr bool PERM = true, AFTER_DRAIN = false;
    const bf16_t* Y; bf16_t* MG; const float* bias; const float* SS;
    __device__ __forceinline__ void operator()(const f32x4 (&acc)[2][2][4][2], const Unit& u, int wr, int wc, int fr, int fq) const {
        float rs[2][4]; load_rstd(rs, SS, u, wr, fr, fq);
        const int row0 = u.pm * BM + wr * 64 + fr, col0 = u.pn * BM + wc * 32 + 8 * fq;
        f32x4 bv[2][2];
#pragma unroll
        for (int bj = 0; bj < 2; ++bj)
#pragma unroll
            for (int n = 0; n < 2; ++n) bv[bj][n] = *(const f32x4*)(bias + col0 + bj * HALF + 4 * n);
#pragma unroll
        for (int ai = 0; ai < 2; ++ai)
#pragma unroll
            for (int m = 0; m < 4; ++m) { const size_t off = (size_t)(row0 + ai * HALF + m * 16) * 1024 + col0; const float r = rs[ai][m];
#pragma unroll
                for (int bj = 0; bj < 2; ++bj) { const f32x4 z0 = acc[ai][bj][m][0] * r + bv[bj][0], z1 = acc[ai][bj][m][1] * r + bv[bj][1];
                    const u32x4 y = *(const u32x4*)(Y + off + bj * HALF);
                    float o0 = fast_sigmoid(z0[0]) * bf_lo(y.x), o1 = fast_sigmoid(z0[1]) * bf_hi(y.x), o2 = fast_sigmoid(z0[2]) * bf_lo(y.y), o3 = fast_sigmoid(z0[3]) * bf_hi(y.y);
                    float o4 = fast_sigmoid(z1[0]) * bf_lo(y.z), o5 = fast_sigmoid(z1[1]) * bf_hi(y.z), o6 = fast_sigmoid(z1[2]) * bf_lo(y.w), o7 = fast_sigmoid(z1[3]) * bf_hi(y.w);
                    if (!FIRST) { const u32x4 p = *(const u32x4*)(MG + off + bj * HALF);
                        o0 += bf_lo(p.x); o1 += bf_hi(p.x); o2 += bf_lo(p.y); o3 += bf_hi(p.y); o4 += bf_lo(p.z); o5 += bf_hi(p.z); o6 += bf_lo(p.w); o7 += bf_hi(p.w); }
                    u32x4 w; w.x = cvt_pk_bf16(o0, o1); w.y = cvt_pk_bf16(o2, o3); w.z = cvt_pk_bf16(o4, o5); w.w = cvt_pk_bf16(o6, o7);
                    *(u32x4*)(MG + off + bj * HALF) = w; }
                if (m & 1) asm volatile("" ::: "memory"); }
    }
};
struct EpiRes { static constexpr bool PERM = false, AFTER_DRAIN = false;
    const float* base; float* out; bf16_t* xb; float* SS;
    __device__ __forceinline__ void operator()(const f32x4 (&acc)[2][2][4][2], const Unit& u, int wr, int wc, int fr, int fq) const {
        const int row0 = u.pm * BM + wr * 64 + fr, col0 = u.pn * BM + wc * 32 + 4 * fq;
#pragma unroll
        for (int ai = 0; ai < 2; ++ai)
#pragma unroll
            for (int m = 0; m < 4; ++m) { const int row = row0 + ai * HALF + m * 16; const size_t off = (size_t)row * 1024 + col0; float ss = 0.f;
#pragma unroll
                for (int bj = 0; bj < 2; ++bj)
#pragma unroll
                    for (int n = 0; n < 2; ++n) { const f32x4 b = *(const f32x4*)(base + off + bj * HALF + n * 16); const f32x4 v = b + acc[ai][bj][m][n];
                        *(f32x4*)(out + off + bj * HALF + n * 16) = v; ss += (v[0] * v[0] + v[1] * v[1]) + (v[2] * v[2] + v[3] * v[3]);
                        u32x2 w; w.x = cvt_pk_bf16(v[0], v[1]); w.y = cvt_pk_bf16(v[2], v[3]); *(u32x2*)(xb + off + bj * HALF + n * 16) = w; }
                ss = comb16<false>(ss); ss = comb32<false>(ss);
                if (fq == 0) SS[(size_t)row * 16 + u.pn * 4 + wc] = ss;
                if (m & 1) asm volatile("" ::: "memory"); }
    }
};
struct EpiSoftmax { static constexpr bool PERM = true, AFTER_DRAIN = true;
    bf16_t* P;
    __device__ __forceinline__ void fused(f32x4 (&acc)[2][2][4][2], const Unit& u, int wr, int wc, int fr, int fq, PG8_LAS unsigned char* lds, int wid, int lane) const {
        PG8_LAS float* Pm = (PG8_LAS float*)lds; PG8_LAS float* Ps = Pm + 1024;
#pragma unroll
        for (int ai = 0; ai < 2; ++ai)
#pragma unroll
            for (int m = 0; m < 4; ++m) { float t = -INFINITY;
#pragma unroll
                for (int bj = 0; bj < 2; ++bj)
#pragma unroll
                    for (int n = 0; n < 2; ++n) { const f32x4 x = acc[ai][bj][m][n]; t = __builtin_fmaxf(t, __builtin_fmaxf(__builtin_fmaxf(x[0], x[1]), __builtin_fmaxf(x[2], x[3]))); }
                t = comb16<true>(t); t = comb32<true>(t);
                if (fq == 0) Pm[(ai * HALF + wr * 64 + m * 16 + fr) * 4 + wc] = t; }
        asm volatile("s_waitcnt lgkmcnt(0)" ::: "memory"); __builtin_amdgcn_s_barrier(); asm volatile("" ::: "memory");
#pragma unroll
        for (int ai = 0; ai < 2; ++ai)
#pragma unroll
            for (int m = 0; m < 4; ++m) { const int r = ai * HALF + wr * 64 + m * 16 + fr; const f32x4 mm = *(const PG8_LAS f32x4*)(Pm + r * 4);
                const float mx = __builtin_fmaxf(__builtin_fmaxf(mm[0], mm[1]), __builtin_fmaxf(mm[2], mm[3])); float s = 0.f;
#pragma unroll
                for (int bj = 0; bj < 2; ++bj)
#pragma unroll
                    for (int n = 0; n < 2; ++n) { f32x4 x = acc[ai][bj][m][n];
#pragma unroll
                        for (int i = 0; i < 4; ++i) x[i] = __builtin_amdgcn_exp2f(x[i] - mx);
                        acc[ai][bj][m][n] = x; s += (x[0] + x[1]) + (x[2] + x[3]); }
                s = comb16<false>(s); s = comb32<false>(s);
                if (fq == 0) Ps[r * 4 + wc] = s; }
        asm volatile("s_waitcnt lgkmcnt(0)" ::: "memory"); __builtin_amdgcn_s_barrier(); asm volatile("" ::: "memory");
        bf16_t* base = P + ((size_t)u.pn * TOK + (size_t)u.pm * BM) * 256; const int col0 = wc * 32 + 8 * fq;
#pragma unroll
        for (int ai = 0; ai < 2; ++ai)
#pragma unroll
            for (int m = 0; m < 4; ++m) { const int r = ai * HALF + wr * 64 + m * 16 + fr; const f32x4 sm = *(const PG8_LAS f32x4*)(Ps + r * 4);
                const float inv = 1.0f / ((sm[0] + sm[1]) + (sm[2] + sm[3])); bf16_t* rowp = base + (size_t)r * 256 + col0;
#pragma unroll
                for (int bj = 0; bj < 2; ++bj) { const f32x4 v0 = acc[ai][bj][m][0] * inv, v1 = acc[ai][bj][m][1] * inv;
                    u32x4 w; w.x = cvt_pk_bf16(v0[0], v0[1]); w.y = cvt_pk_bf16(v0[2], v0[3]); w.z = cvt_pk_bf16(v1[0], v1[1]); w.w = cvt_pk_bf16(v1[2], v1[3]);
                    *(u32x4*)(rowp + bj * HALF) = w; } }
        asm volatile("s_waitcnt lgkmcnt(0)" ::: "memory"); __builtin_amdgcn_s_barrier(); asm volatile("" ::: "memory");
    }
};
}

#include <hip/hip_bf16.h>
#include <cmath>
namespace attn_body {
using bf16=__hip_bfloat16;
using bf16x8=__attribute__((ext_vector_type(8)))short;
using s16x4=__attribute__((ext_vector_type(4)))short;
using f32x16=__attribute__((ext_vector_type(16)))float;
using u32x4=__attribute__((ext_vector_type(4)))unsigned;
constexpr int BATCH=8,NHEAD=8,SEQ=2048,D=64,DM=NHEAD*D;
constexpr int NW=8,QBLK=32,QB=QBLK*NW,KVBLK=64,NQB=SEQ/QB;
constexpr int ATTN_PITCH=DM, ATTN_UNIT_ROWS=QB;
__device__ __forceinline__ int crow(int r,int hi){return (r&3)+8*(r>>2)+4*hi;}
#define SBAR() __builtin_amdgcn_sched_barrier(0)
__device__ __forceinline__ void cmask(f32x16&p0,f32x16&p1,int jb,int qrel,int hi){
  const float NEG=-INFINITY; int kb=64*jb+4*hi;
  #pragma unroll
  for(int r=0;r<16;++r){int kv=kb+(r&3)+8*(r>>2); if(kv>qrel)p0[r]=NEG; if(kv+32>qrel)p1[r]=NEG;}
}

constexpr int NSLOT=3, SLOTB=8192;
constexpr int LDS_K=0, LDS_V=NSLOT*SLOTB, LDS_WS=2*NSLOT*SLOTB, LDS_OST=LDS_WS+NW*64*4, LDS_BYTES=LDS_OST+NW*4096, LDS_NB=LDS_BYTES;
constexpr float C2=0.125f*1.4426950408889634f;
__device__ __forceinline__ void glds16(const void*gsrc,unsigned lds_dst){unsigned keep;
  asm volatile("s_mov_b32 %0, m0\n\ts_mov_b32 m0, %2\n\ts_nop 0\n\tglobal_load_lds_dwordx4 %1, off\n\ts_mov_b32 m0, %0":"=&s"(keep):"v"(gsrc),"s"(lds_dst):"memory");}
__device__ __forceinline__ float max3f(float a,float b,float c){float r;asm("v_max3_f32 %0, %1, %2, %3":"=v"(r):"v"(a),"v"(b),"v"(c));return r;}
__device__ __forceinline__ float max2f(float a,float b){float r;asm("v_max_f32_e32 %0, %1, %2":"=v"(r):"v"(a),"v"(b));return r;}
__device__ __forceinline__ float fadd_s(float a,float b){float r;asm("v_add_f32_e32 %0, %1, %2":"=v"(r):"v"(a),"v"(b));return r;}
__device__ __forceinline__ float fsub_s(float a,float b){float r;asm("v_sub_f32_e32 %0, %1, %2":"=v"(r):"v"(a),"v"(b));return r;}
typedef float f32x2_t __attribute__((ext_vector_type(2))); typedef __bf16 bf16x2_t __attribute__((ext_vector_type(2)));
__device__ __forceinline__ unsigned cvtpk_s(float lo,float hi){f32x2_t v={lo,hi};bf16x2_t b=__builtin_convertvector(v,bf16x2_t);return __builtin_bit_cast(unsigned,b);}
#define WAIT_BAR(N) asm volatile("s_waitcnt vmcnt(" #N ") lgkmcnt(0)\n\ts_barrier":::"memory")

__device__ __forceinline__ void qkt(f32x16&p0,f32x16&p1,const char*Kslot,const bf16x8*qr,int r32,int hi){
  const char*kb=Kslot+hi*1024+r32*16;
  #pragma unroll
  for(int d0=0;d0<4;++d0){
    const bf16x8 b0=*reinterpret_cast<const bf16x8*>(kb+d0*2048);
    const bf16x8 b1=*reinterpret_cast<const bf16x8*>(kb+d0*2048+512);
    p0=__builtin_amdgcn_mfma_f32_32x32x16_bf16(b0,qr[d0],p0,0,0,0);p1=__builtin_amdgcn_mfma_f32_32x32x16_bf16(b1,qr[d0],p1,0,0,0);}
}
typedef __attribute__((address_space(3))) const char* lds_cptr;
typedef short v4i16_t __attribute__((ext_vector_type(4)));
__device__ __forceinline__ void kload8(bf16x8*kf,lds_cptr kp){
  kf[0]=*(const __attribute__((address_space(3))) bf16x8*)(kp);      kf[1]=*(const __attribute__((address_space(3))) bf16x8*)(kp+512);
  kf[2]=*(const __attribute__((address_space(3))) bf16x8*)(kp+2048); kf[3]=*(const __attribute__((address_space(3))) bf16x8*)(kp+2560);
  kf[4]=*(const __attribute__((address_space(3))) bf16x8*)(kp+4096); kf[5]=*(const __attribute__((address_space(3))) bf16x8*)(kp+4608);
  kf[6]=*(const __attribute__((address_space(3))) bf16x8*)(kp+6144); kf[7]=*(const __attribute__((address_space(3))) bf16x8*)(kp+6656);
}
__device__ __forceinline__ void kload2(bf16x8*kf,lds_cptr kp,int j){ kf[2*j]=*(const __attribute__((address_space(3))) bf16x8*)(kp+j*2048); kf[2*j+1]=*(const __attribute__((address_space(3))) bf16x8*)(kp+j*2048+512); }
__device__ __forceinline__ s16x4 vtr(lds_cptr p){ return __builtin_bit_cast(s16x4,__builtin_amdgcn_ds_read_tr16_b64_v4i16((__attribute__((address_space(3))) v4i16_t*)p)); }
__device__ __forceinline__ float rowmax(const f32x16&p0,const f32x16&p1){
  float a=max3f(p0[0],p0[1],p1[0]),b=max3f(p0[2],p0[3],p1[1]);a=max3f(a,p1[2],p1[3]);
  #pragma unroll
  for(int r=4;r<16;r+=4){a=max3f(a,p0[r],p0[r+1]);b=max3f(b,p0[r+2],p0[r+3]);a=max3f(a,p1[r],p1[r+1]);b=max3f(b,p1[r+2],p1[r+3]);}
  const float m=max2f(a,b);
  auto rr=__builtin_amdgcn_permlane32_swap(__float_as_uint(m),__float_as_uint(m),false,false);
  return max2f(__uint_as_float(rr[0]),__uint_as_float(rr[1]));
}
__device__ __forceinline__ void pv(f32x16*o,int vb,bf16x8 pa0,bf16x8 pa1,bf16x8 pa2,bf16x8 pa3){
  #pragma unroll
  for(int d0=0;d0<2;++d0){s16x4 lo[4],hi[4];
    #pragma unroll
    for(int ks=0;ks<4;++ks){
      asm volatile("ds_read_b64_tr_b16 %0,%1 offset:%c2":"=&v"(lo[ks]):"v"(vb),"i"(d0*4096+ks*1024):"memory");
      asm volatile("ds_read_b64_tr_b16 %0,%1 offset:%c2":"=&v"(hi[ks]):"v"(vb),"i"(d0*4096+ks*1024+512):"memory");}
    asm volatile("s_waitcnt lgkmcnt(0)":::"memory");SBAR();
    #define PK(k) (bf16x8){lo[k][0],lo[k][1],lo[k][2],lo[k][3],hi[k][0],hi[k][1],hi[k][2],hi[k][3]}
    o[d0]=__builtin_amdgcn_mfma_f32_32x32x16_bf16(pa0,PK(0),o[d0],0,0,0);
    o[d0]=__builtin_amdgcn_mfma_f32_32x32x16_bf16(pa1,PK(1),o[d0],0,0,0);
    o[d0]=__builtin_amdgcn_mfma_f32_32x32x16_bf16(pa2,PK(2),o[d0],0,0,0);
    o[d0]=__builtin_amdgcn_mfma_f32_32x32x16_bf16(pa3,PK(3),o[d0],0,0,0);
    #undef PK
  }
}

#ifndef ATTN_STORE16
#define ATTN_STORE16(p,v) (*(u32x4*)(p)=(v))
#endif
template<int THRL> __device__ __forceinline__ void attn_unit(int b,int h,int qb,const bf16*Q,const bf16*__restrict__ K,const bf16*__restrict__ V,bf16*O,char*shm){
  int tid_=threadIdx.x; asm volatile("":"+v"(tid_)); const int tid=tid_,lane=tid&63,r32=lane&31,hi=lane>>5; const int wid=__builtin_amdgcn_readfirstlane(tid>>6);
  const long rowbase=(long)b*SEQ; const int q0=qb*QB;
  const bf16*Qw=Q+(rowbase+q0+wid*QBLK)*DM+h*D;
  const bf16*Kh=K+rowbase*DM+h*D,*Vh=V+rowbase*DM+h*D;
  const unsigned lds0=(unsigned)(uintptr_t)shm;
  float*wsf=(float*)(shm+LDS_WS)+wid*64;
  const bf16*ksrc=Kh+(long)lane*DM+wid*8;
  const bf16*vsrc=Vh+(long)(16*(wid&3)+(lane>>2))*DM+(wid>>2)*32+(lane&3)*8;
  const unsigned kdst=lds0+LDS_K+wid*1024, vdst=lds0+LDS_V+wid*1024;
  #define DMA_K(t,slot) glds16(ksrc+(long)(t)*KVBLK*DM,(unsigned)__builtin_amdgcn_readfirstlane(kdst+(slot)))
  #define DMA_V(t,slot) glds16(vsrc+(long)(t)*KVBLK*DM,(unsigned)__builtin_amdgcn_readfirstlane(vdst+(slot)))
  const int vb0=(int)(lds0+LDS_V)+((lane>>4)&1)*32+(lane&3)*8+(4*hi+((lane&15)>>2))*64;
  const char*Kbase=shm+LDS_K; bf16x8 kf[8];
  const lds_cptr shm3=(lds_cptr)shm; const lds_cptr kp0=shm3+LDS_K+hi*1024+r32*16; const lds_cptr vp0=shm3+LDS_V+((lane>>4)&1)*32+(lane&3)*8+(4*hi+((lane&15)>>2))*64;
  const int NT=(q0+QB)/KVBLK;
  DMA_K(0,0);DMA_V(0,0);DMA_K(1,SLOTB);
  bf16x8 qr[4];
  #pragma unroll
  for(int d0=0;d0<4;++d0)qr[d0]=*reinterpret_cast<const bf16x8*>(&Qw[(long)r32*DM+d0*16+hi*8]);
  float mhat=0.f,l_reg=0.f;f32x16 o[2];o[0]=f32x16{};o[1]=f32x16{};
  typedef float f32x4_t __attribute__((ext_vector_type(4)));
  const __attribute__((address_space(3))) f32x4_t* nb3=(const __attribute__((address_space(3))) f32x4_t*)((lds_cptr)shm+LDS_NB+hi*16);
  #define LDBIAS(C0,C1,t) do{ const __attribute__((address_space(3))) f32x4_t* nb_=nb3+16*(t); \
    _Pragma("unroll") for(int g_=0;g_<4;++g_){ const f32x4_t a_=nb_[2*g_], b_=nb_[8+2*g_]; \
      C0[4*g_]=a_[0];C0[4*g_+1]=a_[1];C0[4*g_+2]=a_[2];C0[4*g_+3]=a_[3]; C1[4*g_]=b_[0];C1[4*g_+1]=b_[1];C1[4*g_+2]=b_[2];C1[4*g_+3]=b_[3]; } }while(0)
  const int qrel=wid*QBLK+r32;
  #define CMASK(P0,P1,t) do{int jb_=(t)-(NT-4); if(jb_>=0)cmask(P0,P1,jb_,qrel,hi);}while(0)
  bool resc=false;
  #define START(P0,P1) do{ const float rm=rowmax(P0,P1); resc=false; mhat=rm; \
    _Pragma("unroll") for(int r=0;r<16;++r)P0[r]=__builtin_amdgcn_exp2f(P0[r]-mhat); }while(0)
  #define RESC() do{ if(resc){ asm volatile("s_waitcnt lgkmcnt(0)":::"memory"); \
      _Pragma("unroll") for(int d_=0;d_<2;++d_) _Pragma("unroll") for(int r=0;r<16;++r)o[d_][r]*=wsf[crow(r,hi)]; } }while(0)
  f32x16 pA0,pA1,pB0,pB1;
  int sl_prev=0,sl_cur=0,sl_next=SLOTB;
  #define ROT() do{sl_prev=sl_cur;sl_cur=sl_next;sl_next=(sl_next==(NSLOT-1)*SLOTB)?0:sl_next+SLOTB;}while(0)
  DMA_K(2,2*SLOTB);
  WAIT_BAR(3);
  LDBIAS(pA0,pA1,0); qkt(pA0,pA1,Kbase,qr,r32,hi);asm volatile("s_nop 15\n\ts_nop 7":"+v"(pA0),"+v"(pA1));CMASK(pA0,pA1,0);
  START(pA0,pA1);
  _Pragma("unroll") for(int r=0;r<16;++r)pA1[r]=__builtin_amdgcn_exp2f(pA1[r]-mhat);
  WAIT_BAR(0);
  DMA_K(3,0);DMA_V(1,SLOTB);
  ROT();
  kload8(kf,kp0+sl_cur);
  WAIT_BAR(2);
  s16x4 vlo[8],vhi[8]; u32x4 pw0,pw1,pw2,pw3;
  #define PKW(P,B) cvtpk_s(P[B],P[B+1])
  #define PAF(k) __builtin_bit_cast(bf16x8,pw##k)
  #define VFR(i) (bf16x8){vlo[i][0],vlo[i][1],vlo[i][2],vlo[i][3],vhi[i][0],vhi[i][1],vhi[i][2],vhi[i][3]}
  #define PIN(x) asm volatile("":"+v"(x))
  #define MX3(a,b,c) __builtin_fmaxf(__builtin_fmaxf((a),(b)),(c))
  #define GAPA(MF,A0,A1,A2,A3,W0,W1,PW) do{ MF; sacc+=A0; sacc+=A1; sacc+=A2; sacc+=A3; PIN(sacc); W0; W1; PIN(PW); SBAR(); }while(0)
  #define EX(v) __builtin_amdgcn_exp2f((v)-mhat)
  #define GAPB(MF,X,B) do{ MF; X[B]=EX(X[B]); X[B+1]=EX(X[B+1]); X[B+2]=EX(X[B+2]); X[B+3]=EX(X[B+3]); PIN(X); SBAR(); }while(0)
  #define VRD(i) do{ vlo[i]=vtr(vp_+(((i)>>2)*4096+((i)&3)*1024)); vhi[i]=vtr(vp_+(((i)>>2)*4096+((i)&3)*1024+512)); }while(0)
  #define KRD(G,j) do{ if(G){ kload2(kf,kp0+sl_next,j); SBAR(); } }while(0)
  #define STEP(C0,C1,P0,P1,t,GK,GV,GL) do{ SBAR(); LDBIAS(C0,C1,t); \
    const lds_cptr vp_=vp0+sl_prev; \
    VRD(0); SBAR(); float sacc=(P0[0]+P0[1]); \
    GAPA(C0=__builtin_amdgcn_mfma_f32_32x32x16_bf16(kf[0],qr[0],C0,0,0,0), P0[2],P0[3],P0[4],P0[5],     pw0[0]=PKW(P0,0), pw0[1]=PKW(P0,2), pw0); \
    VRD(4); SBAR(); GAPA(C1=__builtin_amdgcn_mfma_f32_32x32x16_bf16(kf[1],qr[0],C1,0,0,0), P0[6],P0[7],P0[8],P0[9],     pw0[2]=PKW(P0,4), pw0[3]=PKW(P0,6), pw0); \
    VRD(1); SBAR(); GAPA(C0=__builtin_amdgcn_mfma_f32_32x32x16_bf16(kf[2],qr[1],C0,0,0,0),   P0[10],P0[11],P0[12],P0[13], pw1[0]=PKW(P0,8), pw1[1]=PKW(P0,10), pw1); \
    VRD(5); SBAR(); GAPA(C1=__builtin_amdgcn_mfma_f32_32x32x16_bf16(kf[3],qr[1],C1,0,0,0),   P0[14],P0[15],P1[0],P1[1],   pw1[2]=PKW(P0,12),pw1[3]=PKW(P0,14), pw1); \
    VRD(2); SBAR(); GAPA(C0=__builtin_amdgcn_mfma_f32_32x32x16_bf16(kf[4],qr[2],C0,0,0,0),   P1[2],P1[3],P1[4],P1[5],     pw2[0]=PKW(P1,0), pw2[1]=PKW(P1,2), pw2); \
    VRD(6); SBAR(); GAPA(C1=__builtin_amdgcn_mfma_f32_32x32x16_bf16(kf[5],qr[2],C1,0,0,0),   P1[6],P1[7],P1[8],P1[9],     pw2[2]=PKW(P1,4), pw2[3]=PKW(P1,6), pw2); \
    VRD(3); SBAR(); GAPA(C0=__builtin_amdgcn_mfma_f32_32x32x16_bf16(kf[6],qr[3],C0,0,0,0),   P1[10],P1[11],P1[12],P1[13], pw3[0]=PKW(P1,8), pw3[1]=PKW(P1,10), pw3); \
    VRD(7); SBAR(); GAPA(C1=__builtin_amdgcn_mfma_f32_32x32x16_bf16(kf[7],qr[3],C1,0,0,0),   P1[14],P1[15],0.f,0.f,       pw3[2]=PKW(P1,12),pw3[3]=PKW(P1,14), pw3); \
    l_reg+=sacc; \
    if(GK){DMA_K((t)+3,sl_cur);} if(GV){DMA_V((t)+1,sl_next);} \
    CMASK(C0,C1,t); \
    { float a=MX3(C0[0],C0[1],C1[0]),b=MX3(C0[2],C0[3],C1[1]); a=MX3(a,C1[2],C1[3]); \
      _Pragma("unroll") for(int r=4;r<16;r+=4){a=MX3(a,C0[r],C0[r+1]);b=MX3(b,C0[r+2],C0[r+3]);a=MX3(a,C1[r],C1[r+1]);b=MX3(b,C1[r+2],C1[r+3]);} \
      float rm=__builtin_fmaxf(a,b); { auto rr=__builtin_amdgcn_permlane32_swap(__float_as_uint(rm),__float_as_uint(rm),false,false); rm=__builtin_fmaxf(__uint_as_float(rr[0]),__uint_as_float(rr[1])); } \
      resc=false; rm-=mhat; \
      if(__builtin_expect(__any(rm>(float)THRL),0)){ const float dl=__builtin_fmaxf(rm,0.f); mhat+=dl; \
        const float f=__builtin_amdgcn_exp2f(-dl); l_reg*=f; if(hi==0)wsf[r32]=f; resc=true; } } \
    SBAR(); \
    GAPB(o[0]=__builtin_amdgcn_mfma_f32_32x32x16_bf16(PAF(0),VFR(0),o[0],0,0,0), C0,0); \
    GAPB(o[1]=__builtin_amdgcn_mfma_f32_32x32x16_bf16(PAF(0),VFR(4),o[1],0,0,0), C0,4); \
    KRD(GL,0); GAPB(o[0]=__builtin_amdgcn_mfma_f32_32x32x16_bf16(PAF(1),VFR(1),o[0],0,0,0), C0,8); \
    KRD(GL,1); GAPB(o[1]=__builtin_amdgcn_mfma_f32_32x32x16_bf16(PAF(1),VFR(5),o[1],0,0,0), C0,12); \
    KRD(GL,2); GAPB(o[0]=__builtin_amdgcn_mfma_f32_32x32x16_bf16(PAF(2),VFR(2),o[0],0,0,0), C1,0); \
    KRD(GL,3); GAPB(o[1]=__builtin_amdgcn_mfma_f32_32x32x16_bf16(PAF(2),VFR(6),o[1],0,0,0), C1,4); \
    GAPB(o[0]=__builtin_amdgcn_mfma_f32_32x32x16_bf16(PAF(3),VFR(3),o[0],0,0,0), C1,8); \
    GAPB(o[1]=__builtin_amdgcn_mfma_f32_32x32x16_bf16(PAF(3),VFR(7),o[1],0,0,0), C1,12); \
    }while(0)
  int t=1;
  #undef CMASK
  #define CMASK(P0,P1,t) do{}while(0)
  for(;t+5<NT;t+=2){
    STEP(pB0,pB1,pA0,pA1,t,true,true,true);     WAIT_BAR(2); RESC(); ROT();
    STEP(pA0,pA1,pB0,pB1,t+1,true,true,true);   WAIT_BAR(2); RESC(); ROT();
  }
  #undef CMASK
  #define CMASK(P0,P1,t) do{int jb_=(t)-(NT-4); if(jb_>=0)cmask(P0,P1,jb_,qrel,hi);}while(0)
  #define ENDW(tt) do{ if((tt)+3<NT){WAIT_BAR(2);} else if((tt)+2<NT){WAIT_BAR(1);} else {WAIT_BAR(0);} }while(0)
  for(;t+1<NT;t+=2){
    STEP(pB0,pB1,pA0,pA1,t,(t+3<NT),(t+1<NT),(t+1<NT));       ENDW(t);   RESC(); ROT();
    STEP(pA0,pA1,pB0,pB1,t+1,(t+4<NT),(t+2<NT),(t+2<NT));     ENDW(t+1); RESC(); ROT();
  }
  STEP(pB0,pB1,pA0,pA1,NT-1,false,false,false); RESC();
  { float sacc=pB0[0]+pB0[1]; _Pragma("unroll") for(int r=2;r<16;++r)sacc+=pB0[r]; _Pragma("unroll") for(int r=0;r<16;++r)sacc+=pB1[r]; l_reg+=sacc;
    pw0=(u32x4){PKW(pB0,0),PKW(pB0,2),PKW(pB0,4),PKW(pB0,6)};pw1=(u32x4){PKW(pB0,8),PKW(pB0,10),PKW(pB0,12),PKW(pB0,14)};pw2=(u32x4){PKW(pB1,0),PKW(pB1,2),PKW(pB1,4),PKW(pB1,6)};pw3=(u32x4){PKW(pB1,8),PKW(pB1,10),PKW(pB1,12),PKW(pB1,14)};
    SBAR(); pv(o,vb0+sl_cur,PAF(0),PAF(1),PAF(2),PAF(3)); }
  #undef PKW
  #undef PAF
  #undef VFR
  #undef PIN
  #undef MX3
  #undef GAPA
  #undef GAPB
  #undef EX
  #undef VRD
  #undef KRD
  #undef STEP
  #undef ENDW
  {auto rr=__builtin_amdgcn_permlane32_swap(__float_as_uint(l_reg),__float_as_uint(l_reg),false,false);l_reg=__uint_as_float(rr[0])+__uint_as_float(rr[1]);}
  if(hi==0)wsf[32+r32]=l_reg;asm volatile("s_waitcnt lgkmcnt(0)":::"memory");
  float rli[16];
  #pragma unroll
  for(int r=0;r<16;++r)rli[r]=__builtin_amdgcn_rcpf(wsf[32+crow(r,hi)]);
  bf16*Ow=O+(rowbase+q0+wid*QBLK)*DM+h*D;
  { bf16*stg=(bf16*)(shm+LDS_OST)+wid*2048;
    #pragma unroll
    for(int r=0;r<16;++r){const int orow=crow(r,hi);
      #pragma unroll
      for(int d0=0;d0<2;++d0)stg[orow*64+d0*32+r32]=__float2bfloat16(o[d0][r]*rli[r]);}
    asm volatile("s_waitcnt lgkmcnt(0)":::"memory");
    #pragma unroll
    for(int i=0;i<4;++i){const int row=i*8+(lane>>3),ch=lane&7; const u32x4 v=*(const u32x4*)(stg+row*64+ch*8); ATTN_STORE16(Ow+(long)row*DM+ch*8,v);} }
  asm volatile("s_waitcnt lgkmcnt(0)\n\ts_barrier":::"memory");
  #undef DMA_K
  #undef DMA_V
  #undef CMASK
  #undef START
  #undef RESC
  #undef ROT
  #undef LDBIAS
}
constexpr int ATTN_LDS_BYTES=LDS_BYTES;
#undef SBAR
#undef WAIT_BAR
}

#define GAS __attribute__((address_space(1)))
#define LAS __attribute__((address_space(3)))
typedef unsigned short bf16;
typedef unsigned v4u __attribute__((ext_vector_type(4)));
typedef float f32x4 __attribute__((ext_vector_type(4)));
typedef short bf16x8 __attribute__((ext_vector_type(8)));
typedef GAS unsigned gu32;
typedef GAS unsigned long long gu64;
#define RLX_AGENT __ATOMIC_RELAXED, __HIP_MEMORY_SCOPE_AGENT
#define LDS_WAIT() asm volatile("s_waitcnt lgkmcnt(0)" ::: "memory")
#define VM_WAIT() asm volatile("s_waitcnt vmcnt(0)" ::: "memory")
__device__ __forceinline__ unsigned long long rt() { return __builtin_amdgcn_s_memrealtime(); }
__device__ __forceinline__ unsigned f2bf(float f) { unsigned u = __builtin_bit_cast(unsigned, f); return (u + 0x7fffu + ((u >> 16) & 1u)) >> 16; }
__device__ __forceinline__ unsigned pk2(float lo, float hi) { return f2bf(lo) | (f2bf(hi) << 16); }

#define XB_TMO      128
#define XB_XCNT(j)  (256  + 64 * (j))
#define XB_XSUB(j)  (1280 + 64 * (j))
#define XB_XGEN(j)  (2304 + 64 * (j))
#define XB_TOP      3328
#define XB_TOPGEN   3392
#define XCD_BAR_WORDS 3456
#define XB_SPIN_CAP (1u << 18)

__device__ __forceinline__ unsigned xb_ld(unsigned* p)              { return __hip_atomic_load(p, __ATOMIC_RELAXED, __HIP_MEMORY_SCOPE_AGENT); }
__device__ __forceinline__ unsigned xb_add(unsigned* p, unsigned v) { return __hip_atomic_fetch_add(p, v, __ATOMIC_RELAXED, __HIP_MEMORY_SCOPE_AGENT); }
__device__ __forceinline__ unsigned xb_xcc_id() { return (unsigned)__builtin_amdgcn_s_getreg((3 << 11) | 20) & 0xFu; }
#define XB_SPIN(cond, bar) do { unsigned _sp = 0; while (cond) { __builtin_amdgcn_s_sleep(1); \
    if ((++_sp & 255u) == 0u) { if (xb_ld(&(bar)[XB_TMO])) break; if (_sp > XB_SPIN_CAP) { atomicAdd(&(bar)[XB_TMO], 1u); break; } } } } while (0)

struct XcdBarrier {
    unsigned* bar; unsigned x;
    volatile LAS unsigned* st;
};

__device__ __forceinline__ XcdBarrier xcd_barrier_post(unsigned* bar, volatile LAS unsigned* st) {
    XcdBarrier b; b.bar = bar; b.x = xb_xcc_id(); b.st = st;
    if (threadIdx.x == 0) (void)xb_add(&bar[XB_XCNT(b.x)], 1u);
    return b;
}
__device__ __forceinline__ void xcd_barrier_complete(unsigned* bar, unsigned x, unsigned& nloc, unsigned& nx) {
    const unsigned G = gridDim.x * gridDim.y * gridDim.z;
    unsigned sum, cnt, mine, sp = 0u;
    for (;;) {
        sum = 0u; cnt = 0u; mine = 0u;
#pragma unroll
        for (unsigned j = 0; j < 16; ++j) { const unsigned c = xb_ld(&bar[XB_XCNT(j)]); sum += c; cnt += (c > 0u) ? 1u : 0u; mine = (j == x) ? c : mine; }
        if (sum == G) break;
        __builtin_amdgcn_s_sleep(1);
        if ((++sp & 255u) == 0u) { if (xb_ld(&bar[XB_TMO])) break; if (sp > XB_SPIN_CAP) { atomicAdd(&bar[XB_TMO], 1u); break; } }
    }
    nloc = mine > 0u ? mine : 1u; nx = cnt > 0u ? cnt : 1u;
}

__device__ __forceinline__ void xcd_barrier(const XcdBarrier& b) {
    asm volatile("s_waitcnt vmcnt(0)" ::: "memory");
    __syncthreads();
    int tb_ = threadIdx.x; asm volatile("" : "+v"(tb_));
    if (tb_ == 0) {
        unsigned* bar = b.bar;
        __builtin_amdgcn_s_waitcnt(0);
        unsigned nloc = b.st[0], nx = b.st[1];
        if (nloc == 0u) { xcd_barrier_complete(bar, b.x, nloc, nx); b.st[0] = nloc; b.st[1] = nx; }
        const unsigned old = xb_add(&bar[XB_XSUB(b.x)], 1u);
        const unsigned gen = old / nloc;
        if (old + 1u == (gen + 1u) * nloc) {
            __builtin_amdgcn_fence(__ATOMIC_RELEASE, "agent");
            asm volatile("s_waitcnt vmcnt(0)" ::: "memory");
            const unsigned og = xb_add(&bar[XB_TOP], 1u);
            const unsigned tg = og / nx;
            if (og + 1u == (tg + 1u) * nx) xb_add(&bar[XB_TOPGEN], 1u);
            else XB_SPIN(xb_ld(&bar[XB_TOPGEN]) == tg, bar);
            __builtin_amdgcn_fence(__ATOMIC_ACQUIRE, "agent");
            xb_add(&bar[XB_XGEN(b.x)], 1u);
            asm volatile("s_waitcnt vmcnt(0)" ::: "memory");
        } else {
            XB_SPIN(xb_ld(&bar[XB_XGEN(b.x)]) == gen, bar);
            __builtin_amdgcn_fence(__ATOMIC_ACQUIRE, "agent");
            asm volatile("s_waitcnt vmcnt(0)" ::: "memory");
        }
    }
    __syncthreads();
}

constexpr int NWAVES = 8, NCU = 256;
constexpr int BATCH = 8, SEQ = 2048, D = 1024, TOK = BATCH * SEQ, DEPTH = 2, MEMLEN = 256, FF = 4096;
constexpr int N_IN = 5384, OFF_F = 1792, OFF_C = 1800, OFF_G = 2312;
constexpr float EPSF = 1e-6f, LOG2E = 1.4426950408889634f;
constexpr size_t MiB = 1u << 20;
constexpr size_t WS_CTL = 0, CTL_ZERO_BYTES = 1 * MiB;
constexpr size_t WS_SS = 1 * MiB;
constexpr size_t WS_LOGF = 2 * MiB;
constexpr size_t WS_W = 3 * MiB;
constexpr size_t OW_IN = 0, OW_G = OW_IN + (size_t)2304 * 1024 * 2, OW_A = OW_G + (size_t)3072 * 1024 * 2, OW_B = OW_A + (size_t)1024 * 256 * 2, OW_C = OW_B + (size_t)1024 * 512 * 2,
                 OW_OUT = OW_C + (size_t)1024 * 256 * 2, OW_XQ = OW_OUT + (size_t)1024 * 1024 * 2, OW_XKV = OW_XQ + (size_t)1024 * 1024 * 2, OW_XO = OW_XKV + (size_t)2048 * 1024 * 2,
                 OW_FF1 = OW_XO + (size_t)1024 * 1024 * 2, OW_FF2 = OW_FF1 + (size_t)4096 * 1024 * 2, LW = OW_FF2 + (size_t)1024 * 4096 * 2;
static_assert(LW == 40370176 && WS_W + 2 * LW <= 80 * MiB, "weight map");
constexpr size_t WS_XKV1 = 80 * MiB;
constexpr size_t WS_XB = 88 * MiB;
constexpr size_t WS_DYN = 120 * MiB;
constexpr size_t WS_Q = WS_DYN, WS_K = WS_DYN + 16 * MiB, WS_V = WS_DYN + 32 * MiB, WS_PA = WS_DYN + 48 * MiB, WS_DD = WS_DYN + 56 * MiB, WS_ZC = WS_DYN + 64 * MiB,
                 WS_SG = WS_DYN + 80 * MiB, WS_T2 = WS_DYN + 88 * MiB, WS_HM = WS_DYN + 120 * MiB, WS_XKV0 = WS_DYN + 128 * MiB;
constexpr size_t WS_MG = WS_DYN + 16 * MiB;
constexpr size_t WS_XQH = WS_DYN, WS_PP = WS_DYN + 32 * MiB, WS_XO = WS_DYN + 64 * MiB;
constexpr size_t WS_FFH = WS_DYN;
constexpr size_t WS_END = 256 * MiB;
static_assert(WS_XKV0 + 8 * MiB <= WS_END, "d_ws map");
constexpr int CW_TMO = 0, CW_CODE = 1, CW_BAR = 4096;
constexpr int RING_OFF = 0, RING_BYTES = 131072, LDSCTL_OFF = RING_BYTES, MISC_OFF = LDSCTL_OFF + 320, LDS_BYTES = 147456;

template <int CTRL> __device__ __forceinline__ float dppf(float v) { return __uint_as_float(__builtin_amdgcn_update_dpp(0u, __float_as_uint(v), CTRL, 0xf, 0xf, false)); }
__device__ __forceinline__ float wave_sum(float v) {
    v += dppf<0xB1>(v); v += dppf<0x4E>(v); v += dppf<0x141>(v); v += dppf<0x140>(v);
    v = pg8::comb16<false>(v); v = pg8::comb32<false>(v);
    return v;
}
__device__ __forceinline__ float wave_scan(float v) {
    v += dppf<0x111>(v); v += dppf<0x112>(v); v += dppf<0x114>(v); v += dppf<0x118>(v);
    v += __uint_as_float(__builtin_amdgcn_update_dpp(0u, __float_as_uint(v), 0x142, 0xa, 0xf, false));
    v += __uint_as_float(__builtin_amdgcn_update_dpp(0u, __float_as_uint(v), 0x143, 0xc, 0xf, false));
    return v;
}

struct Frame {
    LAS unsigned char* lds;
    volatile LAS unsigned* MISC;
    gu32* ctl;
    int tid, lane, wave, vcu, G;
    float* out; unsigned char* ws;
};
constexpr int PTRS_OFF = LDSCTL_OFF + 512;
__device__ __forceinline__ const float* inp(const Frame& F, int i) {
    const unsigned long long v = *(volatile LAS unsigned long long*)(F.lds + PTRS_OFF + 8 * i);
    const unsigned lo = __builtin_amdgcn_readfirstlane((unsigned)v), hi = __builtin_amdgcn_readfirstlane((unsigned)(v >> 32));
    return (const float*)(const GAS float*)(((unsigned long long)hi << 32) | lo); }
__device__ __forceinline__ bf16* wsb(const Frame& F, size_t off) { return (bf16*)(F.ws + off); }
__device__ __forceinline__ bf16* wlay(const Frame& F, int l, size_t off) { return (bf16*)(F.ws + WS_W + (size_t)l * LW + off); }

__device__ __forceinline__ void tr_item(const float* W, int ldw, int K, int scol0, bf16* WT, int drow0, const float* gain, LAS float* scr, int kb, int nb, int lane) {
    const int k0 = 64 * kb, n0 = 32 * nb;
#pragma unroll 8
    for (int i = 0; i < 32; ++i) { const int kk = 2 * i + (lane >> 5); float v = W[(size_t)(k0 + kk) * ldw + scol0 + n0 + (lane & 31)]; if (gain) v *= gain[k0 + kk]; scr[kk * 33 + (lane & 31)] = v; }
    LDS_WAIT(); asm volatile("" ::: "memory");
    const int c = lane & 7;
#pragma unroll
    for (int j = 0; j < 4; ++j) { const int n = (lane >> 3) + 8 * j; const LAS float* s = scr + (8 * c) * 33 + n;
        v4u o; o.x = pk2(s[0 * 33], s[1 * 33]); o.y = pk2(s[2 * 33], s[3 * 33]); o.z = pk2(s[4 * 33], s[5 * 33]); o.w = pk2(s[6 * 33], s[7 * 33]);
        *(GAS v4u*)(WT + (size_t)(drow0 + n0 + n) * K + k0 + 8 * c) = o; }
    LDS_WAIT(); asm volatile("" ::: "memory");
}
constexpr int I_IN1 = 16 * 56, I_IN2 = 16 * 16, I_G = 16 * 96, I_B = 8 * 32, I_C = 4 * 32, I_OUT = 16 * 32, I_XQ = 16 * 32, I_XKV = 16 * 64, I_XO = 16 * 32, I_FF1 = 16 * 128, I_FF2 = 64 * 32;
constexpr int I_LAYER = I_IN1 + I_IN2 + I_G + I_B + I_C + I_OUT + I_XQ + I_XKV + I_XO + I_FF1 + I_FF2;

__device__ __forceinline__ void p0_prologue(Frame& F) {
    LAS float* scr = (LAS float*)(F.lds + RING_OFF + F.wave * 16384);
    const int gw = F.vcu * NWAVES + F.wave, NGW = F.G * NWAVES, lane = F.lane;
    for (int it = gw; it < DEPTH * I_LAYER; it += NGW) {
        const int l = it / I_LAYER; int r = it % I_LAYER;
        const float* w_in = inp(F, 3) + (size_t)l * D * N_IN;
        if (r < I_IN1) { tr_item(w_in, N_IN, D, 0, wlay(F, l, OW_IN), 0, inp(F, 2) + l * D, scr, r / 56, r % 56, lane); continue; } r -= I_IN1;
        if (r < I_IN2) { tr_item(w_in, N_IN, D, OFF_C, wlay(F, l, OW_IN), 1792, inp(F, 2) + l * D, scr, r / 16, r % 16, lane); continue; } r -= I_IN2;
        if (r < I_G) { tr_item(w_in, N_IN, D, OFF_G, wlay(F, l, OW_G), 0, inp(F, 2) + l * D, scr, r / 96, r % 96, lane); continue; } r -= I_G;
        if (r < I_B) { tr_item(inp(F, 11) + (size_t)l * 512 * D, D, 512, 0, wlay(F, l, OW_B), 0, nullptr, scr, r / 32, r % 32, lane); continue; } r -= I_B;
        if (r < I_C) { tr_item(inp(F, 12) + (size_t)l * 256 * D, D, 256, 0, wlay(F, l, OW_C), 0, nullptr, scr, r / 32, r % 32, lane); continue; } r -= I_C;
        if (r < I_OUT) { tr_item(inp(F, 14) + (size_t)l * D * D, D, D, 0, wlay(F, l, OW_OUT), 0, nullptr, scr, r / 32, r % 32, lane); continue; } r -= I_OUT;
        if (r < I_XQ) { tr_item(inp(F, 17) + (size_t)l * D * D, D, D, 0, wlay(F, l, OW_XQ), 0, inp(F, 15) + l * D, scr, r / 32, r % 32, lane); continue; } r -= I_XQ;
        if (r < I_XKV) { tr_item(inp(F, 18) + (size_t)l * D * 2 * D, 2 * D, D, 0, wlay(F, l, OW_XKV), 0, nullptr, scr, r / 64, r % 64, lane); continue; } r -= I_XKV;
        if (r < I_XO) { tr_item(inp(F, 19) + (size_t)l * D * D, D, D, 0, wlay(F, l, OW_XO), 0, nullptr, scr, r / 32, r % 32, lane); continue; } r -= I_XO;
        if (r < I_FF1) { tr_item(inp(F, 21) + (size_t)l * D * FF, FF, D, 0, wlay(F, l, OW_FF1), 0, inp(F, 20) + l * D, scr, r / 128, r % 128, lane); continue; } r -= I_FF1;
        tr_item(inp(F, 22) + (size_t)l * FF * D, D, FF, 0, wlay(F, l, OW_FF2), 0, nullptr, scr, r / 32, r % 32, lane);
    }
    for (int it = gw; it < DEPTH * 256 * 16; it += NGW) {
        const int l = it / 4096, r = it % 4096, cp = r / 16, n = (r % 16) * 64 + lane, g = cp >> 6;
        const float* pw = inp(F, 5) + ((size_t)l * 256 + cp) * 64; const float* ps = inp(F, 6) + l * 256 + g * 64; const float* wa = inp(F, 10) + ((size_t)l * 256 + g * 64) * D + n;
        float a = 0.f;
#pragma unroll 8
        for (int d = 0; d < 64; ++d) a += pw[d] * ps[d] * wa[(size_t)d * D];
        wlay(F, l, OW_A)[(size_t)n * 256 + cp] = (bf16)f2bf(a);
    }
    for (int it = gw; it < DEPTH * BATCH * MEMLEN; it += NGW) {
        const int l = it / (BATCH * MEMLEN), m = it % (BATCH * MEMLEN);
        const GAS f32x4* xr = (const GAS f32x4*)(inp(F, 1) + (size_t)m * D) + lane; const GAS f32x4* gr = (const GAS f32x4*)(inp(F, 16) + l * D) + lane;
        f32x4 v[4]; float s = 0.f;
#pragma unroll
        for (int j = 0; j < 4; ++j) { v[j] = xr[64 * j]; s += (v[j].x * v[j].x + v[j].y * v[j].y) + (v[j].z * v[j].z + v[j].w * v[j].w); }
        const float rstd = 1.0f / sqrtf(wave_sum(s) * (1.f / D) + EPSF);
        GAS unsigned long long* o8 = (GAS unsigned long long*)(wsb(F, WS_HM) + ((size_t)l * BATCH * MEMLEN + m) * D) + lane;
#pragma unroll
        for (int j = 0; j < 4; ++j) { const f32x4 g = gr[64 * j]; o8[64 * j] = (unsigned long long)pk2(v[j].x * rstd * g.x, v[j].y * rstd * g.y) | ((unsigned long long)pk2(v[j].z * rstd * g.z, v[j].w * rstd * g.w) << 32); }
    }
    for (int m = gw; m < TOK; m += NGW) {
        const GAS f32x4* xr = (const GAS f32x4*)(inp(F, 0) + (size_t)m * D) + lane;
        f32x4 v[4]; float s = 0.f;
#pragma unroll
        for (int j = 0; j < 4; ++j) { v[j] = xr[64 * j]; s += (v[j].x * v[j].x + v[j].y * v[j].y) + (v[j].z * v[j].z + v[j].w * v[j].w); }
        s = wave_sum(s);
        GAS unsigned long long* o8 = (GAS unsigned long long*)(wsb(F, WS_XB) + (size_t)m * D) + lane;
#pragma unroll
        for (int j = 0; j < 4; ++j) o8[64 * j] = (unsigned long long)pk2(v[j].x, v[j].y) | ((unsigned long long)pk2(v[j].z, v[j].w) << 32);
        if (lane < 16) ((float*)(F.ws + WS_SS))[(size_t)m * 16 + lane] = lane == 0 ? s : 0.f;
    }
}

__device__ __forceinline__ float row_rstd(const Frame& F, int row) {
    const f32x4* p = (const f32x4*)((const float*)(F.ws + WS_SS) + (size_t)row * 16);
    const f32x4 a = p[0], b = p[1], c = p[2], d = p[3];
    const float s = ((a[0] + a[1]) + (a[2] + a[3])) + ((b[0] + b[1]) + (b[2] + b[3])) + ((c[0] + c[1]) + (c[2] + c[3])) + ((d[0] + d[1]) + (d[2] + d[3]));
    return 1.0f / sqrtf(s * (1.f / D) + EPSF);
}

__device__ __forceinline__ void logf_pass(Frame& F, int l) {
    const int gw = F.vcu * NWAVES + F.wave, NGW = F.G * NWAVES, lane = F.lane;
    LAS float* WF = (LAS float*)(F.lds + RING_OFF);
    {
        const float* w_in = inp(F, 3) + (size_t)l * D * N_IN; const float* g = inp(F, 2) + l * D;
#pragma unroll
        for (int i = 0; i < 2; ++i) { const int k = F.tid + 512 * i; const float gk = g[k]; const float* p = w_in + (size_t)k * N_IN + OFF_F;
            const f32x4 a = *(const f32x4*)p * gk, b = *(const f32x4*)(p + 4) * gk;
            LAS f32x4* dst = (LAS f32x4*)(WF + (k >> 4) * 132 + (k & 15) * 8); dst[0] = a; dst[1] = b; }
    }
    LDS_WAIT(); __syncthreads();
    const float bfl = (lane < 8) ? (inp(F, 4) + l * 8)[lane] : 0.f;
    float* LOGF = (float*)(F.ws + WS_LOGF);
    const LAS f32x4* wl = (const LAS f32x4*)(WF + lane * 132);
    for (int m = gw; m < TOK; m += NGW) {
        const v4u* xp = (const v4u*)(wsb(F, WS_XB) + (size_t)m * D + 16 * lane);
        const v4u x0 = xp[0], x1 = xp[1];
        float xv[16];
        xv[0] = __uint_as_float(x0.x << 16); xv[1] = __uint_as_float(x0.x & 0xffff0000u); xv[2] = __uint_as_float(x0.y << 16); xv[3] = __uint_as_float(x0.y & 0xffff0000u);
        xv[4] = __uint_as_float(x0.z << 16); xv[5] = __uint_as_float(x0.z & 0xffff0000u); xv[6] = __uint_as_float(x0.w << 16); xv[7] = __uint_as_float(x0.w & 0xffff0000u);
        xv[8] = __uint_as_float(x1.x << 16); xv[9] = __uint_as_float(x1.x & 0xffff0000u); xv[10] = __uint_as_float(x1.y << 16); xv[11] = __uint_as_float(x1.y & 0xffff0000u);
        xv[12] = __uint_as_float(x1.z << 16); xv[13] = __uint_as_float(x1.z & 0xffff0000u); xv[14] = __uint_as_float(x1.w << 16); xv[15] = __uint_as_float(x1.w & 0xffff0000u);
        f32x4 a0 = (f32x4){0.f, 0.f, 0.f, 0.f}, a1 = a0;
#pragma unroll
        for (int j = 0; j < 16; ++j) { a0 += wl[2 * j] * xv[j]; a1 += wl[2 * j + 1] * xv[j]; }
        float d[8] = {a0[0], a0[1], a0[2], a0[3], a1[0], a1[1], a1[2], a1[3]};
#pragma unroll
        for (int h = 0; h < 8; ++h) d[h] = wave_sum(d[h]);
        const float rstd = row_rstd(F, m);
        if (lane < 8) {
            float dv = d[0];
#pragma unroll
            for (int h = 1; h < 8; ++h) dv = (lane == h) ? d[h] : dv;
            const float z = dv * rstd + bfl;
            const float ls = fminf(z, 0.f) - 0.6931471805599453f * __builtin_amdgcn_logf(1.0f + __builtin_amdgcn_exp2f(-LOG2E * fabsf(z)));
            LOGF[((size_t)(m / SEQ) * 8 + lane) * SEQ + (m % SEQ)] = ls;
        }
    }
    LDS_WAIT(); __syncthreads();
}

__device__ __forceinline__ void cumsum_bias(Frame& F, int bh, LAS float* nb, LAS float* scr) {
    const f32x4 v = *((const f32x4*)((const float*)(F.ws + WS_LOGF) + (size_t)bh * SEQ) + F.tid);
    const float p0 = v[0], p1 = p0 + v[1], p2 = p1 + v[2], p3 = p2 + v[3];
    const float incl = wave_scan(p3);
    if (F.lane == 63) scr[F.wave] = incl;
    LDS_WAIT(); __syncthreads();
    float woff = 0.f;
#pragma unroll
    for (int w = 0; w < 8; ++w) woff += (w < F.wave) ? scr[w] : 0.f;
    const float base = woff + (incl - p3);
    *((LAS f32x4*)nb + F.tid) = (f32x4){-(base + p0) * LOG2E, -(base + p1) * LOG2E, -(base + p2) * LOG2E, -(base + p3) * LOG2E};
    LDS_WAIT(); __syncthreads();
}

__device__ __forceinline__ void pool_diff(Frame& F) {
    const bf16* PA = wsb(F, WS_PA); bf16* DD = wsb(F, WS_DD);
    for (int j = 0; j < 4; ++j) {
        const int item = F.tid + 512 * j, row = 64 * F.vcu + (item >> 5), ch = item & 31, g = ch >> 3, win = 2 << g, tl = row & (SEQ - 1);
        const int n = (tl + 1 < win) ? tl + 1 : win;
        float s[8] = {0.f, 0.f, 0.f, 0.f, 0.f, 0.f, 0.f, 0.f}; v4u cur = (v4u){0u, 0u, 0u, 0u};
        for (int k = 0; k < n; ++k) { const v4u w = *(const v4u*)(PA + (size_t)(row - k) * 256 + 8 * ch); if (k == 0) cur = w;
            s[0] += __uint_as_float(w.x << 16); s[1] += __uint_as_float(w.x & 0xffff0000u); s[2] += __uint_as_float(w.y << 16); s[3] += __uint_as_float(w.y & 0xffff0000u);
            s[4] += __uint_as_float(w.z << 16); s[5] += __uint_as_float(w.z & 0xffff0000u); s[6] += __uint_as_float(w.w << 16); s[7] += __uint_as_float(w.w & 0xffff0000u); }
        const float inv = 1.0f / (float)n;
        v4u o;
        o.x = pk2(s[0] * inv - __uint_as_float(cur.x << 16), s[1] * inv - __uint_as_float(cur.x & 0xffff0000u));
        o.y = pk2(s[2] * inv - __uint_as_float(cur.y << 16), s[3] * inv - __uint_as_float(cur.y & 0xffff0000u));
        o.z = pk2(s[4] * inv - __uint_as_float(cur.z << 16), s[5] * inv - __uint_as_float(cur.z & 0xffff0000u));
        o.w = pk2(s[6] * inv - __uint_as_float(cur.w << 16), s[7] * inv - __uint_as_float(cur.w & 0xffff0000u));
        *(v4u*)(DD + (size_t)row * 256 + 8 * ch) = o;
    }
}

__device__ __forceinline__ void sgu_unit(Frame& F, int l, int unit) {
    const int chunk = unit >> 2, g = unit & 3, row0 = chunk * 128, lane = F.lane, w = F.wave;
    const bf16* ZC = wsb(F, WS_ZC); bf16* SG = wsb(F, WS_SG);
    LAS bf16* vnT = (LAS bf16*)(F.lds + RING_OFF);
    const float* gain = inp(F, 7) + l * 256;
    const float g0 = gain[4 * lane], g1 = gain[4 * lane + 1], g2 = gain[4 * lane + 2], g3 = gain[4 * lane + 3];
    for (int i = 0; i < 16; ++i) {
        const int s = 16 * w + i;
        const unsigned long long q = *(const unsigned long long*)(ZC + (size_t)(row0 + s) * 512 + 256 + 4 * lane);
        const unsigned lo = (unsigned)q, hi = (unsigned)(q >> 32);
        const float v0 = __uint_as_float(lo << 16), v1 = __uint_as_float(lo & 0xffff0000u), v2 = __uint_as_float(hi << 16), v3 = __uint_as_float(hi & 0xffff0000u);
        const float ss = wave_sum((v0 * v0 + v1 * v1) + (v2 * v2 + v3 * v3));
        const float r = 1.0f / sqrtf(ss * (1.f / 256.f) + EPSF);
        if ((lane >> 4) == g) { const int d = 4 * (lane & 15);
            vnT[(d + 0) * 136 + s] = (bf16)f2bf(v0 * r * g0); vnT[(d + 1) * 136 + s] = (bf16)f2bf(v1 * r * g1); vnT[(d + 2) * 136 + s] = (bf16)f2bf(v2 * r * g2); vnT[(d + 3) * 136 + s] = (bf16)f2bf(v3 * r * g3); }
    }
    LDS_WAIT(); __syncthreads();
    const float* Wg = inp(F, 8) + ((size_t)(l * 4 + g) * 128) * 128;
    const int t = 16 * w + (lane & 15), kq = lane >> 4;
    f32x4 acc[4];
#pragma unroll
    for (int n = 0; n < 4; ++n) acc[n] = (f32x4){0.f, 0.f, 0.f, 0.f};
#pragma unroll
    for (int kk = 0; kk < 4; ++kk) {
        if (32 * kk <= 16 * w + 15) {
            const int s0 = 32 * kk + 8 * kq;
            const f32x4 wa = *(const f32x4*)(Wg + (size_t)t * 128 + s0), wb = *(const f32x4*)(Wg + (size_t)t * 128 + s0 + 4);
            float wv[8] = {wa[0], wa[1], wa[2], wa[3], wb[0], wb[1], wb[2], wb[3]};
#pragma unroll
            for (int j = 0; j < 8; ++j) wv[j] = (s0 + j <= t) ? wv[j] : 0.f;
            v4u bw; bw.x = pk2(wv[0], wv[1]); bw.y = pk2(wv[2], wv[3]); bw.z = pk2(wv[4], wv[5]); bw.w = pk2(wv[6], wv[7]);
            const bf16x8 bfrag = __builtin_bit_cast(bf16x8, bw);
#pragma unroll
            for (int n = 0; n < 4; ++n) { const bf16x8 afrag = *(const LAS bf16x8*)(vnT + (16 * n + (lane & 15)) * 136 + s0);
                acc[n] = __builtin_amdgcn_mfma_f32_16x16x32_bf16(afrag, bfrag, acc[n], 0, 0, 0); }
        }
    }
    const float bt = inp(F, 9)[(l * 4 + g) * 128 + t];
#pragma unroll
    for (int n = 0; n < 4; ++n) { const int d = 64 * g + 16 * n + 4 * kq;
        const unsigned long long q = *(const unsigned long long*)(ZC + (size_t)(row0 + t) * 512 + d);
        const unsigned lo = (unsigned)q, hi = (unsigned)(q >> 32);
        const float o0 = __uint_as_float(lo << 16) * (acc[n][0] + bt), o1 = __uint_as_float(lo & 0xffff0000u) * (acc[n][1] + bt), o2 = __uint_as_float(hi << 16) * (acc[n][2] + bt), o3 = __uint_as_float(hi & 0xffff0000u) * (acc[n][3] + bt);
        *(unsigned long long*)(SG + (size_t)(row0 + t) * 256 + d) = (unsigned long long)pk2(o0, o1) | ((unsigned long long)pk2(o2, o3) << 32); }
    LDS_WAIT(); __syncthreads();
}

__device__ __forceinline__ void final_norm(Frame& F) {
    const int gw = F.vcu * NWAVES + F.wave, NGW = F.G * NWAVES, lane = F.lane;
    const GAS f32x4* gr = (const GAS f32x4*)inp(F, 23) + lane;
    for (int m = gw; m < TOK; m += NGW) {
        const float rstd = row_rstd(F, m);
        GAS f32x4* xr = (GAS f32x4*)(F.out + (size_t)m * D) + lane;
#pragma unroll
        for (int j = 0; j < 4; ++j) { const f32x4 v = xr[64 * j]; xr[64 * j] = v * rstd * gr[64 * j]; }
    }
}

struct Args { const float* in[24]; float* out; unsigned char* ws; };
__global__ void __launch_bounds__(NWAVES * 64, 2) mega_fwd(Args args) {
    extern __shared__ __attribute__((aligned(16))) unsigned char lds[];
    Frame F;
    F.lds = (LAS unsigned char*)lds;
    F.MISC = (volatile LAS unsigned*)(F.lds + MISC_OFF);
    int c = 0;
#define REFRESH() do { int t_ = threadIdx.x, b_ = blockIdx.x; asm volatile("" : "+v"(t_)); asm volatile("" : "+s"(b_)); F.tid = t_; F.lane = t_ & 63; F.wave = __builtin_amdgcn_readfirstlane(t_ >> 6); \
        F.G = NCU; F.vcu = (b_ % 8) * (NCU / 8) + b_ / 8; c = b_; \
        unsigned lb_ = (unsigned)(uintptr_t)(LAS unsigned char*)lds; asm volatile("" : "+s"(lb_)); F.lds = (LAS unsigned char*)(uintptr_t)lb_; F.MISC = (volatile LAS unsigned*)(F.lds + MISC_OFF); } while (0)
    REFRESH();
    F.ws = args.ws; F.out = args.out; F.ctl = (gu32*)(args.ws + WS_CTL);
    for (int u = F.tid; u < (LDS_BYTES - LDSCTL_OFF) / 4; u += NWAVES * 64) ((LAS unsigned*)(F.lds + LDSCTL_OFF))[u] = 0u;
    __syncthreads();
    if (F.tid < 24) *(LAS unsigned long long*)(F.lds + PTRS_OFF + 8 * F.tid) = (unsigned long long)args.in[F.tid];
    LDS_WAIT(); __syncthreads();
    XcdBarrier bar = xcd_barrier_post((unsigned*)(F.ctl + CW_BAR), F.MISC + 8);
#define GRID_BAR() xcd_barrier(bar)
    float* SS = (float*)(F.ws + WS_SS);

    p0_prologue(F);
    GRID_BAR();
    REFRESH();
    for (int l = 0; l < DEPTH; ++l) {
        bf16* xk = wsb(F, l == 0 ? WS_XKV0 : WS_XKV1); bf16* xvt = xk + (size_t)BATCH * 4 * 65536;
        const bf16* hm = wsb(F, WS_HM) + (size_t)l * BATCH * MEMLEN * D;
        { pg8::GemmP g{hm, wlay(F, l, OW_XKV), D, D, D}; pg8::StaticOrder S; S.init(BATCH * MEMLEN, D, F.G, c); pg8::EpiTile E{xk, 4, 1};
          pg8::gemm_phase<pg8::EpiTile, pg8::StaticOrder, pg8::GemmP, true, true>(F.lds + RING_OFF, g, S, E); }
        { pg8::GemmP g{wlay(F, l, OW_XKV) + (size_t)D * D, hm, D, D, D}; pg8::StaticOrder S; S.init(D, BATCH * MEMLEN, F.G, c); pg8::EpiTile E{xvt, 1, 4};
          pg8::gemm_phase<pg8::EpiTile, pg8::StaticOrder, pg8::GemmP, true, true>(F.lds + RING_OFF, g, S, E); }
    }
    for (int l = 0; l < DEPTH; ++l) {
        const float* xres = (l == 0) ? inp(F, 0) : F.out;
        REFRESH();
        logf_pass(F, l);
        { pg8::GemmP g{wsb(F, WS_XB), wlay(F, l, OW_IN), D, D, D}; pg8::StaticOrder S; S.init(TOK, 2304, F.G, c);
          pg8::EpiProj E{wsb(F, WS_PA), wsb(F, WS_Q), wsb(F, WS_K), wsb(F, WS_V), wsb(F, WS_ZC), SS, attn_body::C2};
          pg8::gemm_phase<pg8::EpiProj, pg8::StaticOrder, pg8::GemmP, true, true>(F.lds + RING_OFF, g, S, E); }
        GRID_BAR();
        REFRESH();
        {
            const int bh = F.vcu >> 2, s4 = F.vcu & 3;
            LAS float* nb = (LAS float*)(F.lds + RING_OFF + attn_body::LDS_NB);
            cumsum_bias(F, bh, nb, (LAS float*)(F.lds + RING_OFF + attn_body::LDS_NB + 8192));
            attn_body::attn_unit<8>(bh >> 3, bh & 7, 7 - s4, (const attn_body::bf16*)wsb(F, WS_Q), (const attn_body::bf16*)wsb(F, WS_K), (const attn_body::bf16*)wsb(F, WS_V), (attn_body::bf16*)wsb(F, WS_Q), (char*)F.lds + RING_OFF);
            attn_body::attn_unit<8>(bh >> 3, bh & 7, s4, (const attn_body::bf16*)wsb(F, WS_Q), (const attn_body::bf16*)wsb(F, WS_K), (const attn_body::bf16*)wsb(F, WS_V), (attn_body::bf16*)wsb(F, WS_Q), (char*)F.lds + RING_OFF);
            pool_diff(F);
            sgu_unit(F, l, 2 * F.vcu); sgu_unit(F, l, 2 * F.vcu + 1);
        }
        GRID_BAR();
        REFRESH();
        {
            pg8::StaticOrder S; S.init(TOK, D, F.G, c);
            const float* bg = inp(F, 13) + (size_t)l * 3 * D;
            { pg8::GemmP g{wsb(F, WS_DD), wlay(F, l, OW_A), 256, 256, 256}; pg8::EpiStore<0, false, false> E{wsb(F, WS_T2), D, nullptr, 1.f};
              pg8::gemm_phase<pg8::EpiStore<0, false, false>, pg8::StaticOrder, pg8::GemmP, true, true>(F.lds + RING_OFF, g, S, E); }
            { pg8::GemmP g{wsb(F, WS_XB), wlay(F, l, OW_G), D, D, D}; pg8::EpiGate<true> E{wsb(F, WS_T2), wsb(F, WS_MG), bg, SS};
              pg8::gemm_phase<pg8::EpiGate<true>, pg8::StaticOrder, pg8::GemmP, true, true>(F.lds + RING_OFF, g, S, E); }
            { pg8::GemmP g{wsb(F, WS_Q), wlay(F, l, OW_B), 512, 512, 512}; pg8::EpiStore<0, false, false> E{wsb(F, WS_T2), D, nullptr, 1.f};
              pg8::gemm_phase<pg8::EpiStore<0, false, false>, pg8::StaticOrder, pg8::GemmP, true, true>(F.lds + RING_OFF, g, S, E); }
            { pg8::GemmP g{wsb(F, WS_XB), wlay(F, l, OW_G) + (size_t)D * D, D, D, D}; pg8::EpiGate<false> E{wsb(F, WS_T2), wsb(F, WS_MG), bg + D, SS};
              pg8::gemm_phase<pg8::EpiGate<false>, pg8::StaticOrder, pg8::GemmP, true, true>(F.lds + RING_OFF, g, S, E); }
            { pg8::GemmP g{wsb(F, WS_SG), wlay(F, l, OW_C), 256, 256, 256}; pg8::EpiStore<0, false, false> E{wsb(F, WS_T2), D, nullptr, 1.f};
              pg8::gemm_phase<pg8::EpiStore<0, false, false>, pg8::StaticOrder, pg8::GemmP, true, true>(F.lds + RING_OFF, g, S, E); }
            { pg8::GemmP g{wsb(F, WS_XB), wlay(F, l, OW_G) + (size_t)2 * D * D, D, D, D}; pg8::EpiGate<false> E{wsb(F, WS_T2), wsb(F, WS_MG), bg + 2 * D, SS};
              pg8::gemm_phase<pg8::EpiGate<false>, pg8::StaticOrder, pg8::GemmP, true, true>(F.lds + RING_OFF, g, S, E); }
        }
        GRID_BAR();
        REFRESH();
        { pg8::GemmP g{wsb(F, WS_MG), wlay(F, l, OW_OUT), D, D, D}; pg8::StaticOrder S; S.init(TOK, D, F.G, c); pg8::EpiRes E{xres, F.out, wsb(F, WS_XB), SS};
          pg8::gemm_phase<pg8::EpiRes, pg8::StaticOrder, pg8::GemmP, true, true>(F.lds + RING_OFF, g, S, E); }
        GRID_BAR();
        REFRESH();
        {
            pg8::StaticOrder S; S.init(TOK, D, F.G, c);
            const bf16* xk = wsb(F, l == 0 ? WS_XKV0 : WS_XKV1); const bf16* xvt = xk + (size_t)BATCH * 4 * 65536;
            { pg8::GemmP g{wsb(F, WS_XB), wlay(F, l, OW_XQ), D, D, D}; pg8::EpiStore<0, true, true> E{wsb(F, WS_XQH), 256, SS, 0.0625f * LOG2E};
              pg8::gemm_phase<pg8::EpiStore<0, true, true>, pg8::StaticOrder, pg8::GemmP, true, true>(F.lds + RING_OFF, g, S, E); }
            { pg8::GemmX g{wsb(F, WS_XQH), xk, 256, 256, 256}; pg8::EpiSoftmax E{wsb(F, WS_PP)};
              pg8::gemm_phase<pg8::EpiSoftmax, pg8::StaticOrder, pg8::GemmX, false, true>(F.lds + RING_OFF, g, S, E); }
            { pg8::GemmX g{wsb(F, WS_PP), xvt, 256, 256, 256}; pg8::EpiStore<0, false, false> E{wsb(F, WS_XO), D, nullptr, 1.f};
              pg8::gemm_phase<pg8::EpiStore<0, false, false>, pg8::StaticOrder, pg8::GemmX, true, true>(F.lds + RING_OFF, g, S, E); }
        }
        GRID_BAR();
        REFRESH();
        { pg8::GemmP g{wsb(F, WS_XO), wlay(F, l, OW_XO), D, D, D}; pg8::StaticOrder S; S.init(TOK, D, F.G, c); pg8::EpiRes E{F.out, F.out, wsb(F, WS_XB), SS};
          pg8::gemm_phase<pg8::EpiRes, pg8::StaticOrder, pg8::GemmP, true, true>(F.lds + RING_OFF, g, S, E); }
        GRID_BAR();
        REFRESH();
        { pg8::GemmP g{wsb(F, WS_XB), wlay(F, l, OW_FF1), D, D, D}; pg8::StaticOrder S; S.init(TOK, FF, F.G, c); pg8::EpiStore<1, true, false> E{wsb(F, WS_FFH), FF, SS, 1.f};
          pg8::gemm_phase<pg8::EpiStore<1, true, false>, pg8::StaticOrder, pg8::GemmP, true, true>(F.lds + RING_OFF, g, S, E); }
        GRID_BAR();
        REFRESH();
        { pg8::GemmP g{wsb(F, WS_FFH), wlay(F, l, OW_FF2), FF, FF, FF}; pg8::StaticOrder S; S.init(TOK, D, F.G, c); pg8::EpiRes E{F.out, F.out, wsb(F, WS_XB), SS};
          pg8::gemm_phase<pg8::EpiRes, pg8::StaticOrder, pg8::GemmP, true, true>(F.lds + RING_OFF, g, S, E); }
        GRID_BAR();
    }
    REFRESH();
    final_norm(F);
    if (__hip_atomic_load((gu32*)((unsigned*)(F.ctl + CW_BAR) + XB_TMO), RLX_AGENT) != 0u && blockIdx.x == 0 && F.tid < 64) F.out[F.tid] = __builtin_nanf("");
}

extern "C" void kernel_launch(void* const* d_in, const int* in_sizes, int n_in, void* d_out, int out_size, void* d_ws, size_t ws_size, hipStream_t stream) {
    static int grid = 0;
    if (grid == 0) {
        if (n_in != 24 || out_size != TOK * D || ws_size < WS_END) { fprintf(stderr, "kernel_launch: unexpected problem shape (n_in %d, out %d, ws %zu); nothing launched\n", n_in, out_size, ws_size); grid = -1; return; }
        int dev = 0, cus = 0;
        if (hipGetDevice(&dev) != hipSuccess || hipDeviceGetAttribute(&cus, hipDeviceAttributeMultiprocessorCount, dev) != hipSuccess) { grid = -1; return; }
        if (hipFuncSetAttribute((const void*)mega_fwd, hipFuncAttributeMaxDynamicSharedMemorySize, LDS_BYTES) != hipSuccess) { fprintf(stderr, "kernel_launch: hipFuncSetAttribute failed\n"); grid = -1; return; }
        int per_cu = 0;
        if (hipOccupancyMaxActiveBlocksPerMultiprocessor(&per_cu, (const void*)mega_fwd, NWAVES * 64, LDS_BYTES) != hipSuccess || per_cu < 1) fprintf(stderr, "kernel_launch: occupancy query reports %d workgroups per CU\n", per_cu);
        (void)hipGetLastError();
        if (cus != 256) fprintf(stderr, "kernel_launch: built for a 256-CU device, found %d CUs\n", cus);
        grid = NCU;
    }
    if (grid < 0) return;
    (void)in_sizes;
    if (hipMemsetAsync((char*)d_ws + WS_CTL, 0, CTL_ZERO_BYTES, stream) != hipSuccess) return;
    Args a{};
    for (int i = 0; i < 24; ++i) a.in[i] = (const float*)d_in[i];
    a.out = (float*)d_out; a.ws = (unsigned char*)d_ws;
    hipLaunchKernelGGL(mega_fwd, dim3(grid), dim3(NWAVES * 64), LDS_BYTES, stream, a);
}
```

```cpp
#include <hip/hip_runtime.h>
#include <cstdio>
#include <cstdint>
namespace pg8 {
#define PG8_LAS __attribute__((address_space(3)))
typedef unsigned short bf16_t;
typedef short bf16x8 __attribute__((ext_vector_type(8)));
typedef float f32x4 __attribute__((ext_vector_type(4)));
typedef unsigned u32x4 __attribute__((ext_vector_type(4)));
constexpr int BM = 256, BK = 64, HALF = 128, HTB = HALF * BK * 2  , STAGE_BYTES = 8 * HTB, NXCD = 8, WGM = 8;

__host__ __device__ __forceinline__ int lds_byte(int r, int c) { const int st = (r >> 4) * 2 + (c >> 5), rr = r & 15, cc = c & 31, ob = rr * 64 + cc * 2; return st * 1024 + (ob ^ (((ob >> 9) & 1) << 5)); }
__host__ __device__ __forceinline__ void stage_rc(int b, int& R, int& C) { const int st = b / 1024, sb = b % 1024, swz = sb ^ (((sb >> 9) & 1) << 5); R = (st >> 1) * 16 + swz / 64; C = (st & 1) * 32 + (swz % 64) / 2; }
__host__ __device__ __forceinline__ int perm32(int rho) { const int n = rho >> 4, i = rho & 15; return 8 * (i >> 2) + 4 * n + (i & 3); }

struct Unit { int pm, pn; };

struct StaticOrder {
    int nM, nN, nwg, G, c;
    __host__ __device__ void init(int M, int N, int G_, int c_) { nM = M / BM; nN = N / BM; nwg = nM * nN; G = G_; c = c_; }
    __host__ __device__ bool next(int i, Unit& u) const {
        const long L = (long)i * G + c; if (L >= nwg) return false;
        int wgid = (int)L; { const int q = nwg / NXCD, r = nwg % NXCD, xcd = wgid % NXCD, off = wgid / NXCD; wgid = (xcd < r ? xcd * (q + 1) : r * (q + 1) + (xcd - r) * q) + off; }
        const int nig = WGM * nN, gid = wgid / nig, fm = gid * WGM, gsz = (nM - fm) < WGM ? (nM - fm) : WGM;
        u.pm = fm + ((wgid % nig) % gsz); u.pn = (wgid % nig) / gsz; return true;
    }
    __device__ __forceinline__ void a_ready(const Unit&) const {}
    __device__ __forceinline__ void done(const Unit&) const {}
};
__device__ __forceinline__ unsigned cvt_pk_bf16(float lo, float hi) { unsigned r; asm volatile("v_cvt_pk_bf16_f32 %0, %1, %2" : "=v"(r) : "v"(lo), "v"(hi)); return r; }
template <class Epi, class Sched, class G, bool ALIGN_EPI = false, bool SP2 = false>
__device__ __forceinline__ void gemm_phase(PG8_LAS unsigned char* lds, const G g, const Sched& S, const Epi& E) {
    int tid_ = threadIdx.x; asm volatile("" : "+v"(tid_));
    const int tid = tid_, wid = __builtin_amdgcn_readfirstlane(tid >> 6), lane = tid & 63, wr = wid >> 2, wc = wid & 3, fr = lane & 15, fq = lane >> 4;
    const int K = g.K, nt = K / BK;
    unsigned voffA[2], voffB[2];
#pragma unroll
    for (int i = 0; i < 2; ++i) { int R, C; stage_rc(tid * 16 + i * 8192, R, C); const int Rb = Epi::PERM ? ((R & ~31) + perm32(R & 31)) : R;
        voffA[i] = (unsigned)(R * g.lda + C) * 2u; voffB[i] = (unsigned)(Rb * g.ldb + C) * 2u; }
    const size_t kstep = (size_t)(BK * 2);
    const size_t hstepA = (size_t)HALF * g.lda * 2, hstepB = (size_t)HALF * g.ldb * 2;
    const unsigned ldsw = (unsigned)wid * 1024u;
    const int aoff = lds_byte(wr * 64 + fr, fq * 8), boff = lds_byte(wc * 32 + fr, fq * 8);
#define PG8_SA(b, h) (((b) * 2 + (h)) * HTB)
#define PG8_SB(b, h) ((4 + (b) * 2 + (h)) * HTB)
#define PG8_STAGE(bufoff, gbase, voff) do { _Pragma("unroll") for (int _i = 0; _i < 2; ++_i) \
        __builtin_amdgcn_global_load_lds((const unsigned*)((const char*)(gbase) + (voff)[_i]), (PG8_LAS unsigned*)(lds + (bufoff) + ldsw + _i * 8192), 16, 0, 0); } while (0)
#define PG8_LDA(dst, b, h) do { _Pragma("unroll") for (int m = 0; m < 4; ++m) _Pragma("unroll") for (int k = 0; k < 2; ++k) dst[m][k] = *(const PG8_LAS bf16x8*)(lds + PG8_SA(b, h) + aoff + m * 2048 + k * 1024); } while (0)
#define PG8_LDB(dst, b, h) do { _Pragma("unroll") for (int n = 0; n < 2; ++n) _Pragma("unroll") for (int k = 0; k < 2; ++k) dst[n][k] = *(const PG8_LAS bf16x8*)(lds + PG8_SB(b, h) + boff + n * 2048 + k * 1024); } while (0)
#define PG8_MMA(ai, bj, At, Bt) do { __builtin_amdgcn_s_setprio(1); _Pragma("unroll") for (int m = 0; m < 4; ++m) _Pragma("unroll") for (int n = 0; n < 2; ++n) _Pragma("unroll") for (int k = 0; k < 2; ++k) \
        acc[ai][bj][m][n] = __builtin_amdgcn_mfma_f32_16x16x32_bf16(Bt[n][k], At[m][k], acc[ai][bj][m][n], 0, 0, 0); __builtin_amdgcn_s_setprio(0); } while (0)
#define PG8_WAIT_V(n) asm volatile("s_waitcnt vmcnt(" #n ")" ::: "memory")
#define PG8_WAIT_L(n) asm volatile("s_waitcnt lgkmcnt(" #n ")" ::: "memory")
#define PG8_BAR __builtin_amdgcn_s_barrier()
#define PG8_SCHED __builtin_amdgcn_sched_barrier(0)
    Unit cur, nxt; int ui = 0;
    if (!S.next(0, cur)) return;
    f32x4 acc[2][2][4][2];
#pragma unroll
    for (int a = 0; a < 2; ++a)
#pragma unroll
        for (int b = 0; b < 2; ++b)
#pragma unroll
            for (int m = 0; m < 4; ++m)
#pragma unroll
                for (int n = 0; n < 2; ++n) acc[a][b][m][n] = (f32x4){0.f, 0.f, 0.f, 0.f};
    bf16x8 At[4][2], B0[2][2], B1[2][2];
    const char* cA = g.a_ptr(cur); const char* cB = g.b_ptr(cur);
    S.a_ready(cur);
    if constexpr (SP2) {
        PG8_STAGE(PG8_SB(0, 0), cB, voffB); PG8_STAGE(PG8_SB(0, 1), cB + hstepB, voffB); PG8_STAGE(PG8_SA(0, 0), cA, voffA); PG8_STAGE(PG8_SA(0, 1), cA + hstepA, voffA);
        if (wr == 1) PG8_BAR;
        PG8_WAIT_V(2); PG8_BAR;
        PG8_STAGE(PG8_SB(1, 0), cB + kstep, voffB); PG8_STAGE(PG8_SA(1, 0), cA + kstep, voffA); PG8_STAGE(PG8_SB(1, 1), cB + hstepB + kstep, voffB);
        PG8_WAIT_V(6); PG8_BAR;
    } else {
        PG8_STAGE(PG8_SB(0, 0), cB, voffB); PG8_STAGE(PG8_SA(0, 0), cA, voffA); PG8_STAGE(PG8_SB(0, 1), cB + hstepB, voffB); PG8_STAGE(PG8_SA(0, 1), cA + hstepA, voffA);
        if (wr == 1) PG8_BAR;
        PG8_WAIT_V(4); PG8_BAR;
        PG8_STAGE(PG8_SB(1, 0), cB + kstep, voffB); PG8_STAGE(PG8_SA(1, 0), cA + kstep, voffA); PG8_STAGE(PG8_SB(1, 1), cB + hstepB + kstep, voffB);
        PG8_WAIT_V(6); PG8_BAR;
    }
    for (;;) {
        const bool has_next = S.next(ui + 1, nxt);
        const char* nA = has_next ? g.a_ptr(nxt) : cA; const char* nB = has_next ? g.b_ptr(nxt) : cB;
        for (int t = 0; t < nt; t += 2) {
            const bool last = (t == nt - 2);
            const char* a1 = cA + (size_t)(t + 1) * kstep;
            const char* a2 = last ? nA : cA + (size_t)(t + 2) * kstep; const char* b2 = last ? nB : cB + (size_t)(t + 2) * kstep;
            const char* a3 = a2 + kstep; const char* b3 = b2 + kstep;
            if (last && has_next) S.a_ready(nxt);
            if constexpr (SP2) {
            PG8_LDB(B0, 0, 0); PG8_LDB(B1, 0, 1); PG8_SCHED; PG8_LDA(At, 0, 0); PG8_STAGE(PG8_SA(1, 1), a1 + hstepA, voffA);
            PG8_WAIT_V(8); PG8_WAIT_L(0); PG8_BAR; PG8_MMA(0, 0, At, B0); PG8_MMA(0, 1, At, B1); PG8_BAR; PG8_SCHED;
            PG8_LDA(At, 0, 1); PG8_STAGE(PG8_SB(0, 0), b2, voffB); PG8_STAGE(PG8_SB(0, 1), b2 + hstepB, voffB); PG8_STAGE(PG8_SA(0, 0), a2, voffA);
            PG8_WAIT_V(8); PG8_WAIT_L(0); PG8_BAR; PG8_MMA(1, 0, At, B0); PG8_MMA(1, 1, At, B1); PG8_BAR; PG8_SCHED;
            PG8_LDB(B0, 1, 0); PG8_LDB(B1, 1, 1); PG8_SCHED; PG8_LDA(At, 1, 0); PG8_STAGE(PG8_SA(0, 1), a2 + hstepA, voffA);
            PG8_WAIT_V(8); PG8_WAIT_L(0); PG8_BAR; PG8_MMA(0, 0, At, B0); PG8_MMA(0, 1, At, B1); PG8_BAR; PG8_SCHED;
            PG8_LDA(At, 1, 1); PG8_STAGE(PG8_SB(1, 0), b3, voffB); PG8_STAGE(PG8_SB(1, 1), b3 + hstepB, voffB); PG8_STAGE(PG8_SA(1, 0), a3, voffA);
            PG8_WAIT_V(8); PG8_WAIT_L(0); PG8_BAR; PG8_MMA(1, 0, At, B0); PG8_MMA(1, 1, At, B1); PG8_BAR; PG8_SCHED;
            } else {
            PG8_LDB(B0, 0, 0); PG8_SCHED; PG8_LDA(At, 0, 0); PG8_STAGE(PG8_SA(1, 1), a1 + hstepA, voffA);
            PG8_WAIT_L(8); PG8_BAR; PG8_WAIT_L(0); PG8_MMA(0, 0, At, B0); PG8_BAR; PG8_SCHED;
            PG8_LDB(B1, 0, 1); PG8_STAGE(PG8_SB(0, 0), b2, voffB);
            PG8_BAR; PG8_WAIT_L(0); PG8_MMA(0, 1, At, B1); PG8_BAR;
            PG8_LDA(At, 0, 1); PG8_STAGE(PG8_SA(0, 0), a2, voffA);
            PG8_BAR; PG8_WAIT_L(0); PG8_MMA(1, 0, At, B0); PG8_BAR; PG8_SCHED;
            PG8_STAGE(PG8_SB(0, 1), b2 + hstepB, voffB);
            PG8_WAIT_V(6); PG8_BAR; PG8_MMA(1, 1, At, B1); PG8_BAR;
            PG8_LDB(B0, 1, 0); PG8_SCHED; PG8_LDA(At, 1, 0); PG8_STAGE(PG8_SA(0, 1), a2 + hstepA, voffA);
            PG8_WAIT_L(8); PG8_BAR; PG8_WAIT_L(0); PG8_MMA(0, 0, At, B0); PG8_BAR; PG8_SCHED;
            PG8_LDB(B1, 1, 1); PG8_STAGE(PG8_SB(1, 0), b3, voffB);
            PG8_BAR; PG8_WAIT_L(0); PG8_MMA(0, 1, At, B1); PG8_BAR;
            PG8_LDA(At, 1, 1); PG8_STAGE(PG8_SA(1, 0), a3, voffA);
            PG8_BAR; PG8_WAIT_L(0); PG8_MMA(1, 0, At, B0); PG8_BAR; PG8_SCHED;
            PG8_STAGE(PG8_SB(1, 1), b3 + hstepB, voffB);
            PG8_WAIT_V(6); PG8_BAR; PG8_MMA(1, 1, At, B1); PG8_BAR;
            }
        }
        if constexpr (ALIGN_EPI) { if (wr == 0) PG8_BAR; }
        if constexpr (!Epi::AFTER_DRAIN) { int te_ = threadIdx.x; asm volatile("" : "+v"(te_)); E(acc, cur, wr, wc, te_ & 15, (te_ & 63) >> 4); S.done(cur); }
        if (!has_next) break;
#pragma unroll
        for (int a = 0; a < 2; ++a)
#pragma unroll
            for (int b = 0; b < 2; ++b)
#pragma unroll
                for (int m = 0; m < 4; ++m)
#pragma unroll
                    for (int n = 0; n < 2; ++n) acc[a][b][m][n] = (f32x4){0.f, 0.f, 0.f, 0.f};
        cur = nxt; cA = nA; cB = nB; ++ui;
        if constexpr (ALIGN_EPI) { if (wr == 1) PG8_BAR; }
    }
    PG8_WAIT_V(0);
    if constexpr (!ALIGN_EPI) { if (wr == 0) PG8_BAR; }
    PG8_BAR;
    if constexpr (Epi::AFTER_DRAIN) { int te_ = threadIdx.x; asm volatile("" : "+v"(te_)); E.fused(acc, cur, wr, wc, te_ & 15, (te_ & 63) >> 4, lds, wid, te_ & 63); S.done(cur); }
#undef PG8_SA
#undef PG8_SB
#undef PG8_STAGE
#undef PG8_LDA
#undef PG8_LDB
#undef PG8_MMA
#undef PG8_WAIT_V
#undef PG8_WAIT_L
#undef PG8_BAR
#undef PG8_SCHED
}
constexpr int TOK = 16384;
constexpr float RMS_EPS = 1e-6f;
struct GemmP { const bf16_t* A; const bf16_t* Bt; int lda, ldb, K;
    __device__ __forceinline__ const char* a_ptr(const Unit& u) const { return (const char*)(A + (size_t)u.pm * BM * lda); }
    __device__ __forceinline__ const char* b_ptr(const Unit& u) const { return (const char*)(Bt + (size_t)u.pn * BM * ldb); } };
struct GemmX { const bf16_t* A; const bf16_t* Bt; int lda, ldb, K;
    __device__ __forceinline__ const char* a_ptr(const Unit& u) const { return (const char*)(A + ((size_t)u.pn * TOK + (size_t)u.pm * BM) * 256); }
    __device__ __forceinline__ const char* b_ptr(const Unit& u) const { return (const char*)(Bt + (size_t)((u.pm >> 3) * 4 + u.pn) * 65536); } };

struct GemmProj { const bf16_t* XB; const bf16_t* WIN; const bf16_t* HM; const bf16_t* WKV0; size_t wkv_lstride; int lda, ldb, K;
    __device__ __forceinline__ const char* a_ptr(const Unit& u) const {
        if (u.pn < 9) return (const char*)(XB + (size_t)u.pm * BM * 1024);
        const int idx = 2 * u.pm + (u.pn - 9), l = idx >> 6, part = (idx >> 5) & 1, b = (idx >> 2) & 7, h = idx & 3;
        return part == 0 ? (const char*)(HM + ((size_t)l * 2048 + b * 256) * 1024) : (const char*)(WKV0 + (size_t)l * wkv_lstride + (size_t)(1024 + h * 256) * 1024); }
    __device__ __forceinline__ const char* b_ptr(const Unit& u) const {
        if (u.pn < 9) return (const char*)(WIN + (size_t)u.pn * BM * 1024);
        const int idx = 2 * u.pm + (u.pn - 9), l = idx >> 6, part = (idx >> 5) & 1, b = (idx >> 2) & 7, h = idx & 3;
        return part == 0 ? (const char*)(WKV0 + (size_t)l * wkv_lstride + (size_t)(h * 256) * 1024) : (const char*)(HM + ((size_t)l * 2048 + b * 256) * 1024); } };
typedef unsigned u32x2 __attribute__((ext_vector_type(2)));
template <bool MAX> __device__ __forceinline__ float comb16(float s) { const auto r = __builtin_amdgcn_permlane16_swap(__float_as_uint(s), __float_as_uint(s), false, false);
    const float a = __uint_as_float(r[0]), b = __uint_as_float(r[1]); return MAX ? __builtin_fmaxf(a, b) : a + b; }
template <bool MAX> __device__ __forceinline__ float comb32(float s) { const auto r = __builtin_amdgcn_permlane32_swap(__float_as_uint(s), __float_as_uint(s), false, false);
    const float a = __uint_as_float(r[0]), b = __uint_as_float(r[1]); return MAX ? __builtin_fmaxf(a, b) : a + b; }
__device__ __forceinline__ float bf_lo(unsigned w) { return __uint_as_float(w << 16); }
__device__ __forceinline__ float bf_hi(unsigned w) { return __uint_as_float(w & 0xffff0000u); }
__device__ __forceinline__ float fast_sigmoid(float z) { return __builtin_amdgcn_rcpf(1.0f + __builtin_amdgcn_exp2f(-1.4426950408889634f * z)); }
__device__ __forceinline__ float gelu_tanh(float x) {
    const float u = x * (0.7978845608028654f + 0.035677408136300125f * x * x);
    return x * __builtin_amdgcn_rcpf(1.0f + __builtin_amdgcn_exp2f(-2.8853900817779268f * u)); }
__device__ __forceinline__ void load_rstd(float (&rs)[2][4], const float* SS, const Unit& u, int wr, int fr, int fq) {
#pragma unroll
    for (int ai = 0; ai < 2; ++ai)
#pragma unroll
        for (int m = 0; m < 4; ++m) { const f32x4 a = *((const f32x4*)(SS + (size_t)(u.pm * BM + ai * HALF + wr * 64 + m * 16 + fr) * 16) + fq);
            float s = (a[0] + a[1]) + (a[2] + a[3]); s = comb16<false>(s); s = comb32<false>(s);
            rs[ai][m] = __builtin_amdgcn_rsqf(s * (1.0f / 1024.0f) + RMS_EPS); }
}
struct EpiProj { static constexpr bool PERM = true, AFTER_DRAIN = false;
    bf16_t *PA, *Q, *K, *V, *ZC; const float* SS; float qscale; bf16_t *XKV0, *XKV1;
    __device__ __forceinline__ void operator()(const f32x4 (&acc)[2][2][4][2], const Unit& u, int wr, int wc, int fr, int fq) const {
        const int pn = u.pn; bf16_t* base; int ldc, colt, mode;
        if (pn >= 9) {
            const int idx = 2 * u.pm + (pn - 9), l = idx >> 6, part = (idx >> 5) & 1, b = (idx >> 2) & 7, h = idx & 3;
            bf16_t* tb = (l == 0 ? XKV0 : XKV1) + (size_t)(part * 32 + b * 4 + h) * 65536; const int r0 = wr * 64 + fr, c0 = wc * 32 + 8 * fq;
#pragma unroll
            for (int ai = 0; ai < 2; ++ai)
#pragma unroll
                for (int m = 0; m < 4; ++m) { bf16_t* rowp = tb + (size_t)(r0 + ai * HALF + m * 16) * 256 + c0;
#pragma unroll
                    for (int bj = 0; bj < 2; ++bj) { const f32x4 v0 = acc[ai][bj][m][0], v1 = acc[ai][bj][m][1];
                        u32x4 w; w.x = cvt_pk_bf16(v0[0], v0[1]); w.y = cvt_pk_bf16(v0[2], v0[3]); w.z = cvt_pk_bf16(v1[0], v1[1]); w.w = cvt_pk_bf16(v1[2], v1[3]);
                        *(u32x4*)(rowp + bj * HALF) = w; } }
            return; }
        if (pn == 0) { base = PA; ldc = 256; colt = 0; mode = 0; }
        else if (pn <= 2) { base = Q; ldc = 512; colt = (pn - 1) * 256; mode = 1; }
        else if (pn <= 4) { base = K; ldc = 512; colt = (pn - 3) * 256; mode = 0; }
        else if (pn <= 6) { base = V; ldc = 512; colt = (pn - 5) * 256; mode = 0; }
        else { base = ZC; ldc = 512; colt = (pn - 7) * 256; mode = 2; }
        float rs[2][4]; load_rstd(rs, SS, u, wr, fr, fq);
        const float sc = (mode == 1) ? qscale : 1.0f;
        const int row0 = u.pm * BM + wr * 64 + fr, col0 = colt + wc * 32 + 8 * fq;
#pragma unroll
        for (int ai = 0; ai < 2; ++ai)
#pragma unroll
            for (int m = 0; m < 4; ++m) { bf16_t* rowp = base + (size_t)(row0 + ai * HALF + m * 16) * ldc + col0; const float r = rs[ai][m] * sc;
#pragma unroll
                for (int bj = 0; bj < 2; ++bj) { f32x4 v0 = acc[ai][bj][m][0] * r, v1 = acc[ai][bj][m][1] * r;
                    if (mode == 2) { v0 = (f32x4){gelu_tanh(v0[0]), gelu_tanh(v0[1]), gelu_tanh(v0[2]), gelu_tanh(v0[3])}; v1 = (f32x4){gelu_tanh(v1[0]), gelu_tanh(v1[1]), gelu_tanh(v1[2]), gelu_tanh(v1[3])}; }
                    u32x4 w; w.x = cvt_pk_bf16(v0[0], v0[1]); w.y = cvt_pk_bf16(v0[2], v0[3]); w.z = cvt_pk_bf16(v1[0], v1[1]); w.w = cvt_pk_bf16(v1[2], v1[3]);
                    *(u32x4*)(rowp + bj * HALF) = w; } }
    }
};
struct EpiTile { static constexpr bool PERM = true, AFTER_DRAIN = false;
    bf16_t* O; int mm, mn;
    __device__ __forceinline__ void operator()(const f32x4 (&acc)[2][2][4][2], const Unit& u, int wr, int wc, int fr, int fq) const {
        bf16_t* base = O + (size_t)(mm * u.pm + mn * u.pn) * 65536; const int row0 = wr * 64 + fr, col0 = wc * 32 + 8 * fq;
#pragma unroll
        for (int ai = 0; ai < 2; ++ai)
#pragma unroll
            for (int m = 0; m < 4; ++m) { bf16_t* rowp = base + (size_t)(row0 + ai * HALF + m * 16) * 256 + col0;
#pragma unroll
                for (int bj = 0; bj < 2; ++bj) { const f32x4 v0 = acc[ai][bj][m][0], v1 = acc[ai][bj][m][1];
                    u32x4 w; w.x = cvt_pk_bf16(v0[0], v0[1]); w.y = cvt_pk_bf16(v0[2], v0[3]); w.z = cvt_pk_bf16(v1[0], v1[1]); w.w = cvt_pk_bf16(v1[2], v1[3]);
                    *(u32x4*)(rowp + bj * HALF) = w; } }
    }
};
template <int ACT  , bool ROWSCALE, bool HEADMAJOR> struct EpiStore { static constexpr bool PERM = true, AFTER_DRAIN = false;
    bf16_t* O; int ldc; const float* SS; float scale;
    __device__ __forceinline__ void operator()(const f32x4 (&acc)[2][2][4][2], const Unit& u, int wr, int wc, int fr, int fq) const {
        float rs[2][4];
        if (ROWSCALE) load_rstd(rs, SS, u, wr, fr, fq);
        bf16_t* base = O; int colt = u.pn * BM;
        if (HEADMAJOR) { base += (size_t)u.pn * TOK * 256; colt = 0; }
        const int row0 = u.pm * BM + wr * 64 + fr, col0 = colt + wc * 32 + 8 * fq;
#pragma unroll
        for (int ai = 0; ai < 2; ++ai)
#pragma unroll
            for (int m = 0; m < 4; ++m) { bf16_t* rowp = base + (size_t)(row0 + ai * HALF + m * 16) * ldc + col0; const float r = ROWSCALE ? rs[ai][m] * scale : scale;
#pragma unroll
                for (int bj = 0; bj < 2; ++bj) { f32x4 v0 = acc[ai][bj][m][0] * r, v1 = acc[ai][bj][m][1] * r;
                    if (ACT == 1) {
#pragma unroll
                        for (int i = 0; i < 4; ++i) { const float a = __builtin_fmaxf(v0[i], 0.f), b = __builtin_fmaxf(v1[i], 0.f); v0[i] = a * a; v1[i] = b * b; } }
                    u32x4 w; w.x = cvt_pk_bf16(v0[0], v0[1]); w.y = cvt_pk_bf16(v0[2], v0[3]); w.z = cvt_pk_bf16(v1[0], v1[1]); w.w = cvt_pk_bf16(v1[2], v1[3]);
                    *(u32x4*)(rowp + bj * HALF) = w; } }
    }
};
template <bool FIRST> struct EpiGate { static constexpr bool PERM = true, AFTER_DRAIN = false;
    const bf16_t* Y; bf16_t* MG; const float* bias; const float* SS;
    __device__ __forceinline__ void operator()(const f32x4 (&acc)[2][2][4][2], const Unit& u, int wr, int wc, int fr, int fq) const {
        float rs[2][4]; load_rstd(rs, SS, u, wr, fr, fq);
        const int row0 = u.pm * BM + wr * 64 + fr, col0 = u.pn * BM + wc * 32 + 8 * fq;
        f32x4 bv[2][2];
#pragma unroll
        for (int bj = 0; bj < 2; ++bj)
#pragma unroll
            for (int n = 0; n < 2; ++n) bv[bj][n] = *(const f32x4*)(bias + col0 + bj * HALF + 4 * n);
#pragma unroll
        for (int ai = 0; ai < 2; ++ai)
#pragma unroll
            for (int m = 0; m < 4; ++m) { const size_t off = (size_t)(row0 + ai * HALF + m * 16) * 1024 + col0; const float r = rs[ai][m];
#pragma unroll
                for (int bj = 0; bj < 2; ++bj) { const f32x4 z0 = acc[ai][bj][m][0] * r + bv[bj][0], z1 = acc[ai][bj][m][1] * r + bv[bj][1];
                    const u32x4 y = *(const u32x4*)(Y + off + bj * HALF);
                    float o0 = fast_sigmoid(z0[0]) * bf_lo(y.x), o1 = fast_sigmoid(z0[1]) * bf_hi(y.x), o2 = fast_sigmoid(z0[2]) * bf_lo(y.y), o3 = fast_sigmoid(z0[3]) * bf_hi(y.y);
                    float o4 = fast_sigmoid(z1[0]) * bf_lo(y.z), o5 = fast_sigmoid(z1[1]) * bf_hi(y.z), o6 = fast_sigmoid(z1[2]) * bf_lo(y.w), o7 = fast_sigmoid(z1[3]) * bf_hi(y.w);
                    if (!FIRST) { const u32x4 p = *(const u32x4*)(MG + off + bj * HALF);
                        o0 += bf_lo(p.x); o1 += bf_hi(p.x); o2 += bf_lo(p.y); o3 += bf_hi(p.y); o4 += bf_lo(p.z); o5 += bf_hi(p.z); o6 += bf_lo(p.w); o7 += bf_hi(p.w); }
                    u32x4 w; w.x = cvt_pk_bf16(o0, o1); w.y = cvt_pk_bf16(o2, o3); w.z = cvt_pk_bf16(o4, o5); w.w = cvt_pk_bf16(o6, o7);
                    *(u32x4*)(MG + off + bj * HALF) = w; }
                if (m & 1) asm volatile("" ::: "memory"); }
    }
};
struct EpiRes { static constexpr bool PERM = false, AFTER_DRAIN = false;
    const float* base; float* out; bf16_t* xb; float* SS;
    __device__ __forceinline__ void operator()(const f32x4 (&acc)[2][2][4][2], const Unit& u, int wr, int wc, int fr, int fq) const {
        const int row0 = u.pm * BM + wr * 64 + fr, col0 = u.pn * BM + wc * 32 + 4 * fq;
#pragma unroll
        for (int ai = 0; ai < 2; ++ai)
#pragma unroll
            for (int m = 0; m < 4; ++m) { const int row = row0 + ai * HALF + m * 16; const size_t off = (size_t)row * 1024 + col0; float ss = 0.f;
#pragma unroll
                for (int bj = 0; bj < 2; ++bj)
#pragma unroll
                    for (int n = 0; n < 2; ++n) { const f32x4 b = *(const f32x4*)(base + off + bj * HALF + n * 16); const f32x4 v = b + acc[ai][bj][m][n];
                        *(f32x4*)(out + off + bj * HALF + n * 16) = v; ss += (v[0] * v[0] + v[1] * v[1]) + (v[2] * v[2] + v[3] * v[3]);
                        u32x2 w; w.x = cvt_pk_bf16(v[0], v[1]); w.y = cvt_pk_bf16(v[2], v[3]); *(u32x2*)(xb + off + bj * HALF + n * 16) = w; }
                ss = comb16<false>(ss); ss = comb32<false>(ss);
                if (fq == 0) SS[(size_t)row * 16 + u.pn * 4 + wc] = ss;
                if (m & 1) asm volatile("" ::: "memory"); }
    }
};
struct EpiSoftmax { static constexpr bool PERM = true, AFTER_DRAIN = true;
    bf16_t* P;
    __device__ __forceinline__ void fused(f32x4 (&acc)[2][2][4][2], const Unit& u, int wr, int wc, int fr, int fq, PG8_LAS unsigned char* lds, int wid, int lane) const {
        PG8_LAS float* Pm = (PG8_LAS float*)lds; PG8_LAS float* Ps = Pm + 1024;
#pragma unroll
        for (int ai = 0; ai < 2; ++ai)
#pragma unroll
            for (int m = 0; m < 4; ++m) { float t = -INFINITY;
#pragma unroll
                for (int bj = 0; bj < 2; ++bj)
#pragma unroll
                    for (int n = 0; n < 2; ++n) { const f32x4 x = acc[ai][bj][m][n]; t = __builtin_fmaxf(t, __builtin_fmaxf(__builtin_fmaxf(x[0], x[1]), __builtin_fmaxf(x[2], x[3]))); }
                t = comb16<true>(t); t = comb32<true>(t);
                if (fq == 0) Pm[(ai * HALF + wr * 64 + m * 16 + fr) * 4 + wc] = t; }
        asm volatile("s_waitcnt lgkmcnt(0)" ::: "memory"); __builtin_amdgcn_s_barrier(); asm volatile("" ::: "memory");
#pragma unroll
        for (int ai = 0; ai < 2; ++ai)
#pragma unroll
            for (int m = 0; m < 4; ++m) { const int r = ai * HALF + wr * 64 + m * 16 + fr; const f32x4 mm = *(const PG8_LAS f32x4*)(Pm + r * 4);
                const float mx = __builtin_fmaxf(__builtin_fmaxf(mm[0], mm[1]), __builtin_fmaxf(mm[2], mm[3])); float s = 0.f;
#pragma unroll
                for (int bj = 0; bj < 2; ++bj)
#pragma unroll
                    for (int n = 0; n < 2; ++n) { f32x4 x = acc[ai][bj][m][n];
#pragma unroll
                        for (int i = 0; i < 4; ++i) x[i] = __builtin_amdgcn_exp2f(x[i] - mx);
                        acc[ai][bj][m][n] = x; s += (x[0] + x[1]) + (x[2] + x[3]); }
                s = comb16<false>(s); s = comb32<false>(s);
                if (fq == 0) Ps[r * 4 + wc] = s; }
        asm volatile("s_waitcnt lgkmcnt(0)" ::: "memory"); __builtin_amdgcn_s_barrier(); asm volatile("" ::: "memory");
        bf16_t* base = P + ((size_t)u.pn * TOK + (size_t)u.pm * BM) * 256; const int col0 = wc * 32 + 8 * fq;
#pragma unroll
        for (int ai = 0; ai < 2; ++ai)
#pragma unroll
            for (int m = 0; m < 4; ++m) { const int r = ai * HALF + wr * 64 + m * 16 + fr; const f32x4 sm = *(const PG8_LAS f32x4*)(Ps + r * 4);
                const float inv = 1.0f / ((sm[0] + sm[1]) + (sm[2] + sm[3])); bf16_t* rowp = base + (size_t)r * 256 + col0;
#pragma unroll
                for (int bj = 0; bj < 2; ++bj) { const f32x4 v0 = acc[ai][bj][m][0] * inv, v1 = acc[ai][bj][m][1] * inv;
                    u32x4 w; w.x = cvt_pk_bf16(v0[0], v0[1]); w.y = cvt_pk_bf16(v0[2], v0[3]); w.z = cvt_pk_bf16(v1[0], v1[1]); w.w = cvt_pk_bf16(v1[2], v1[3]);
                    *(u32x4*)(rowp + bj * HALF) = w; } }
        asm volatile("s_waitcnt lgkmcnt(0)" ::: "memory"); __builtin_amdgcn_s_barrier(); asm volatile("" ::: "memory");
    }
};
}

#include <hip/hip_bf16.h>
#include <cmath>
namespace attn_body {
using bf16=__hip_bfloat16;
using bf16x8=__attribute__((ext_vector_type(8)))short;
using s16x4=__attribute__((ext_vector_type(4)))short;
using f32x16=__attribute__((ext_vector_type(16)))float;
using u32x4=__attribute__((ext_vector_type(4)))unsigned;
constexpr int BATCH=8,NHEAD=8,SEQ=2048,D=64,DM=NHEAD*D;
constexpr int NW=8,QBLK=32,QB=QBLK*NW,KVBLK=64,NQB=SEQ/QB;
constexpr int ATTN_PITCH=DM, ATTN_UNIT_ROWS=QB;
__device__ __forceinline__ int crow(int r,int hi){return (r&3)+8*(r>>2)+4*hi;}
#define SBAR() __builtin_amdgcn_sched_barrier(0)
__device__ __forceinline__ void cmask(f32x16&p0,f32x16&p1,int jb,int qrel,int hi){
  const float NEG=-INFINITY; int kb=64*jb+4*hi;
  #pragma unroll
  for(int r=0;r<16;++r){int kv=kb+(r&3)+8*(r>>2); if(kv>qrel)p0[r]=NEG; if(kv+32>qrel)p1[r]=NEG;}
}

constexpr int NSLOT=3, SLOTB=8192;
constexpr int LDS_K=0, LDS_V=NSLOT*SLOTB, LDS_WS=2*NSLOT*SLOTB, LDS_OST=LDS_WS+NW*64*4, LDS_BYTES=LDS_OST+NW*4096, LDS_NB=LDS_BYTES;
constexpr float C2=0.125f*1.4426950408889634f;
__device__ __forceinline__ void glds16(const void*gsrc,unsigned lds_dst){unsigned keep;
  asm volatile("s_mov_b32 %0, m0\n\ts_mov_b32 m0, %2\n\ts_nop 0\n\tglobal_load_lds_dwordx4 %1, off\n\ts_mov_b32 m0, %0":"=&s"(keep):"v"(gsrc),"s"(lds_dst):"memory");}
__device__ __forceinline__ float max3f(float a,float b,float c){float r;asm("v_max3_f32 %0, %1, %2, %3":"=v"(r):"v"(a),"v"(b),"v"(c));return r;}
__device__ __forceinline__ float max2f(float a,float b){float r;asm("v_max_f32_e32 %0, %1, %2":"=v"(r):"v"(a),"v"(b));return r;}
__device__ __forceinline__ float fadd_s(float a,float b){float r;asm("v_add_f32_e32 %0, %1, %2":"=v"(r):"v"(a),"v"(b));return r;}
__device__ __forceinline__ float fsub_s(float a,float b){float r;asm("v_sub_f32_e32 %0, %1, %2":"=v"(r):"v"(a),"v"(b));return r;}
typedef float f32x2_t __attribute__((ext_vector_type(2))); typedef __bf16 bf16x2_t __attribute__((ext_vector_type(2)));
__device__ __forceinline__ unsigned cvtpk_s(float lo,float hi){f32x2_t v={lo,hi};bf16x2_t b=__builtin_convertvector(v,bf16x2_t);return __builtin_bit_cast(unsigned,b);}
#define WAIT_BAR(N) asm volatile("s_waitcnt vmcnt(" #N ") lgkmcnt(0)\n\ts_barrier":::"memory")

__device__ __forceinline__ void qkt(f32x16&p0,f32x16&p1,const char*Kslot,const bf16x8*qr,int r32,int hi){
  const char*kb=Kslot+hi*1024+r32*16;
  #pragma unroll
  for(int d0=0;d0<4;++d0){
    const bf16x8 b0=*reinterpret_cast<const bf16x8*>(kb+d0*2048);
    const bf16x8 b1=*reinterpret_cast<const bf16x8*>(kb+d0*2048+512);
    p0=__builtin_amdgcn_mfma_f32_32x32x16_bf16(b0,qr[d0],p0,0,0,0);p1=__builtin_amdgcn_mfma_f32_32x32x16_bf16(b1,qr[d0],p1,0,0,0);}
}
typedef __attribute__((address_space(3))) const char* lds_cptr;
typedef short v4i16_t __attribute__((ext_vector_type(4)));
__device__ __forceinline__ void kload8(bf16x8*kf,lds_cptr kp){
  kf[0]=*(const __attribute__((address_space(3))) bf16x8*)(kp);      kf[1]=*(const __attribute__((address_space(3))) bf16x8*)(kp+512);
  kf[2]=*(const __attribute__((address_space(3))) bf16x8*)(kp+2048); kf[3]=*(const __attribute__((address_space(3))) bf16x8*)(kp+2560);
  kf[4]=*(const __attribute__((address_space(3))) bf16x8*)(kp+4096); kf[5]=*(const __attribute__((address_space(3))) bf16x8*)(kp+4608);
  kf[6]=*(const __attribute__((address_space(3))) bf16x8*)(kp+6144); kf[7]=*(const __attribute__((address_space(3))) bf16x8*)(kp+6656);
}
__device__ __forceinline__ void kload2(bf16x8*kf,lds_cptr kp,int j){ kf[2*j]=*(const __attribute__((address_space(3))) bf16x8*)(kp+j*2048); kf[2*j+1]=*(const __attribute__((address_space(3))) bf16x8*)(kp+j*2048+512); }
__device__ __forceinline__ s16x4 vtr(lds_cptr p){ return __builtin_bit_cast(s16x4,__builtin_amdgcn_ds_read_tr16_b64_v4i16((__attribute__((address_space(3))) v4i16_t*)p)); }
__device__ __forceinline__ float rowmax(const f32x16&p0,const f32x16&p1){
  float a=max3f(p0[0],p0[1],p1[0]),b=max3f(p0[2],p0[3],p1[1]);a=max3f(a,p1[2],p1[3]);
  #pragma unroll
  for(int r=4;r<16;r+=4){a=max3f(a,p0[r],p0[r+1]);b=max3f(b,p0[r+2],p0[r+3]);a=max3f(a,p1[r],p1[r+1]);b=max3f(b,p1[r+2],p1[r+3]);}
  const float m=max2f(a,b);
  auto rr=__builtin_amdgcn_permlane32_swap(__float_as_uint(m),__float_as_uint(m),false,false);
  return max2f(__uint_as_float(rr[0]),__uint_as_float(rr[1]));
}
__device__ __forceinline__ void pv(f32x16*o,int vb,bf16x8 pa0,bf16x8 pa1,bf16x8 pa2,bf16x8 pa3){
  #pragma unroll
  for(int d0=0;d0<2;++d0){s16x4 lo[4],hi[4];
    #pragma unroll
    for(int ks=0;ks<4;++ks){
      asm volatile("ds_read_b64_tr_b16 %0,%1 offset:%c2":"=&v"(lo[ks]):"v"(vb),"i"(d0*4096+ks*1024):"memory");
      asm volatile("ds_read_b64_tr_b16 %0,%1 offset:%c2":"=&v"(hi[ks]):"v"(vb),"i"(d0*4096+ks*1024+512):"memory");}
    asm volatile("s_waitcnt lgkmcnt(0)":::"memory");SBAR();
    #define PK(k) (bf16x8){lo[k][0],lo[k][1],lo[k][2],lo[k][3],hi[k][0],hi[k][1],hi[k][2],hi[k][3]}
    o[d0]=__builtin_amdgcn_mfma_f32_32x32x16_bf16(pa0,PK(0),o[d0],0,0,0);
    o[d0]=__builtin_amdgcn_mfma_f32_32x32x16_bf16(pa1,PK(1),o[d0],0,0,0);
    o[d0]=__builtin_amdgcn_mfma_f32_32x32x16_bf16(pa2,PK(2),o[d0],0,0,0);
    o[d0]=__builtin_amdgcn_mfma_f32_32x32x16_bf16(pa3,PK(3),o[d0],0,0,0);
    #undef PK
  }
}

#ifndef ATTN_STORE16
#define ATTN_STORE16(p,v) (*(u32x4*)(p)=(v))
#endif
template<int THRL> __device__ __forceinline__ void attn_unit(int b,int h,int qb,const bf16*Q,const bf16*__restrict__ K,const bf16*__restrict__ V,bf16*O,char*shm){
  int tid_=threadIdx.x; asm volatile("":"+v"(tid_)); const int tid=tid_,lane=tid&63,r32=lane&31,hi=lane>>5; const int wid=__builtin_amdgcn_readfirstlane(tid>>6);
  const long rowbase=(long)b*SEQ; const int q0=qb*QB;
  const bf16*Qw=Q+(rowbase+q0+wid*QBLK)*DM+h*D;
  const bf16*Kh=K+rowbase*DM+h*D,*Vh=V+rowbase*DM+h*D;
  const unsigned lds0=(unsigned)(uintptr_t)shm;
  float*wsf=(float*)(shm+LDS_WS)+wid*64;
  const bf16*ksrc=Kh+(long)lane*DM+wid*8;
  const bf16*vsrc=Vh+(long)(16*(wid&3)+(lane>>2))*DM+(wid>>2)*32+(lane&3)*8;
  const unsigned kdst=lds0+LDS_K+wid*1024, vdst=lds0+LDS_V+wid*1024;
  #define DMA_K(t,slot) glds16(ksrc+(long)(t)*KVBLK*DM,(unsigned)__builtin_amdgcn_readfirstlane(kdst+(slot)))
  #define DMA_V(t,slot) glds16(vsrc+(long)(t)*KVBLK*DM,(unsigned)__builtin_amdgcn_readfirstlane(vdst+(slot)))
  const int vb0=(int)(lds0+LDS_V)+((lane>>4)&1)*32+(lane&3)*8+(4*hi+((lane&15)>>2))*64;
  const char*Kbase=shm+LDS_K; bf16x8 kf[8];
  const lds_cptr shm3=(lds_cptr)shm; const lds_cptr kp0=shm3+LDS_K+hi*1024+r32*16; const lds_cptr vp0=shm3+LDS_V+((lane>>4)&1)*32+(lane&3)*8+(4*hi+((lane&15)>>2))*64;
  const int NT=(q0+QB)/KVBLK;
  DMA_K(0,0);DMA_V(0,0);DMA_K(1,SLOTB);
  bf16x8 qr[4];
  #pragma unroll
  for(int d0=0;d0<4;++d0)qr[d0]=*reinterpret_cast<const bf16x8*>(&Qw[(long)r32*DM+d0*16+hi*8]);
  float mhat=0.f,l_reg=0.f;f32x16 o[2];o[0]=f32x16{};o[1]=f32x16{};
  typedef float f32x4_t __attribute__((ext_vector_type(4)));
  const __attribute__((address_space(3))) f32x4_t* nb3=(const __attribute__((address_space(3))) f32x4_t*)((lds_cptr)shm+LDS_NB+hi*16);
  #define LDBIAS(C0,C1,t) do{ const __attribute__((address_space(3))) f32x4_t* nb_=nb3+16*(t); \
    _Pragma("unroll") for(int g_=0;g_<4;++g_){ const f32x4_t a_=nb_[2*g_], b_=nb_[8+2*g_]; \
      C0[4*g_]=a_[0];C0[4*g_+1]=a_[1];C0[4*g_+2]=a_[2];C0[4*g_+3]=a_[3]; C1[4*g_]=b_[0];C1[4*g_+1]=b_[1];C1[4*g_+2]=b_[2];C1[4*g_+3]=b_[3]; } }while(0)
  const int qrel=wid*QBLK+r32;
  #define CMASK(P0,P1,t) do{int jb_=(t)-(NT-4); if(jb_>=0)cmask(P0,P1,jb_,qrel,hi);}while(0)
  bool resc=false;
  #define START(P0,P1) do{ const float rm=rowmax(P0,P1); resc=false; mhat=rm; \
    _Pragma("unroll") for(int r=0;r<16;++r)P0[r]=__builtin_amdgcn_exp2f(P0[r]-mhat); }while(0)
  #define RESC() do{ if(resc){ asm volatile("s_waitcnt lgkmcnt(0)":::"memory"); \
      _Pragma("unroll") for(int d_=0;d_<2;++d_) _Pragma("unroll") for(int r=0;r<16;++r)o[d_][r]*=wsf[crow(r,hi)]; } }while(0)
  f32x16 pA0,pA1,pB0,pB1;
  int sl_prev=0,sl_cur=0,sl_next=SLOTB;
  #define ROT() do{sl_prev=sl_cur;sl_cur=sl_next;sl_next=(sl_next==(NSLOT-1)*SLOTB)?0:sl_next+SLOTB;}while(0)
  DMA_K(2,2*SLOTB);
  WAIT_BAR(3);
  LDBIAS(pA0,pA1,0); qkt(pA0,pA1,Kbase,qr,r32,hi);asm volatile("s_nop 15\n\ts_nop 7":"+v"(pA0),"+v"(pA1));CMASK(pA0,pA1,0);
  START(pA0,pA1);
  _Pragma("unroll") for(int r=0;r<16;++r)pA1[r]=__builtin_amdgcn_exp2f(pA1[r]-mhat);
  WAIT_BAR(0);
  DMA_K(3,0);DMA_V(1,SLOTB);
  ROT();
  kload8(kf,kp0+sl_cur);
  WAIT_BAR(2);
  s16x4 vlo[8],vhi[8]; u32x4 pw0,pw1,pw2,pw3;
  #define PKW(P,B) cvtpk_s(P[B],P[B+1])
  #define PAF(k) __builtin_bit_cast(bf16x8,pw##k)
  #define VFR(i) (bf16x8){vlo[i][0],vlo[i][1],vlo[i][2],vlo[i][3],vhi[i][0],vhi[i][1],vhi[i][2],vhi[i][3]}
  #define PIN(x) asm volatile("":"+v"(x))
  #define MX3(a,b,c) __builtin_fmaxf(__builtin_fmaxf((a),(b)),(c))
  #define GAPA(MF,A0,A1,A2,A3,W0,W1,PW) do{ MF; sacc+=A0; sacc+=A1; sacc+=A2; sacc+=A3; PIN(sacc); W0; W1; PIN(PW); SBAR(); }while(0)
  #define EX(v) __builtin_amdgcn_exp2f((v)-mhat)
  #define GAPB(MF,X,B) do{ MF; X[B]=EX(X[B]); X[B+1]=EX(X[B+1]); X[B+2]=EX(X[B+2]); X[B+3]=EX(X[B+3]); PIN(X); SBAR(); }while(0)
  #define VRD(i) do{ vlo[i]=vtr(vp_+(((i)>>2)*4096+((i)&3)*1024)); vhi[i]=vtr(vp_+(((i)>>2)*4096+((i)&3)*1024+512)); }while(0)
  #define KRD(G,j) do{ if(G){ kload2(kf,kp0+sl_next,j); SBAR(); } }while(0)
  #define STEP(C0,C1,P0,P1,t,GK,GV,GL) do{ SBAR(); LDBIAS(C0,C1,t); \
    const lds_cptr vp_=vp0+sl_prev; \
    VRD(0); SBAR(); float sacc=(P0[0]+P0[1]); \
    GAPA(C0=__builtin_amdgcn_mfma_f32_32x32x16_bf16(kf[0],qr[0],C0,0,0,0), P0[2],P0[3],P0[4],P0[5],     pw0[0]=PKW(P0,0), pw0[1]=PKW(P0,2), pw0); \
    VRD(4); SBAR(); GAPA(C1=__builtin_amdgcn_mfma_f32_32x32x16_bf16(kf[1],qr[0],C1,0,0,0), P0[6],P0[7],P0[8],P0[9],     pw0[2]=PKW(P0,4), pw0[3]=PKW(P0,6), pw0); \
    VRD(1); SBAR(); GAPA(C0=__builtin_amdgcn_mfma_f32_32x32x16_bf16(kf[2],qr[1],C0,0,0,0),   P0[10],P0[11],P0[12],P0[13], pw1[0]=PKW(P0,8), pw1[1]=PKW(P0,10), pw1); \
    VRD(5); SBAR(); GAPA(C1=__builtin_amdgcn_mfma_f32_32x32x16_bf16(kf[3],qr[1],C1,0,0,0),   P0[14],P0[15],P1[0],P1[1],   pw1[2]=PKW(P0,12),pw1[3]=PKW(P0,14), pw1); \
    VRD(2); SBAR(); GAPA(C0=__builtin_amdgcn_mfma_f32_32x32x16_bf16(kf[4],qr[2],C0,0,0,0),   P1[2],P1[3],P1[4],P1[5],     pw2[0]=PKW(P1,0), pw2[1]=PKW(P1,2), pw2); \
    VRD(6); SBAR(); GAPA(C1=__builtin_amdgcn_mfma_f32_32x32x16_bf16(kf[5],qr[2],C1,0,0,0),   P1[6],P1[7],P1[8],P1[9],     pw2[2]=PKW(P1,4), pw2[3]=PKW(P1,6), pw2); \
    VRD(3); SBAR(); GAPA(C0=__builtin_amdgcn_mfma_f32_32x32x16_bf16(kf[6],qr[3],C0,0,0,0),   P1[10],P1[11],P1[12],P1[13], pw3[0]=PKW(P1,8), pw3[1]=PKW(P1,10), pw3); \
    VRD(7); SBAR(); GAPA(C1=__builtin_amdgcn_mfma_f32_32x32x16_bf16(kf[7],qr[3],C1,0,0,0),   P1[14],P1[15],0.f,0.f,       pw3[2]=PKW(P1,12),pw3[3]=PKW(P1,14), pw3); \
    l_reg+=sacc; \
    if(GK){DMA_K((t)+3,sl_cur);} if(GV){DMA_V((t)+1,sl_next);} \
    CMASK(C0,C1,t); \
    { float a=MX3(C0[0],C0[1],C1[0]),b=MX3(C0[2],C0[3],C1[1]); a=MX3(a,C1[2],C1[3]); \
      _Pragma("unroll") for(int r=4;r<16;r+=4){a=MX3(a,C0[r],C0[r+1]);b=MX3(b,C0[r+2],C0[r+3]);a=MX3(a,C1[r],C1[r+1]);b=MX3(b,C1[r+2],C1[r+3]);} \
      float rm=__builtin_fmaxf(a,b); { auto rr=__builtin_amdgcn_permlane32_swap(__float_as_uint(rm),__float_as_uint(rm),false,false); rm=__builtin_fmaxf(__uint_as_float(rr[0]),__uint_as_float(rr[1])); } \
      resc=false; rm-=mhat; \
      if(__builtin_expect(__any(rm>(float)THRL),0)){ const float dl=__builtin_fmaxf(rm,0.f); mhat+=dl; \
        const float f=__builtin_amdgcn_exp2f(-dl); l_reg*=f; if(hi==0)wsf[r32]=f; resc=true; } } \
    SBAR(); \
    GAPB(o[0]=__builtin_amdgcn_mfma_f32_32x32x16_bf16(PAF(0),VFR(0),o[0],0,0,0), C0,0); \
    GAPB(o[1]=__builtin_amdgcn_mfma_f32_32x32x16_bf16(PAF(0),VFR(4),o[1],0,0,0), C0,4); \
    KRD(GL,0); GAPB(o[0]=__builtin_amdgcn_mfma_f32_32x32x16_bf16(PAF(1),VFR(1),o[0],0,0,0), C0,8); \
    KRD(GL,1); GAPB(o[1]=__builtin_amdgcn_mfma_f32_32x32x16_bf16(PAF(1),VFR(5),o[1],0,0,0), C0,12); \
    KRD(GL,2); GAPB(o[0]=__builtin_amdgcn_mfma_f32_32x32x16_bf16(PAF(2),VFR(2),o[0],0,0,0), C1,0); \
    KRD(GL,3); GAPB(o[1]=__builtin_amdgcn_mfma_f32_32x32x16_bf16(PAF(2),VFR(6),o[1],0,0,0), C1,4); \
    GAPB(o[0]=__builtin_amdgcn_mfma_f32_32x32x16_bf16(PAF(3),VFR(3),o[0],0,0,0), C1,8); \
    GAPB(o[1]=__builtin_amdgcn_mfma_f32_32x32x16_bf16(PAF(3),VFR(7),o[1],0,0,0), C1,12); \
    }while(0)
  int t=1;
  #undef CMASK
  #define CMASK(P0,P1,t) do{}while(0)
  for(;t+5<NT;t+=2){
    STEP(pB0,pB1,pA0,pA1,t,true,true,true);     WAIT_BAR(2); RESC(); ROT();
    STEP(pA0,pA1,pB0,pB1,t+1,true,true,true);   WAIT_BAR(2); RESC(); ROT();
  }
  #undef CMASK
  #define CMASK(P0,P1,t) do{int jb_=(t)-(NT-4); if(jb_>=0)cmask(P0,P1,jb_,qrel,hi);}while(0)
  #define ENDW(tt) do{ if((tt)+3<NT){WAIT_BAR(2);} else if((tt)+2<NT){WAIT_BAR(1);} else {WAIT_BAR(0);} }while(0)
  for(;t+1<NT;t+=2){
    STEP(pB0,pB1,pA0,pA1,t,(t+3<NT),(t+1<NT),(t+1<NT));       ENDW(t);   RESC(); ROT();
    STEP(pA0,pA1,pB0,pB1,t+1,(t+4<NT),(t+2<NT),(t+2<NT));     ENDW(t+1); RESC(); ROT();
  }
  STEP(pB0,pB1,pA0,pA1,NT-1,false,false,false); RESC();
  { float sacc=pB0[0]+pB0[1]; _Pragma("unroll") for(int r=2;r<16;++r)sacc+=pB0[r]; _Pragma("unroll") for(int r=0;r<16;++r)sacc+=pB1[r]; l_reg+=sacc;
    pw0=(u32x4){PKW(pB0,0),PKW(pB0,2),PKW(pB0,4),PKW(pB0,6)};pw1=(u32x4){PKW(pB0,8),PKW(pB0,10),PKW(pB0,12),PKW(pB0,14)};pw2=(u32x4){PKW(pB1,0),PKW(pB1,2),PKW(pB1,4),PKW(pB1,6)};pw3=(u32x4){PKW(pB1,8),PKW(pB1,10),PKW(pB1,12),PKW(pB1,14)};
    SBAR(); pv(o,vb0+sl_cur,PAF(0),PAF(1),PAF(2),PAF(3)); }
  #undef PKW
  #undef PAF
  #undef VFR
  #undef PIN
  #undef MX3
  #undef GAPA
  #undef GAPB
  #undef EX
  #undef VRD
  #undef KRD
  #undef STEP
  #undef ENDW
  {auto rr=__builtin_amdgcn_permlane32_swap(__float_as_uint(l_reg),__float_as_uint(l_reg),false,false);l_reg=__uint_as_float(rr[0])+__uint_as_float(rr[1]);}
  if(hi==0)wsf[32+r32]=l_reg;asm volatile("s_waitcnt lgkmcnt(0)":::"memory");
  float rli[16];
  #pragma unroll
  for(int r=0;r<16;++r)rli[r]=__builtin_amdgcn_rcpf(wsf[32+crow(r,hi)]);
  bf16*Ow=O+(rowbase+q0+wid*QBLK)*DM+h*D;
  { bf16*stg=(bf16*)(shm+LDS_OST)+wid*2048;
    #pragma unroll
    for(int r=0;r<16;++r){const int orow=crow(r,hi);
      #pragma unroll
      for(int d0=0;d0<2;++d0)stg[orow*64+d0*32+r32]=__float2bfloat16(o[d0][r]*rli[r]);}
    asm volatile("s_waitcnt lgkmcnt(0)":::"memory");
    #pragma unroll
    for(int i=0;i<4;++i){const int row=i*8+(lane>>3),ch=lane&7; const u32x4 v=*(const u32x4*)(stg+row*64+ch*8); ATTN_STORE16(Ow+(long)row*DM+ch*8,v);} }
  asm volatile("s_waitcnt lgkmcnt(0)\n\ts_barrier":::"memory");
  #undef DMA_K
  #undef DMA_V
  #undef CMASK
  #undef START
  #undef RESC
  #undef ROT
  #undef LDBIAS
}
constexpr int ATTN_LDS_BYTES=LDS_BYTES;
#undef SBAR
#undef WAIT_BAR
}

#define GAS __attribute__((address_space(1)))
#define LAS __attribute__((address_space(3)))
typedef unsigned short bf16;
typedef unsigned v4u __attribute__((ext_vector_type(4)));
typedef float f32x4 __attribute__((ext_vector_type(4)));
typedef short bf16x8 __attribute__((ext_vector_type(8)));
typedef GAS unsigned gu32;
typedef GAS unsigned long long gu64;
#define RLX_AGENT __ATOMIC_RELAXED, __HIP_MEMORY_SCOPE_AGENT
#define LDS_WAIT() asm volatile("s_waitcnt lgkmcnt(0)" ::: "memory")
#define VM_WAIT() asm volatile("s_waitcnt vmcnt(0)" ::: "memory")
__device__ __forceinline__ unsigned long long rt() { return __builtin_amdgcn_s_memrealtime(); }
__device__ __forceinline__ unsigned f2bf(float f) { unsigned u = __builtin_bit_cast(unsigned, f); return (u + 0x7fffu + ((u >> 16) & 1u)) >> 16; }
__device__ __forceinline__ unsigned pk2(float lo, float hi) { return f2bf(lo) | (f2bf(hi) << 16); }

#define XB_TMO      128
#define XB_XCNT(j)  (256  + 64 * (j))
#define XB_XSUB(j)  (1280 + 64 * (j))
#define XB_XGEN(j)  (2304 + 64 * (j))
#define XB_TOP      3328
#define XB_TOPGEN   3392
#define XCD_BAR_WORDS 3456
#define XB_SPIN_CAP (1u << 18)

__device__ __forceinline__ unsigned xb_ld(unsigned* p)              { return __hip_atomic_load(p, __ATOMIC_RELAXED, __HIP_MEMORY_SCOPE_AGENT); }
__device__ __forceinline__ unsigned xb_add(unsigned* p, unsigned v) { return __hip_atomic_fetch_add(p, v, __ATOMIC_RELAXED, __HIP_MEMORY_SCOPE_AGENT); }
__device__ __forceinline__ unsigned xb_xcc_id() { return (unsigned)__builtin_amdgcn_s_getreg((3 << 11) | 20) & 0xFu; }
#define XB_SPIN(cond, bar) do { unsigned _sp = 0; while (cond) { __builtin_amdgcn_s_sleep(1); \
    if ((++_sp & 255u) == 0u) { if (xb_ld(&(bar)[XB_TMO])) break; if (_sp > XB_SPIN_CAP) { atomicAdd(&(bar)[XB_TMO], 1u); break; } } } } while (0)

struct XcdBarrier {
    unsigned* bar; unsigned x;
    volatile LAS unsigned* st;
};

__device__ __forceinline__ XcdBarrier xcd_barrier_post(unsigned* bar, volatile LAS unsigned* st) {
    XcdBarrier b; b.bar = bar; b.x = xb_xcc_id(); b.st = st;
    if (threadIdx.x == 0) (void)xb_add(&bar[XB_XCNT(b.x)], 1u);
    return b;
}
__device__ __forceinline__ void xcd_barrier_complete(unsigned* bar, unsigned x, unsigned& nloc, unsigned& nx) {
    const unsigned G = gridDim.x * gridDim.y * gridDim.z;
    unsigned sum, cnt, mine, sp = 0u;
    for (;;) {
        sum = 0u; cnt = 0u; mine = 0u;
#pragma unroll
        for (unsigned j = 0; j < 16; ++j) { const unsigned c = xb_ld(&bar[XB_XCNT(j)]); sum += c; cnt += (c > 0u) ? 1u : 0u; mine = (j == x) ? c : mine; }
        if (sum == G) break;
        __builtin_amdgcn_s_sleep(1);
        if ((++sp & 255u) == 0u) { if (xb_ld(&bar[XB_TMO])) break; if (sp > XB_SPIN_CAP) { atomicAdd(&bar[XB_TMO], 1u); break; } }
    }
    nloc = mine > 0u ? mine : 1u; nx = cnt > 0u ? cnt : 1u;
}

__device__ __forceinline__ void xcd_barrier(const XcdBarrier& b) {
    asm volatile("s_waitcnt vmcnt(0)" ::: "memory");
    __syncthreads();
    int tb_ = threadIdx.x; asm volatile("" : "+v"(tb_));
    if (tb_ == 0) {
        unsigned* bar = b.bar;
        __builtin_amdgcn_s_waitcnt(0);
        unsigned nloc = b.st[0], nx = b.st[1];
        if (nloc == 0u) { xcd_barrier_complete(bar, b.x, nloc, nx); b.st[0] = nloc; b.st[1] = nx; }
        const unsigned old = xb_add(&bar[XB_XSUB(b.x)], 1u);
        const unsigned gen = old / nloc;
        if (old + 1u == (gen + 1u) * nloc) {
            __builtin_amdgcn_fence(__ATOMIC_RELEASE, "agent");
            asm volatile("s_waitcnt vmcnt(0)" ::: "memory");
            const unsigned og = xb_add(&bar[XB_TOP], 1u);
            const unsigned tg = og / nx;
            if (og + 1u == (tg + 1u) * nx) xb_add(&bar[XB_TOPGEN], 1u);
            else XB_SPIN(xb_ld(&bar[XB_TOPGEN]) == tg, bar);
            __builtin_amdgcn_fence(__ATOMIC_ACQUIRE, "agent");
            xb_add(&bar[XB_XGEN(b.x)], 1u);
            asm volatile("s_waitcnt vmcnt(0)" ::: "memory");
        } else {
            XB_SPIN(xb_ld(&bar[XB_XGEN(b.x)]) == gen, bar);
            __builtin_amdgcn_fence(__ATOMIC_ACQUIRE, "agent");
            asm volatile("s_waitcnt vmcnt(0)" ::: "memory");
        }
    }
    __syncthreads();
}

constexpr int NWAVES = 8, NCU = 256;
constexpr int BATCH = 8, SEQ = 2048, D = 1024, TOK = BATCH * SEQ, DEPTH = 2, MEMLEN = 256, FF = 4096;
constexpr int N_IN = 5384, OFF_F = 1792, OFF_C = 1800, OFF_G = 2312;
constexpr float EPSF = 1e-6f, LOG2E = 1.4426950408889634f;
constexpr size_t MiB = 1u << 20;
constexpr size_t WS_CTL = 0, CTL_ZERO_BYTES = 1 * MiB;
constexpr size_t WS_SS = 1 * MiB;
constexpr size_t WS_LOGF = 2 * MiB;
constexpr size_t WS_W = 3 * MiB;
constexpr size_t OW_IN = 0, OW_G = OW_IN + (size_t)2304 * 1024 * 2, OW_A = OW_G + (size_t)3072 * 1024 * 2, OW_B = OW_A + (size_t)1024 * 256 * 2, OW_C = OW_B + (size_t)1024 * 512 * 2,
                 OW_OUT = OW_C + (size_t)1024 * 256 * 2, OW_XQ = OW_OUT + (size_t)1024 * 1024 * 2, OW_XKV = OW_XQ + (size_t)1024 * 1024 * 2, OW_XO = OW_XKV + (size_t)2048 * 1024 * 2,
                 OW_FF1 = OW_XO + (size_t)1024 * 1024 * 2, OW_FF2 = OW_FF1 + (size_t)4096 * 1024 * 2, LW = OW_FF2 + (size_t)1024 * 4096 * 2;
static_assert(LW == 40370176 && WS_W + 2 * LW <= 80 * MiB, "weight map");
constexpr size_t WS_XKV1 = 80 * MiB;
constexpr size_t WS_XB = 88 * MiB;
constexpr size_t WS_DYN = 120 * MiB;
constexpr size_t WS_Q = WS_DYN, WS_K = WS_DYN + 16 * MiB, WS_V = WS_DYN + 32 * MiB, WS_PA = WS_DYN + 48 * MiB, WS_DD = WS_DYN + 56 * MiB, WS_ZC = WS_DYN + 64 * MiB,
                 WS_SG = WS_DYN + 80 * MiB, WS_T2 = WS_DYN + 88 * MiB, WS_HM = WS_DYN + 120 * MiB, WS_XKV0 = WS_DYN + 128 * MiB;
constexpr size_t WS_MG = WS_DYN + 16 * MiB;
constexpr size_t WS_XQH = WS_DYN, WS_PP = WS_DYN + 32 * MiB, WS_XO = WS_DYN + 64 * MiB;
constexpr size_t WS_FFH = WS_DYN;
constexpr size_t WS_END = 256 * MiB;
static_assert(WS_XKV0 + 8 * MiB <= WS_END, "d_ws map");
constexpr int CW_TMO = 0, CW_CODE = 1, CW_BAR = 4096;
constexpr int RING_OFF = 0, RING_BYTES = 131072, LDSCTL_OFF = RING_BYTES, MISC_OFF = LDSCTL_OFF + 320, LDS_BYTES = 147456;

template <int CTRL> __device__ __forceinline__ float dppf(float v) { return __uint_as_float(__builtin_amdgcn_update_dpp(0u, __float_as_uint(v), CTRL, 0xf, 0xf, false)); }
__device__ __forceinline__ float wave_sum(float v) {
    v += dppf<0xB1>(v); v += dppf<0x4E>(v); v += dppf<0x141>(v); v += dppf<0x140>(v);
    v = pg8::comb16<false>(v); v = pg8::comb32<false>(v);
    return v;
}
__device__ __forceinline__ float wave_scan(float v) {
    v += dppf<0x111>(v); v += dppf<0x112>(v); v += dppf<0x114>(v); v += dppf<0x118>(v);
    v += __uint_as_float(__builtin_amdgcn_update_dpp(0u, __float_as_uint(v), 0x142, 0xa, 0xf, false));
    v += __uint_as_float(__builtin_amdgcn_update_dpp(0u, __float_as_uint(v), 0x143, 0xc, 0xf, false));
    return v;
}

struct Frame {
    LAS unsigned char* lds;
    volatile LAS unsigned* MISC;
    gu32* ctl;
    int tid, lane, wave, vcu, G;
    float* out; unsigned char* ws;
};
constexpr int PTRS_OFF = LDSCTL_OFF + 512;
__device__ __forceinline__ const float* inp(const Frame& F, int i) {
    const unsigned long long v = *(volatile LAS unsigned long long*)(F.lds + PTRS_OFF + 8 * i);
    const unsigned lo = __builtin_amdgcn_readfirstlane((unsigned)v), hi = __builtin_amdgcn_readfirstlane((unsigned)(v >> 32));
    return (const float*)(const GAS float*)(((unsigned long long)hi << 32) | lo); }
__device__ __forceinline__ bf16* wsb(const Frame& F, size_t off) { return (bf16*)(F.ws + off); }
__device__ __forceinline__ bf16* wlay(const Frame& F, int l, size_t off) { return (bf16*)(F.ws + WS_W + (size_t)l * LW + off); }

__device__ __forceinline__ void tr_item(const float* W, int ldw, int K, int scol0, bf16* WT, int drow0, const float* gain, LAS float* scr, int kb, int nb, int lane) {
    const int k0 = 64 * kb, n0 = 32 * nb;
#pragma unroll 8
    for (int i = 0; i < 32; ++i) { const int kk = 2 * i + (lane >> 5); float v = W[(size_t)(k0 + kk) * ldw + scol0 + n0 + (lane & 31)]; if (gain) v *= gain[k0 + kk]; scr[kk * 33 + (lane & 31)] = v; }
    LDS_WAIT(); asm volatile("" ::: "memory");
    const int c = lane & 7;
#pragma unroll
    for (int j = 0; j < 4; ++j) { const int n = (lane >> 3) + 8 * j; const LAS float* s = scr + (8 * c) * 33 + n;
        v4u o; o.x = pk2(s[0 * 33], s[1 * 33]); o.y = pk2(s[2 * 33], s[3 * 33]); o.z = pk2(s[4 * 33], s[5 * 33]); o.w = pk2(s[6 * 33], s[7 * 33]);
        *(GAS v4u*)(WT + (size_t)(drow0 + n0 + n) * K + k0 + 8 * c) = o; }
    LDS_WAIT(); asm volatile("" ::: "memory");
}
constexpr int I_IN1 = 16 * 56, I_IN2 = 16 * 16, I_G = 16 * 96, I_B = 8 * 32, I_C = 4 * 32, I_OUT = 16 * 32, I_XQ = 16 * 32, I_XKV = 16 * 64, I_XO = 16 * 32, I_FF1 = 16 * 128, I_FF2 = 64 * 32;
constexpr int I_LAYER = I_IN1 + I_IN2 + I_G + I_B + I_C + I_OUT + I_XQ + I_XKV + I_XO + I_FF1 + I_FF2;

__device__ __forceinline__ void p0_prologue(Frame& F) {
    LAS float* scr = (LAS float*)(F.lds + RING_OFF + F.wave * 16384);
    const int gw = F.vcu * NWAVES + F.wave, NGW = F.G * NWAVES, lane = F.lane;
    for (int it = gw; it < DEPTH * I_LAYER; it += NGW) {
        const int l = it / I_LAYER; int r = it % I_LAYER;
        const float* w_in = inp(F, 3) + (size_t)l * D * N_IN;
        if (r < I_IN1) { tr_item(w_in, N_IN, D, 0, wlay(F, l, OW_IN), 0, inp(F, 2) + l * D, scr, r / 56, r % 56, lane); continue; } r -= I_IN1;
        if (r < I_IN2) { tr_item(w_in, N_IN, D, OFF_C, wlay(F, l, OW_IN), 1792, inp(F, 2) + l * D, scr, r / 16, r % 16, lane); continue; } r -= I_IN2;
        if (r < I_G) { tr_item(w_in, N_IN, D, OFF_G, wlay(F, l, OW_G), 0, inp(F, 2) + l * D, scr, r / 96, r % 96, lane); continue; } r -= I_G;
        if (r < I_B) { tr_item(inp(F, 11) + (size_t)l * 512 * D, D, 512, 0, wlay(F, l, OW_B), 0, nullptr, scr, r / 32, r % 32, lane); continue; } r -= I_B;
        if (r < I_C) { tr_item(inp(F, 12) + (size_t)l * 256 * D, D, 256, 0, wlay(F, l, OW_C), 0, nullptr, scr, r / 32, r % 32, lane); continue; } r -= I_C;
        if (r < I_OUT) { tr_item(inp(F, 14) + (size_t)l * D * D, D, D, 0, wlay(F, l, OW_OUT), 0, nullptr, scr, r / 32, r % 32, lane); continue; } r -= I_OUT;
        if (r < I_XQ) { tr_item(inp(F, 17) + (size_t)l * D * D, D, D, 0, wlay(F, l, OW_XQ), 0, inp(F, 15) + l * D, scr, r / 32, r % 32, lane); continue; } r -= I_XQ;
        if (r < I_XKV) { tr_item(inp(F, 18) + (size_t)l * D * 2 * D, 2 * D, D, 0, wlay(F, l, OW_XKV), 0, nullptr, scr, r / 64, r % 64, lane); continue; } r -= I_XKV;
        if (r < I_XO) { tr_item(inp(F, 19) + (size_t)l * D * D, D, D, 0, wlay(F, l, OW_XO), 0, nullptr, scr, r / 32, r % 32, lane); continue; } r -= I_XO;
        if (r < I_FF1) { tr_item(inp(F, 21) + (size_t)l * D * FF, FF, D, 0, wlay(F, l, OW_FF1), 0, inp(F, 20) + l * D, scr, r / 128, r % 128, lane); continue; } r -= I_FF1;
        tr_item(inp(F, 22) + (size_t)l * FF * D, D, FF, 0, wlay(F, l, OW_FF2), 0, nullptr, scr, r / 32, r % 32, lane);
    }
    for (int it = gw; it < DEPTH * 256 * 16; it += NGW) {
        const int l = it / 4096, r = it % 4096, cp = r / 16, n = (r % 16) * 64 + lane, g = cp >> 6;
        const float* pw = inp(F, 5) + ((size_t)l * 256 + cp) * 64; const float* ps = inp(F, 6) + l * 256 + g * 64; const float* wa = inp(F, 10) + ((size_t)l * 256 + g * 64) * D + n;
        float a = 0.f;
#pragma unroll 8
        for (int d = 0; d < 64; ++d) a += pw[d] * ps[d] * wa[(size_t)d * D];
        wlay(F, l, OW_A)[(size_t)n * 256 + cp] = (bf16)f2bf(a);
    }
    for (int it = gw; it < DEPTH * BATCH * MEMLEN; it += NGW) {
        const int l = it / (BATCH * MEMLEN), m = it % (BATCH * MEMLEN);
        const GAS f32x4* xr = (const GAS f32x4*)(inp(F, 1) + (size_t)m * D) + lane; const GAS f32x4* gr = (const GAS f32x4*)(inp(F, 16) + l * D) + lane;
        f32x4 v[4]; float s = 0.f;
#pragma unroll
        for (int j = 0; j < 4; ++j) { v[j] = xr[64 * j]; s += (v[j].x * v[j].x + v[j].y * v[j].y) + (v[j].z * v[j].z + v[j].w * v[j].w); }
        const float rstd = 1.0f / sqrtf(wave_sum(s) * (1.f / D) + EPSF);
        GAS unsigned long long* o8 = (GAS unsigned long long*)(wsb(F, WS_HM) + ((size_t)l * BATCH * MEMLEN + m) * D) + lane;
#pragma unroll
        for (int j = 0; j < 4; ++j) { const f32x4 g = gr[64 * j]; o8[64 * j] = (unsigned long long)pk2(v[j].x * rstd * g.x, v[j].y * rstd * g.y) | ((unsigned long long)pk2(v[j].z * rstd * g.z, v[j].w * rstd * g.w) << 32); }
    }
    for (int m = gw; m < TOK; m += NGW) {
        const GAS f32x4* xr = (const GAS f32x4*)(inp(F, 0) + (size_t)m * D) + lane;
        f32x4 v[4]; float s = 0.f;
#pragma unroll
        for (int j = 0; j < 4; ++j) { v[j] = xr[64 * j]; s += (v[j].x * v[j].x + v[j].y * v[j].y) + (v[j].z * v[j].z + v[j].w * v[j].w); }
        s = wave_sum(s);
        GAS unsigned long long* o8 = (GAS unsigned long long*)(wsb(F, WS_XB) + (size_t)m * D) + lane;
#pragma unroll
        for (int j = 0; j < 4; ++j) o8[64 * j] = (unsigned long long)pk2(v[j].x, v[j].y) | ((unsigned long long)pk2(v[j].z, v[j].w) << 32);
        if (lane < 16) ((float*)(F.ws + WS_SS))[(size_t)m * 16 + lane] = lane == 0 ? s : 0.f;
    }
}

__device__ __forceinline__ float row_rstd(const Frame& F, int row) {
    const f32x4* p = (const f32x4*)((const float*)(F.ws + WS_SS) + (size_t)row * 16);
    const f32x4 a = p[0], b = p[1], c = p[2], d = p[3];
    const float s = ((a[0] + a[1]) + (a[2] + a[3])) + ((b[0] + b[1]) + (b[2] + b[3])) + ((c[0] + c[1]) + (c[2] + c[3])) + ((d[0] + d[1]) + (d[2] + d[3]));
    return 1.0f / sqrtf(s * (1.f / D) + EPSF);
}

__device__ __forceinline__ void logf_pass(Frame& F, int l) {
    const int gw = F.vcu * NWAVES + F.wave, NGW = F.G * NWAVES, lane = F.lane;
    LAS float* WF = (LAS float*)(F.lds + RING_OFF);
    {
        const float* w_in = inp(F, 3) + (size_t)l * D * N_IN; const float* g = inp(F, 2) + l * D;
#pragma unroll
        for (int i = 0; i < 2; ++i) { const int k = F.tid + 512 * i; const float gk = g[k]; const float* p = w_in + (size_t)k * N_IN + OFF_F;
            const f32x4 a = *(const f32x4*)p * gk, b = *(const f32x4*)(p + 4) * gk;
            LAS f32x4* dst = (LAS f32x4*)(WF + (k >> 4) * 132 + (k & 15) * 8); dst[0] = a; dst[1] = b; }
    }
    LDS_WAIT(); __syncthreads();
    const float bfl = (lane < 8) ? (inp(F, 4) + l * 8)[lane] : 0.f;
    float* LOGF = (float*)(F.ws + WS_LOGF);
    const LAS f32x4* wl = (const LAS f32x4*)(WF + lane * 132);
    for (int m = gw; m < TOK; m += NGW) {
        const v4u* xp = (const v4u*)(wsb(F, WS_XB) + (size_t)m * D + 16 * lane);
        const v4u x0 = xp[0], x1 = xp[1];
        float xv[16];
        xv[0] = __uint_as_float(x0.x << 16); xv[1] = __uint_as_float(x0.x & 0xffff0000u); xv[2] = __uint_as_float(x0.y << 16); xv[3] = __uint_as_float(x0.y & 0xffff0000u);
        xv[4] = __uint_as_float(x0.z << 16); xv[5] = __uint_as_float(x0.z & 0xffff0000u); xv[6] = __uint_as_float(x0.w << 16); xv[7] = __uint_as_float(x0.w & 0xffff0000u);
        xv[8] = __uint_as_float(x1.x << 16); xv[9] = __uint_as_float(x1.x & 0xffff0000u); xv[10] = __uint_as_float(x1.y << 16); xv[11] = __uint_as_float(x1.y & 0xffff0000u);
        xv[12] = __uint_as_float(x1.z << 16); xv[13] = __uint_as_float(x1.z & 0xffff0000u); xv[14] = __uint_as_float(x1.w << 16); xv[15] = __uint_as_float(x1.w & 0xffff0000u);
        f32x4 a0 = (f32x4){0.f, 0.f, 0.f, 0.f}, a1 = a0;
#pragma unroll
        for (int j = 0; j < 16; ++j) { a0 += wl[2 * j] * xv[j]; a1 += wl[2 * j + 1] * xv[j]; }
        float d[8] = {a0[0], a0[1], a0[2], a0[3], a1[0], a1[1], a1[2], a1[3]};
#pragma unroll
        for (int h = 0; h < 8; ++h) d[h] = wave_sum(d[h]);
        const float rstd = row_rstd(F, m);
        if (lane < 8) {
            float dv = d[0];
#pragma unroll
            for (int h = 1; h < 8; ++h) dv = (lane == h) ? d[h] : dv;
            const float z = dv * rstd + bfl;
            const float ls = fminf(z, 0.f) - 0.6931471805599453f * __builtin_amdgcn_logf(1.0f + __builtin_amdgcn_exp2f(-LOG2E * fabsf(z)));
            LOGF[((size_t)(m / SEQ) * 8 + lane) * SEQ + (m % SEQ)] = ls;
        }
    }
    LDS_WAIT(); __syncthreads();
}

__device__ __forceinline__ void cumsum_bias(Frame& F, int bh, LAS float* nb, LAS float* scr) {
    const f32x4 v = *((const f32x4*)((const float*)(F.ws + WS_LOGF) + (size_t)bh * SEQ) + F.tid);
    const float p0 = v[0], p1 = p0 + v[1], p2 = p1 + v[2], p3 = p2 + v[3];
    const float incl = wave_scan(p3);
    if (F.lane == 63) scr[F.wave] = incl;
    LDS_WAIT(); __syncthreads();
    float woff = 0.f;
#pragma unroll
    for (int w = 0; w < 8; ++w) woff += (w < F.wave) ? scr[w] : 0.f;
    const float base = woff + (incl - p3);
    *((LAS f32x4*)nb + F.tid) = (f32x4){-(base + p0) * LOG2E, -(base + p1) * LOG2E, -(base + p2) * LOG2E, -(base + p3) * LOG2E};
    LDS_WAIT(); __syncthreads();
}

__device__ __forceinline__ void pool_diff(Frame& F) {
    const bf16* PA = wsb(F, WS_PA); bf16* DD = wsb(F, WS_DD);
    for (int j = 0; j < 4; ++j) {
        const int item = F.tid + 512 * j, row = 64 * F.vcu + (item >> 5), ch = item & 31, g = ch >> 3, win = 2 << g, tl = row & (SEQ - 1);
        const int n = (tl + 1 < win) ? tl + 1 : win;
        float s[8] = {0.f, 0.f, 0.f, 0.f, 0.f, 0.f, 0.f, 0.f}; v4u cur = (v4u){0u, 0u, 0u, 0u};
        for (int k = 0; k < n; ++k) { const v4u w = *(const v4u*)(PA + (size_t)(row - k) * 256 + 8 * ch); if (k == 0) cur = w;
            s[0] += __uint_as_float(w.x << 16); s[1] += __uint_as_float(w.x & 0xffff0000u); s[2] += __uint_as_float(w.y << 16); s[3] += __uint_as_float(w.y & 0xffff0000u);
            s[4] += __uint_as_float(w.z << 16); s[5] += __uint_as_float(w.z & 0xffff0000u); s[6] += __uint_as_float(w.w << 16); s[7] += __uint_as_float(w.w & 0xffff0000u); }
        const float inv = 1.0f / (float)n;
        v4u o;
        o.x = pk2(s[0] * inv - __uint_as_float(cur.x << 16), s[1] * inv - __uint_as_float(cur.x & 0xffff0000u));
        o.y = pk2(s[2] * inv - __uint_as_float(cur.y << 16), s[3] * inv - __uint_as_float(cur.y & 0xffff0000u));
        o.z = pk2(s[4] * inv - __uint_as_float(cur.z << 16), s[5] * inv - __uint_as_float(cur.z & 0xffff0000u));
        o.w = pk2(s[6] * inv - __uint_as_float(cur.w << 16), s[7] * inv - __uint_as_float(cur.w & 0xffff0000u));
        *(v4u*)(DD + (size_t)row * 256 + 8 * ch) = o;
    }
}

__device__ __forceinline__ void sgu_unit(Frame& F, int l, int unit) {
    const int chunk = unit >> 2, g = unit & 3, row0 = chunk * 128, lane = F.lane, w = F.wave;
    const bf16* ZC = wsb(F, WS_ZC); bf16* SG = wsb(F, WS_SG);
    LAS bf16* vnT = (LAS bf16*)(F.lds + RING_OFF);
    const float* gain = inp(F, 7) + l * 256;
    const float g0 = gain[4 * lane], g1 = gain[4 * lane + 1], g2 = gain[4 * lane + 2], g3 = gain[4 * lane + 3];
    for (int i = 0; i < 16; ++i) {
        const int s = 16 * w + i;
        const unsigned long long q = *(const unsigned long long*)(ZC + (size_t)(row0 + s) * 512 + 256 + 4 * lane);
        const unsigned lo = (unsigned)q, hi = (unsigned)(q >> 32);
        const float v0 = __uint_as_float(lo << 16), v1 = __uint_as_float(lo & 0xffff0000u), v2 = __uint_as_float(hi << 16), v3 = __uint_as_float(hi & 0xffff0000u);
        const float ss = wave_sum((v0 * v0 + v1 * v1) + (v2 * v2 + v3 * v3));
        const float r = 1.0f / sqrtf(ss * (1.f / 256.f) + EPSF);
        if ((lane >> 4) == g) { const int d = 4 * (lane & 15);
            vnT[(d + 0) * 136 + s] = (bf16)f2bf(v0 * r * g0); vnT[(d + 1) * 136 + s] = (bf16)f2bf(v1 * r * g1); vnT[(d + 2) * 136 + s] = (bf16)f2bf(v2 * r * g2); vnT[(d + 3) * 136 + s] = (bf16)f2bf(v3 * r * g3); }
    }
    LDS_WAIT(); __syncthreads();
    const float* Wg = inp(F, 8) + ((size_t)(l * 4 + g) * 128) * 128;
    const int t = 16 * w + (lane & 15), kq = lane >> 4;
    f32x4 acc[4];
#pragma unroll
    for (int n = 0; n < 4; ++n) acc[n] = (f32x4){0.f, 0.f, 0.f, 0.f};
#pragma unroll
    for (int kk = 0; kk < 4; ++kk) {
        if (32 * kk <= 16 * w + 15) {
            const int s0 = 32 * kk + 8 * kq;
            const f32x4 wa = *(const f32x4*)(Wg + (size_t)t * 128 + s0), wb = *(const f32x4*)(Wg + (size_t)t * 128 + s0 + 4);
            float wv[8] = {wa[0], wa[1], wa[2], wa[3], wb[0], wb[1], wb[2], wb[3]};
#pragma unroll
            for (int j = 0; j < 8; ++j) wv[j] = (s0 + j <= t) ? wv[j] : 0.f;
            v4u bw; bw.x = pk2(wv[0], wv[1]); bw.y = pk2(wv[2], wv[3]); bw.z = pk2(wv[4], wv[5]); bw.w = pk2(wv[6], wv[7]);
            const bf16x8 bfrag = __builtin_bit_cast(bf16x8, bw);
#pragma unroll
            for (int n = 0; n < 4; ++n) { const bf16x8 afrag = *(const LAS bf16x8*)(vnT + (16 * n + (lane & 15)) * 136 + s0);
                acc[n] = __builtin_amdgcn_mfma_f32_16x16x32_bf16(afrag, bfrag, acc[n], 0, 0, 0); }
        }
    }
    const float bt = inp(F, 9)[(l * 4 + g) * 128 + t];
#pragma unroll
    for (int n = 0; n < 4; ++n) { const int d = 64 * g + 16 * n + 4 * kq;
        const unsigned long long q = *(const unsigned long long*)(ZC + (size_t)(row0 + t) * 512 + d);
        const unsigned lo = (unsigned)q, hi = (unsigned)(q >> 32);
        const float o0 = __uint_as_float(lo << 16) * (acc[n][0] + bt), o1 = __uint_as_float(lo & 0xffff0000u) * (acc[n][1] + bt), o2 = __uint_as_float(hi << 16) * (acc[n][2] + bt), o3 = __uint_as_float(hi & 0xffff0000u) * (acc[n][3] + bt);
        *(unsigned long long*)(SG + (size_t)(row0 + t) * 256 + d) = (unsigned long long)pk2(o0, o1) | ((unsigned long long)pk2(o2, o3) << 32); }
    LDS_WAIT(); __syncthreads();
}

__device__ __forceinline__ void final_norm(Frame& F) {
    const int gw = F.vcu * NWAVES + F.wave, NGW = F.G * NWAVES, lane = F.lane;
    const GAS f32x4* gr = (const GAS f32x4*)inp(F, 23) + lane;
    for (int m = gw; m < TOK; m += NGW) {
        const float rstd = row_rstd(F, m);
        GAS f32x4* xr = (GAS f32x4*)(F.out + (size_t)m * D) + lane;
#pragma unroll
        for (int j = 0; j < 4; ++j) { const f32x4 v = xr[64 * j]; xr[64 * j] = v * rstd * gr[64 * j]; }
    }
}

struct Args { const float* in[24]; float* out; unsigned char* ws; };
__global__ void __launch_bounds__(NWAVES * 64, 2) mega_fwd(Args args) {
    extern __shared__ __attribute__((aligned(16))) unsigned char lds[];
    Frame F;
    F.lds = (LAS unsigned char*)lds;
    F.MISC = (volatile LAS unsigned*)(F.lds + MISC_OFF);
    int c = 0;
#define REFRESH() do { int t_ = threadIdx.x, b_ = blockIdx.x; asm volatile("" : "+v"(t_)); asm volatile("" : "+s"(b_)); F.tid = t_; F.lane = t_ & 63; F.wave = __builtin_amdgcn_readfirstlane(t_ >> 6); \
        F.G = NCU; F.vcu = (b_ % 8) * (NCU / 8) + b_ / 8; c = b_; \
        unsigned lb_ = (unsigned)(uintptr_t)(LAS unsigned char*)lds; asm volatile("" : "+s"(lb_)); F.lds = (LAS unsigned char*)(uintptr_t)lb_; F.MISC = (volatile LAS unsigned*)(F.lds + MISC_OFF); } while (0)
    REFRESH();
    F.ws = args.ws; F.out = args.out; F.ctl = (gu32*)(args.ws + WS_CTL);
    for (int u = F.tid; u < (LDS_BYTES - LDSCTL_OFF) / 4; u += NWAVES * 64) ((LAS unsigned*)(F.lds + LDSCTL_OFF))[u] = 0u;
    __syncthreads();
    if (F.tid < 24) *(LAS unsigned long long*)(F.lds + PTRS_OFF + 8 * F.tid) = (unsigned long long)args.in[F.tid];
    LDS_WAIT(); __syncthreads();
    (void)xcd_barrier_post((unsigned*)(F.ctl + CW_BAR), F.MISC + 8);
#define GRID_BAR() do { XcdBarrier b_; b_.bar = (unsigned*)(F.ws + WS_CTL) + CW_BAR; b_.x = xb_xcc_id(); asm volatile("" : "+s"(b_.x)); b_.st = F.MISC + 8; xcd_barrier(b_); } while (0)
    float* SS = (float*)(F.ws + WS_SS);

    p0_prologue(F);
    GRID_BAR();
    for (int l = 0; l < DEPTH; ++l) {
        const float* xres = (l == 0) ? inp(F, 0) : F.out;
        REFRESH();
        logf_pass(F, l);
        { pg8::GemmProj g{wsb(F, WS_XB), wlay(F, l, OW_IN), wsb(F, WS_HM), wlay(F, 0, OW_XKV), LW / 2, D, D, D};
          pg8::StaticOrder S; S.init(TOK, l == 0 ? 11 * 256 : 9 * 256, F.G, c);
          pg8::EpiProj E{wsb(F, WS_PA), wsb(F, WS_Q), wsb(F, WS_K), wsb(F, WS_V), wsb(F, WS_ZC), SS, attn_body::C2, wsb(F, WS_XKV0), wsb(F, WS_XKV1)};
          pg8::gemm_phase<pg8::EpiProj, pg8::StaticOrder, pg8::GemmProj, true, true>(F.lds + RING_OFF, g, S, E); }
        GRID_BAR();
        REFRESH();
        {
            const int bh = F.vcu >> 2, s4 = F.vcu & 3;
            LAS float* nb = (LAS float*)(F.lds + RING_OFF + attn_body::LDS_NB);
            cumsum_bias(F, bh, nb, (LAS float*)(F.lds + RING_OFF + attn_body::LDS_NB + 8192));
            attn_body::attn_unit<8>(bh >> 3, bh & 7, 7 - s4, (const attn_body::bf16*)wsb(F, WS_Q), (const attn_body::bf16*)wsb(F, WS_K), (const attn_body::bf16*)wsb(F, WS_V), (attn_body::bf16*)wsb(F, WS_Q), (char*)F.lds + RING_OFF);
            attn_body::attn_unit<8>(bh >> 3, bh & 7, s4, (const attn_body::bf16*)wsb(F, WS_Q), (const attn_body::bf16*)wsb(F, WS_K), (const attn_body::bf16*)wsb(F, WS_V), (attn_body::bf16*)wsb(F, WS_Q), (char*)F.lds + RING_OFF);
            pool_diff(F);
            sgu_unit(F, l, 2 * F.vcu); sgu_unit(F, l, 2 * F.vcu + 1);
        }
        GRID_BAR();
        REFRESH();
        {
            pg8::StaticOrder S; S.init(TOK, D, F.G, c);
            const float* bg = inp(F, 13) + (size_t)l * 3 * D;
            { pg8::GemmP g{wsb(F, WS_DD), wlay(F, l, OW_A), 256, 256, 256}; pg8::EpiStore<0, false, false> E{wsb(F, WS_T2), D, nullptr, 1.f};
              pg8::gemm_phase<pg8::EpiStore<0, false, false>, pg8::StaticOrder, pg8::GemmP, true, true>(F.lds + RING_OFF, g, S, E); }
            { pg8::GemmP g{wsb(F, WS_XB), wlay(F, l, OW_G), D, D, D}; pg8::EpiGate<true> E{wsb(F, WS_T2), wsb(F, WS_MG), bg, SS};
              pg8::gemm_phase<pg8::EpiGate<true>, pg8::StaticOrder, pg8::GemmP, true, true>(F.lds + RING_OFF, g, S, E); }
            { pg8::GemmP g{wsb(F, WS_Q), wlay(F, l, OW_B), 512, 512, 512}; pg8::EpiStore<0, false, false> E{wsb(F, WS_T2), D, nullptr, 1.f};
              pg8::gemm_phase<pg8::EpiStore<0, false, false>, pg8::StaticOrder, pg8::GemmP, true, true>(F.lds + RING_OFF, g, S, E); }
            { pg8::GemmP g{wsb(F, WS_XB), wlay(F, l, OW_G) + (size_t)D * D, D, D, D}; pg8::EpiGate<false> E{wsb(F, WS_T2), wsb(F, WS_MG), bg + D, SS};
              pg8::gemm_phase<pg8::EpiGate<false>, pg8::StaticOrder, pg8::GemmP, true, true>(F.lds + RING_OFF, g, S, E); }
            { pg8::GemmP g{wsb(F, WS_SG), wlay(F, l, OW_C), 256, 256, 256}; pg8::EpiStore<0, false, false> E{wsb(F, WS_T2), D, nullptr, 1.f};
              pg8::gemm_phase<pg8::EpiStore<0, false, false>, pg8::StaticOrder, pg8::GemmP, true, true>(F.lds + RING_OFF, g, S, E); }
            { pg8::GemmP g{wsb(F, WS_XB), wlay(F, l, OW_G) + (size_t)2 * D * D, D, D, D}; pg8::EpiGate<false> E{wsb(F, WS_T2), wsb(F, WS_MG), bg + 2 * D, SS};
              pg8::gemm_phase<pg8::EpiGate<false>, pg8::StaticOrder, pg8::GemmP, true, true>(F.lds + RING_OFF, g, S, E); }
        }
        GRID_BAR();
        REFRESH();
        { pg8::GemmP g{wsb(F, WS_MG), wlay(F, l, OW_OUT), D, D, D}; pg8::StaticOrder S; S.init(TOK, D, F.G, c); pg8::EpiRes E{xres, F.out, wsb(F, WS_XB), SS};
          pg8::gemm_phase<pg8::EpiRes, pg8::StaticOrder, pg8::GemmP, true, true>(F.lds + RING_OFF, g, S, E); }
        GRID_BAR();
        REFRESH();
        {
            pg8::StaticOrder S; S.init(TOK, D, F.G, c);
            const bf16* xk = wsb(F, l == 0 ? WS_XKV0 : WS_XKV1); const bf16* xvt = xk + (size_t)BATCH * 4 * 65536;
            { pg8::GemmP g{wsb(F, WS_XB), wlay(F, l, OW_XQ), D, D, D}; pg8::EpiStore<0, true, true> E{wsb(F, WS_XQH), 256, SS, 0.0625f * LOG2E};
              pg8::gemm_phase<pg8::EpiStore<0, true, true>, pg8::StaticOrder, pg8::GemmP, true, true>(F.lds + RING_OFF, g, S, E); }
            { pg8::GemmX g{wsb(F, WS_XQH), xk, 256, 256, 256}; pg8::EpiSoftmax E{wsb(F, WS_PP)};
              pg8::gemm_phase<pg8::EpiSoftmax, pg8::StaticOrder, pg8::GemmX, false, true>(F.lds + RING_OFF, g, S, E); }
            { pg8::GemmX g{wsb(F, WS_PP), xvt, 256, 256, 256}; pg8::EpiStore<0, false, false> E{wsb(F, WS_XO), D, nullptr, 1.f};
              pg8::gemm_phase<pg8::EpiStore<0, false, false>, pg8::StaticOrder, pg8::GemmX, true, true>(F.lds + RING_OFF, g, S, E); }
        }
        GRID_BAR();
        REFRESH();
        { pg8::GemmP g{wsb(F, WS_XO), wlay(F, l, OW_XO), D, D, D}; pg8::StaticOrder S; S.init(TOK, D, F.G, c); pg8::EpiRes E{F.out, F.out, wsb(F, WS_XB), SS};
          pg8::gemm_phase<pg8::EpiRes, pg8::StaticOrder, pg8::GemmP, true, true>(F.lds + RING_OFF, g, S, E); }
        GRID_BAR();
        REFRESH();
        { pg8::GemmP g{wsb(F, WS_XB), wlay(F, l, OW_FF1), D, D, D}; pg8::StaticOrder S; S.init(TOK, FF, F.G, c); pg8::EpiStore<1, true, false> E{wsb(F, WS_FFH), FF, SS, 1.f};
          pg8::gemm_phase<pg8::EpiStore<1, true, false>, pg8::StaticOrder, pg8::GemmP, true, true>(F.lds + RING_OFF, g, S, E); }
        GRID_BAR();
        REFRESH();
        { pg8::GemmP g{wsb(F, WS_FFH), wlay(F, l, OW_FF2), FF, FF, FF}; pg8::StaticOrder S; S.init(TOK, D, F.G, c); pg8::EpiRes E{F.out, F.out, wsb(F, WS_XB), SS};
          pg8::gemm_phase<pg8::EpiRes, pg8::StaticOrder, pg8::GemmP, true, true>(F.lds + RING_OFF, g, S, E); }
        GRID_BAR();
    }
    REFRESH();
    final_norm(F);
    if (__hip_atomic_load((gu32*)((unsigned*)(F.ctl + CW_BAR) + XB_TMO), RLX_AGENT) != 0u && blockIdx.x == 0 && F.tid < 64) F.out[F.tid] = __builtin_nanf("");
}

extern "C" void kernel_launch(void* const* d_in, const int* in_sizes, int n_in, void* d_out, int out_size, void* d_ws, size_t ws_size, hipStream_t stream) {
    static int grid = 0;
    if (grid == 0) {
        if (n_in != 24 || out_size != TOK * D || ws_size < WS_END) { fprintf(stderr, "kernel_launch: unexpected problem shape (n_in %d, out %d, ws %zu); nothing launched\n", n_in, out_size, ws_size); grid = -1; return; }
        int dev = 0, cus = 0;
        if (hipGetDevice(&dev) != hipSuccess || hipDeviceGetAttribute(&cus, hipDeviceAttributeMultiprocessorCount, dev) != hipSuccess) { grid = -1; return; }
        if (hipFuncSetAttribute((const void*)mega_fwd, hipFuncAttributeMaxDynamicSharedMemorySize, LDS_BYTES) != hipSuccess) { fprintf(stderr, "kernel_launch: hipFuncSetAttribute failed\n"); grid = -1; return; }
        int per_cu = 0;
        if (hipOccupancyMaxActiveBlocksPerMultiprocessor(&per_cu, (const void*)mega_fwd, NWAVES * 64, LDS_BYTES) != hipSuccess || per_cu < 1) fprintf(stderr, "kernel_launch: occupancy query reports %d workgroups per CU\n", per_cu);
        (void)hipGetLastError();
        if (cus != 256) fprintf(stderr, "kernel_launch: built for a 256-CU device, found %d CUs\n", cus);
        grid = NCU;
    }
    if (grid < 0) return;
    (void)in_sizes;
    if (hipMemsetAsync((char*)d_ws + WS_CTL, 0, CTL_ZERO_BYTES, stream) != hipSuccess) return;
    Args a{};
    for (int i = 0; i < 24; ++i) a.in[i] = (const float*)d_in[i];
    a.out = (float*)d_out; a.ws = (unsigned char*)d_ws;
    hipLaunchKernelGGL(mega_fwd, dim3(grid), dim3(NWAVES * 64), LDS_BYTES, stream, a);
}
```

```cpp
#include <hip/hip_runtime.h>
#include <cstdio>
#include <cstdint>
namespace pg8 {
#define PG8_LAS __attribute__((address_space(3)))
typedef unsigned short bf16_t;
typedef short bf16x8 __attribute__((ext_vector_type(8)));
typedef float f32x4 __attribute__((ext_vector_type(4)));
typedef unsigned u32x4 __attribute__((ext_vector_type(4)));
constexpr int BM = 256, BK = 64, HALF = 128, HTB = HALF * BK * 2  , STAGE_BYTES = 8 * HTB, NXCD = 8, WGM = 8;

__host__ __device__ __forceinline__ int lds_byte(int r, int c) { const int st = (r >> 4) * 2 + (c >> 5), rr = r & 15, cc = c & 31, ob = rr * 64 + cc * 2; return st * 1024 + (ob ^ (((ob >> 9) & 1) << 5)); }
__host__ __device__ __forceinline__ void stage_rc(int b, int& R, int& C) { const int st = b / 1024, sb = b % 1024, swz = sb ^ (((sb >> 9) & 1) << 5); R = (st >> 1) * 16 + swz / 64; C = (st & 1) * 32 + (swz % 64) / 2; }
__host__ __device__ __forceinline__ int perm32(int rho) { const int n = rho >> 4, i = rho & 15; return 8 * (i >> 2) + 4 * n + (i & 3); }

struct Unit { int pm, pn; };

struct StaticOrder {
    int nM, nN, nwg, G, c;
    __host__ __device__ void init(int M, int N, int G_, int c_) { nM = M / BM; nN = N / BM; nwg = nM * nN; G = G_; c = c_; }
    __host__ __device__ bool next(int i, Unit& u) const {
        const long L = (long)i * G + c; if (L >= nwg) return false;
        int wgid = (int)L; { const int q = nwg / NXCD, r = nwg % NXCD, xcd = wgid % NXCD, off = wgid / NXCD; wgid = (xcd < r ? xcd * (q + 1) : r * (q + 1) + (xcd - r) * q) + off; }
        const int nig = WGM * nN, gid = wgid / nig, fm = gid * WGM, gsz = (nM - fm) < WGM ? (nM - fm) : WGM;
        u.pm = fm + ((wgid % nig) % gsz); u.pn = (wgid % nig) / gsz; return true;
    }
    __device__ __forceinline__ void a_ready(const Unit&) const {}
    __device__ __forceinline__ void done(const Unit&) const {}
};
__device__ __forceinline__ unsigned cvt_pk_bf16(float lo, float hi) { unsigned r; asm volatile("v_cvt_pk_bf16_f32 %0, %1, %2" : "=v"(r) : "v"(lo), "v"(hi)); return r; }
template <class Epi, class Sched, class G, bool ALIGN_EPI = false, bool SP2 = false>
__device__ __forceinline__ void gemm_phase(PG8_LAS unsigned char* lds, const G g, const Sched& S, const Epi& E) {
    int tid_ = threadIdx.x; asm volatile("" : "+v"(tid_));
    const int tid = tid_, wid = __builtin_amdgcn_readfirstlane(tid >> 6), lane = tid & 63, wr = wid >> 2, wc = wid & 3, fr = lane & 15, fq = lane >> 4;
    const int K = g.K, nt = K / BK;
    unsigned voffA[2], voffB[2];
#pragma unroll
    for (int i = 0; i < 2; ++i) { int R, C; stage_rc(tid * 16 + i * 8192, R, C); const int Rb = Epi::PERM ? ((R & ~31) + perm32(R & 31)) : R;
        voffA[i] = (unsigned)(R * g.lda + C) * 2u; voffB[i] = (unsigned)(Rb * g.ldb + C) * 2u; }
    const size_t kstep = (size_t)(BK * 2);
    const size_t hstepA = (size_t)HALF * g.lda * 2, hstepB = (size_t)HALF * g.ldb * 2;
    const unsigned ldsw = (unsigned)wid * 1024u;
    const int aoff = lds_byte(wr * 64 + fr, fq * 8), boff = lds_byte(wc * 32 + fr, fq * 8);
#define PG8_SA(b, h) (((b) * 2 + (h)) * HTB)
#define PG8_SB(b, h) ((4 + (b) * 2 + (h)) * HTB)
#define PG8_STAGE(bufoff, gbase, voff) do { _Pragma("unroll") for (int _i = 0; _i < 2; ++_i) \
        __builtin_amdgcn_global_load_lds((const unsigned*)((const char*)(gbase) + (voff)[_i]), (PG8_LAS unsigned*)(lds + (bufoff) + ldsw + _i * 8192), 16, 0, 0); } while (0)
#define PG8_LDA(dst, b, h) do { _Pragma("unroll") for (int m = 0; m < 4; ++m) _Pragma("unroll") for (int k = 0; k < 2; ++k) dst[m][k] = *(const PG8_LAS bf16x8*)(lds + PG8_SA(b, h) + aoff + m * 2048 + k * 1024); } while (0)
#define PG8_LDB(dst, b, h) do { _Pragma("unroll") for (int n = 0; n < 2; ++n) _Pragma("unroll") for (int k = 0; k < 2; ++k) dst[n][k] = *(const PG8_LAS bf16x8*)(lds + PG8_SB(b, h) + boff + n * 2048 + k * 1024); } while (0)
#define PG8_MMA(ai, bj, At, Bt) do { __builtin_amdgcn_s_setprio(1); _Pragma("unroll") for (int m = 0; m < 4; ++m) _Pragma("unroll") for (int n = 0; n < 2; ++n) _Pragma("unroll") for (int k = 0; k < 2; ++k) \
        acc[ai][bj][m][n] = __builtin_amdgcn_mfma_f32_16x16x32_bf16(Bt[n][k], At[m][k], acc[ai][bj][m][n], 0, 0, 0); __builtin_amdgcn_s_setprio(0); } while (0)
#define PG8_WAIT_V(n) asm volatile("s_waitcnt vmcnt(" #n ")" ::: "memory")
#define PG8_WAIT_L(n) asm volatile("s_waitcnt lgkmcnt(" #n ")" ::: "memory")
#define PG8_BAR __builtin_amdgcn_s_barrier()
#define PG8_SCHED __builtin_amdgcn_sched_barrier(0)
    Unit cur, nxt; int ui = 0;
    if (!S.next(0, cur)) return;
    f32x4 acc[2][2][4][2];
#pragma unroll
    for (int a = 0; a < 2; ++a)
#pragma unroll
        for (int b = 0; b < 2; ++b)
#pragma unroll
            for (int m = 0; m < 4; ++m)
#pragma unroll
                for (int n = 0; n < 2; ++n) acc[a][b][m][n] = (f32x4){0.f, 0.f, 0.f, 0.f};
    bf16x8 At[4][2], B0[2][2], B1[2][2];
    const char* cA = g.a_ptr(cur); const char* cB = g.b_ptr(cur);
    S.a_ready(cur);
    if constexpr (SP2) {
        PG8_STAGE(PG8_SB(0, 0), cB, voffB); PG8_STAGE(PG8_SB(0, 1), cB + hstepB, voffB); PG8_STAGE(PG8_SA(0, 0), cA, voffA); PG8_STAGE(PG8_SA(0, 1), cA + hstepA, voffA);
        if (wr == 1) PG8_BAR;
        PG8_WAIT_V(2); PG8_BAR;
        PG8_STAGE(PG8_SB(1, 0), cB + kstep, voffB); PG8_STAGE(PG8_SA(1, 0), cA + kstep, voffA); PG8_STAGE(PG8_SB(1, 1), cB + hstepB + kstep, voffB);
        PG8_WAIT_V(6); PG8_BAR;
    } else {
        PG8_STAGE(PG8_SB(0, 0), cB, voffB); PG8_STAGE(PG8_SA(0, 0), cA, voffA); PG8_STAGE(PG8_SB(0, 1), cB + hstepB, voffB); PG8_STAGE(PG8_SA(0, 1), cA + hstepA, voffA);
        if (wr == 1) PG8_BAR;
        PG8_WAIT_V(4); PG8_BAR;
        PG8_STAGE(PG8_SB(1, 0), cB + kstep, voffB); PG8_STAGE(PG8_SA(1, 0), cA + kstep, voffA); PG8_STAGE(PG8_SB(1, 1), cB + hstepB + kstep, voffB);
        PG8_WAIT_V(6); PG8_BAR;
    }
    for (;;) {
        const bool has_next = S.next(ui + 1, nxt);
        const char* nA = has_next ? g.a_ptr(nxt) : cA; const char* nB = has_next ? g.b_ptr(nxt) : cB;
        for (int t = 0; t < nt; t += 2) {
            const bool last = (t == nt - 2);
            const char* a1 = cA + (size_t)(t + 1) * kstep;
            const char* a2 = last ? nA : cA + (size_t)(t + 2) * kstep; const char* b2 = last ? nB : cB + (size_t)(t + 2) * kstep;
            const char* a3 = a2 + kstep; const char* b3 = b2 + kstep;
            if (last && has_next) S.a_ready(nxt);
            if constexpr (SP2) {
            PG8_LDB(B0, 0, 0); PG8_LDB(B1, 0, 1); PG8_SCHED; PG8_LDA(At, 0, 0); PG8_STAGE(PG8_SA(1, 1), a1 + hstepA, voffA);
            PG8_WAIT_V(8); PG8_WAIT_L(0); PG8_BAR; PG8_MMA(0, 0, At, B0); PG8_MMA(0, 1, At, B1); PG8_BAR; PG8_SCHED;
            PG8_LDA(At, 0, 1); PG8_STAGE(PG8_SB(0, 0), b2, voffB); PG8_STAGE(PG8_SB(0, 1), b2 + hstepB, voffB); PG8_STAGE(PG8_SA(0, 0), a2, voffA);
            PG8_WAIT_V(8); PG8_WAIT_L(0); PG8_BAR; PG8_MMA(1, 0, At, B0); PG8_MMA(1, 1, At, B1); PG8_BAR; PG8_SCHED;
            PG8_LDB(B0, 1, 0); PG8_LDB(B1, 1, 1); PG8_SCHED; PG8_LDA(At, 1, 0); PG8_STAGE(PG8_SA(0, 1), a2 + hstepA, voffA);
            PG8_WAIT_V(8); PG8_WAIT_L(0); PG8_BAR; PG8_MMA(0, 0, At, B0); PG8_MMA(0, 1, At, B1); PG8_BAR; PG8_SCHED;
            PG8_LDA(At, 1, 1); PG8_STAGE(PG8_SB(1, 0), b3, voffB); PG8_STAGE(PG8_SB(1, 1), b3 + hstepB, voffB); PG8_STAGE(PG8_SA(1, 0), a3, voffA);
            PG8_WAIT_V(8); PG8_WAIT_L(0); PG8_BAR; PG8_MMA(1, 0, At, B0); PG8_MMA(1, 1, At, B1); PG8_BAR; PG8_SCHED;
            } else {
            PG8_LDB(B0, 0, 0); PG8_SCHED; PG8_LDA(At, 0, 0); PG8_STAGE(PG8_SA(1, 1), a1 + hstepA, voffA);
            PG8_WAIT_L(8); PG8_BAR; PG8_WAIT_L(0); PG8_MMA(0, 0, At, B0); PG8_BAR; PG8_SCHED;
            PG8_LDB(B1, 0, 1); PG8_STAGE(PG8_SB(0, 0), b2, voffB);
            PG8_BAR; PG8_WAIT_L(0); PG8_MMA(0, 1, At, B1); PG8_BAR;
            PG8_LDA(At, 0, 1); PG8_STAGE(PG8_SA(0, 0), a2, voffA);
            PG8_BAR; PG8_WAIT_L(0); PG8_MMA(1, 0, At, B0); PG8_BAR; PG8_SCHED;
            PG8_STAGE(PG8_SB(0, 1), b2 + hstepB, voffB);
            PG8_WAIT_V(6); PG8_BAR; PG8_MMA(1, 1, At, B1); PG8_BAR;
            PG8_LDB(B0, 1, 0); PG8_SCHED; PG8_LDA(At, 1, 0); PG8_STAGE(PG8_SA(0, 1), a2 + hstepA, voffA);
            PG8_WAIT_L(8); PG8_BAR; PG8_WAIT_L(0); PG8_MMA(0, 0, At, B0); PG8_BAR; PG8_SCHED;
            PG8_LDB(B1, 1, 1); PG8_STAGE(PG8_SB(1, 0), b3, voffB);
            PG8_BAR; PG8_WAIT_L(0); PG8_MMA(0, 1, At, B1); PG8_BAR;
            PG8_LDA(At, 1, 1); PG8_STAGE(PG8_SA(1, 0), a3, voffA);
            PG8_BAR; PG8_WAIT_L(0); PG8_MMA(1, 0, At, B0); PG8_BAR; PG8_SCHED;
            PG8_STAGE(PG8_SB(1, 1), b3 + hstepB, voffB);
            PG8_WAIT_V(6); PG8_BAR; PG8_MMA(1, 1, At, B1); PG8_BAR;
            }
        }
        if constexpr (ALIGN_EPI) { if (wr == 0) PG8_BAR; }
        if constexpr (!Epi::AFTER_DRAIN) { int te_ = threadIdx.x; asm volatile("" : "+v"(te_)); E(acc, cur, wr, wc, te_ & 15, (te_ & 63) >> 4); S.done(cur); }
        if (!has_next) break;
#pragma unroll
        for (int a = 0; a < 2; ++a)
#pragma unroll
            for (int b = 0; b < 2; ++b)
#pragma unroll
                for (int m = 0; m < 4; ++m)
#pragma unroll
                    for (int n = 0; n < 2; ++n) acc[a][b][m][n] = (f32x4){0.f, 0.f, 0.f, 0.f};
        cur = nxt; cA = nA; cB = nB; ++ui;
        if constexpr (ALIGN_EPI) { if (wr == 1) PG8_BAR; }
    }
    PG8_WAIT_V(0);
    if constexpr (!ALIGN_EPI) { if (wr == 0) PG8_BAR; }
    PG8_BAR;
    if constexpr (Epi::AFTER_DRAIN) { int te_ = threadIdx.x; asm volatile("" : "+v"(te_)); E.fused(acc, cur, wr, wc, te_ & 15, (te_ & 63) >> 4, lds, wid, te_ & 63); S.done(cur); }
#undef PG8_SA
#undef PG8_SB
#undef PG8_STAGE
#undef PG8_LDA
#undef PG8_LDB
#undef PG8_MMA
#undef PG8_WAIT_V
#undef PG8_WAIT_L
#undef PG8_BAR
#undef PG8_SCHED
}
constexpr int TOK = 16384;
constexpr float RMS_EPS = 1e-6f;
struct GemmP { const bf16_t* A; const bf16_t* Bt; int lda, ldb, K;
    __device__ __forceinline__ const char* a_ptr(const Unit& u) const { return (const char*)(A + (size_t)u.pm * BM * lda); }
    __device__ __forceinline__ const char* b_ptr(const Unit& u) const { return (const char*)(Bt + (size_t)u.pn * BM * ldb); } };
struct GemmX { const bf16_t* A; const bf16_t* Bt; int lda, ldb, K;
    __device__ __forceinline__ const char* a_ptr(const Unit& u) const { return (const char*)(A + ((size_t)u.pn * TOK + (size_t)u.pm * BM) * 256); }
    __device__ __forceinline__ const char* b_ptr(const Unit& u) const { return (const char*)(Bt + (size_t)((u.pm >> 3) * 4 + u.pn) * 65536); } };

struct GemmProj { const bf16_t* XB; const bf16_t* WIN; const bf16_t* HM; const bf16_t* WKV0; size_t wkv_lstride; int lda, ldb, K;
    __device__ __forceinline__ const char* a_ptr(const Unit& u) const {
        if (u.pn < 9) return (const char*)(XB + (size_t)u.pm * BM * 1024);
        const int idx = 2 * u.pm + (u.pn - 9), l = idx >> 6, part = (idx >> 5) & 1, b = (idx >> 2) & 7, h = idx & 3;
        return part == 0 ? (const char*)(HM + ((size_t)l * 2048 + b * 256) * 1024) : (const char*)(WKV0 + (size_t)l * wkv_lstride + (size_t)(1024 + h * 256) * 1024); }
    __device__ __forceinline__ const char* b_ptr(const Unit& u) const {
        if (u.pn < 9) return (const char*)(WIN + (size_t)u.pn * BM * 1024);
        const int idx = 2 * u.pm + (u.pn - 9), l = idx >> 6, part = (idx >> 5) & 1, b = (idx >> 2) & 7, h = idx & 3;
        return part == 0 ? (const char*)(WKV0 + (size_t)l * wkv_lstride + (size_t)(h * 256) * 1024) : (const char*)(HM + ((size_t)l * 2048 + b * 256) * 1024); } };
typedef unsigned u32x2 __attribute__((ext_vector_type(2)));
template <bool MAX> __device__ __forceinline__ float comb16(float s) { const auto r = __builtin_amdgcn_permlane16_swap(__float_as_uint(s), __float_as_uint(s), false, false);
    const float a = __uint_as_float(r[0]), b = __uint_as_float(r[1]); return MAX ? __builtin_fmaxf(a, b) : a + b; }
template <bool MAX> __device__ __forceinline__ float comb32(float s) { const auto r = __builtin_amdgcn_permlane32_swap(__float_as_uint(s), __float_as_uint(s), false, false);
    const float a = __uint_as_float(r[0]), b = __uint_as_float(r[1]); return MAX ? __builtin_fmaxf(a, b) : a + b; }
__device__ __forceinline__ float bf_lo(unsigned w) { return __uint_as_float(w << 16); }
__device__ __forceinline__ float bf_hi(unsigned w) { return __uint_as_float(w & 0xffff0000u); }
__device__ __forceinline__ float fast_sigmoid(float z) { return __builtin_amdgcn_rcpf(1.0f + __builtin_amdgcn_exp2f(-1.4426950408889634f * z)); }
__device__ __forceinline__ float gelu_tanh(float x) {
    const float u = x * (0.7978845608028654f + 0.035677408136300125f * x * x);
    return x * __builtin_amdgcn_rcpf(1.0f + __builtin_amdgcn_exp2f(-2.8853900817779268f * u)); }
__device__ __forceinline__ void load_rstd(float (&rs)[2][4], const float* SS, const Unit& u, int wr, int fr, int fq) {
#pragma unroll
    for (int ai = 0; ai < 2; ++ai)
#pragma unroll
        for (int m = 0; m < 4; ++m) { const f32x4 a = *((const f32x4*)(SS + (size_t)(u.pm * BM + ai * HALF + wr * 64 + m * 16 + fr) * 16) + fq);
            float s = (a[0] + a[1]) + (a[2] + a[3]); s = comb16<false>(s); s = comb32<false>(s);
            rs[ai][m] = __builtin_amdgcn_rsqf(s * (1.0f / 1024.0f) + RMS_EPS); }
}
struct EpiProj { static constexpr bool PERM = true, AFTER_DRAIN = false;
    bf16_t *PA, *Q, *K, *V, *ZC; const float* SS; float qscale; bf16_t *XKV0, *XKV1;
    __device__ __forceinline__ void operator()(const f32x4 (&acc)[2][2][4][2], const Unit& u, int wr, int wc, int fr, int fq) const {
        const int pn = u.pn; bf16_t* base; int ldc, colt, mode;
        if (pn >= 9) {
            const int idx = 2 * u.pm + (pn - 9), l = idx >> 6, part = (idx >> 5) & 1, b = (idx >> 2) & 7, h = idx & 3;
            bf16_t* tb = (l == 0 ? XKV0 : XKV1) + (size_t)(part * 32 + b * 4 + h) * 65536; const int r0 = wr * 64 + fr, c0 = wc * 32 + 8 * fq;
#pragma unroll
            for (int ai = 0; ai < 2; ++ai)
#pragma unroll
                for (int m = 0; m < 4; ++m) { bf16_t* rowp = tb + (size_t)(r0 + ai * HALF + m * 16) * 256 + c0;
#pragma unroll
                    for (int bj = 0; bj < 2; ++bj) { const f32x4 v0 = acc[ai][bj][m][0], v1 = acc[ai][bj][m][1];
                        u32x4 w; w.x = cvt_pk_bf16(v0[0], v0[1]); w.y = cvt_pk_bf16(v0[2], v0[3]); w.z = cvt_pk_bf16(v1[0], v1[1]); w.w = cvt_pk_bf16(v1[2], v1[3]);
                        *(u32x4*)(rowp + bj * HALF) = w; } }
            return; }
        if (pn == 0) { base = PA; ldc = 256; colt = 0; mode = 0; }
        else if (pn <= 2) { base = Q; ldc = 512; colt = (pn - 1) * 256; mode = 1; }
        else if (pn <= 4) { base = K; ldc = 512; colt = (pn - 3) * 256; mode = 0; }
        else if (pn <= 6) { base = V; ldc = 512; colt = (pn - 5) * 256; mode = 0; }
        else { base = ZC; ldc = 512; colt = (pn - 7) * 256; mode = 2; }
        float rs[2][4]; load_rstd(rs, SS, u, wr, fr, fq);
        const float sc = (mode == 1) ? qscale : 1.0f;
        const int row0 = u.pm * BM + wr * 64 + fr, col0 = colt + wc * 32 + 8 * fq;
#pragma unroll
        for (int ai = 0; ai < 2; ++ai)
#pragma unroll
            for (int m = 0; m < 4; ++m) { bf16_t* rowp = base + (size_t)(row0 + ai * HALF + m * 16) * ldc + col0; const float r = rs[ai][m] * sc;
#pragma unroll
                for (int bj = 0; bj < 2; ++bj) { f32x4 v0 = acc[ai][bj][m][0] * r, v1 = acc[ai][bj][m][1] * r;
                    if (mode == 2) { v0 = (f32x4){gelu_tanh(v0[0]), gelu_tanh(v0[1]), gelu_tanh(v0[2]), gelu_tanh(v0[3])}; v1 = (f32x4){gelu_tanh(v1[0]), gelu_tanh(v1[1]), gelu_tanh(v1[2]), gelu_tanh(v1[3])}; }
                    u32x4 w; w.x = cvt_pk_bf16(v0[0], v0[1]); w.y = cvt_pk_bf16(v0[2], v0[3]); w.z = cvt_pk_bf16(v1[0], v1[1]); w.w = cvt_pk_bf16(v1[2], v1[3]);
                    *(u32x4*)(rowp + bj * HALF) = w; } }
    }
};
struct EpiTile { static constexpr bool PERM = true, AFTER_DRAIN = false;
    bf16_t* O; int mm, mn;
    __device__ __forceinline__ void operator()(const f32x4 (&acc)[2][2][4][2], const Unit& u, int wr, int wc, int fr, int fq) const {
        bf16_t* base = O + (size_t)(mm * u.pm + mn * u.pn) * 65536; const int row0 = wr * 64 + fr, col0 = wc * 32 + 8 * fq;
#pragma unroll
        for (int ai = 0; ai < 2; ++ai)
#pragma unroll
            for (int m = 0; m < 4; ++m) { bf16_t* rowp = base + (size_t)(row0 + ai * HALF + m * 16) * 256 + col0;
#pragma unroll
                for (int bj = 0; bj < 2; ++bj) { const f32x4 v0 = acc[ai][bj][m][0], v1 = acc[ai][bj][m][1];
                    u32x4 w; w.x = cvt_pk_bf16(v0[0], v0[1]); w.y = cvt_pk_bf16(v0[2], v0[3]); w.z = cvt_pk_bf16(v1[0], v1[1]); w.w = cvt_pk_bf16(v1[2], v1[3]);
                    *(u32x4*)(rowp + bj * HALF) = w; } }
    }
};
template <int ACT  , bool ROWSCALE, bool HEADMAJOR> struct EpiStore { static constexpr bool PERM = true, AFTER_DRAIN = false;
    bf16_t* O; int ldc; const float* SS; float scale;
    __device__ __forceinline__ void operator()(const f32x4 (&acc)[2][2][4][2], const Unit& u, int wr, int wc, int fr, int fq) const {
        float rs[2][4];
        if (ROWSCALE) load_rstd(rs, SS, u, wr, fr, fq);
        bf16_t* base = O; int colt = u.pn * BM;
        if (HEADMAJOR) { base += (size_t)u.pn * TOK * 256; colt = 0; }
        const int row0 = u.pm * BM + wr * 64 + fr, col0 = colt + wc * 32 + 8 * fq;
#pragma unroll
        for (int ai = 0; ai < 2; ++ai)
#pragma unroll
            for (int m = 0; m < 4; ++m) { bf16_t* rowp = base + (size_t)(row0 + ai * HALF + m * 16) * ldc + col0; const float r = ROWSCALE ? rs[ai][m] * scale : scale;
#pragma unroll
                for (int bj = 0; bj < 2; ++bj) { f32x4 v0 = acc[ai][bj][m][0] * r, v1 = acc[ai][bj][m][1] * r;
                    if (ACT == 1) {
#pragma unroll
                        for (int i = 0; i < 4; ++i) { const float a = __builtin_fmaxf(v0[i], 0.f), b = __builtin_fmaxf(v1[i], 0.f); v0[i] = a * a; v1[i] = b * b; } }
                    u32x4 w; w.x = cvt_pk_bf16(v0[0], v0[1]); w.y = cvt_pk_bf16(v0[2], v0[3]); w.z = cvt_pk_bf16(v1[0], v1[1]); w.w = cvt_pk_bf16(v1[2], v1[3]);
                    *(u32x4*)(rowp + bj * HALF) = w; } }
    }
};
template <bool FIRST> struct EpiGate { static constexpr bool PERM = true, AFTER_DRAIN = false;
    const bf16_t* Y; bf16_t* MG; const float* bias; const float* SS;
    __device__ __forceinline__ void operator()(const f32x4 (&acc)[2][2][4][2], const Unit& u, int wr, int wc, int fr, int fq) const {
        float rs[2][4]; load_rstd(rs, SS, u, wr, fr, fq);
        const int row0 = u.pm * BM + wr * 64 + fr, col0 = u.pn * BM + wc * 32 + 8 * fq;
        f32x4 bv[2][2];
#pragma unroll
        for (int bj = 0; bj < 2; ++bj)
#pragma unroll
            for (int n = 0; n < 2; ++n) bv[bj][n] = *(const f32x4*)(bias + col0 + bj * HALF + 4 * n);
#pragma unroll
        for (int ai = 0; ai < 2; ++ai)
#pragma unroll
            for (int m = 0; m < 4; ++m) { const size_t off = (size_t)(row0 + ai * HALF + m * 16) * 1024 + col0; const float r = rs[ai][m];
#pragma unroll
                for (int bj = 0; bj < 2; ++bj) { const f32x4 z0 = acc[ai][bj][m][0] * r + bv[bj][0], z1 = acc[ai][bj][m][1] * r + bv[bj][1];
                    const u32x4 y = *(const u32x4*)(Y + off + bj * HALF);
                    float o0 = fast_sigmoid(z0[0]) * bf_lo(y.x), o1 = fast_sigmoid(z0[1]) * bf_hi(y.x), o2 = fast_sigmoid(z0[2]) * bf_lo(y.y), o3 = fast_sigmoid(z0[3]) * bf_hi(y.y);
                    float o4 = fast_sigmoid(z1[0]) * bf_lo(y.z), o5 = fast_sigmoid(z1[1]) * bf_hi(y.z), o6 = fast_sigmoid(z1[2]) * bf_lo(y.w), o7 = fast_sigmoid(z1[3]) * bf_hi(y.w);
                    if (!FIRST) { const u32x4 p = *(const u32x4*)(MG + off + bj * HALF);
                        o0 += bf_lo(p.x); o1 += bf_hi(p.x); o2 += bf_lo(p.y); o3 += bf_hi(p.y); o4 += bf_lo(p.z); o5 += bf_hi(p.z); o6 += bf_lo(p.w); o7 += bf_hi(p.w); }
                    u32x4 w; w.x = cvt_pk_bf16(o0, o1); w.y = cvt_pk_bf16(o2, o3); w.z = cvt_pk_bf16(o4, o5); w.w = cvt_pk_bf16(o6, o7);
                    *(u32x4*)(MG + off + bj * HALF) = w; }
                if (m & 1) asm volatile("" ::: "memory"); }
    }
};
struct EpiRes { static constexpr bool PERM = false, AFTER_DRAIN = false;
    const float* base; float* out; bf16_t* xb; float* SS;
    __device__ __forceinline__ void operator()(const f32x4 (&acc)[2][2][4][2], const Unit& u, int wr, int wc, int fr, int fq) const {
        const int row0 = u.pm * BM + wr * 64 + fr, col0 = u.pn * BM + wc * 32 + 4 * fq;
#pragma unroll
        for (int ai = 0; ai < 2; ++ai)
#pragma unroll
            for (int m = 0; m < 4; ++m) { const int row = row0 + ai * HALF + m * 16; const size_t off = (size_t)row * 1024 + col0; float ss = 0.f;
#pragma unroll
                for (int bj = 0; bj < 2; ++bj)
#pragma unroll
                    for (int n = 0; n < 2; ++n) { const f32x4 b = *(const f32x4*)(base + off + bj * HALF + n * 16); const f32x4 v = b + acc[ai][bj][m][n];
                        *(f32x4*)(out + off + bj * HALF + n * 16) = v; ss += (v[0] * v[0] + v[1] * v[1]) + (v[2] * v[2] + v[3] * v[3]);
                        u32x2 w; w.x = cvt_pk_bf16(v[0], v[1]); w.y = cvt_pk_bf16(v[2], v[3]); *(u32x2*)(xb + off + bj * HALF + n * 16) = w; }
                ss = comb16<false>(ss); ss = comb32<false>(ss);
                if (fq == 0) SS[(size_t)row * 16 + u.pn * 4 + wc] = ss;
                if (m & 1) asm volatile("" ::: "memory"); }
    }
};
struct EpiSoftmax { static constexpr bool PERM = true, AFTER_DRAIN = true;
    bf16_t* P;
    __device__ __forceinline__ void fused(f32x4 (&acc)[2][2][4][2], const Unit& u, int wr, int wc, int fr, int fq, PG8_LAS unsigned char* lds, int wid, int lane) const {
        PG8_LAS float* Pm = (PG8_LAS float*)lds; PG8_LAS float* Ps = Pm + 1024;
#pragma unroll
        for (int ai = 0; ai < 2; ++ai)
#pragma unroll
            for (int m = 0; m < 4; ++m) { float t = -INFINITY;
#pragma unroll
                for (int bj = 0; bj < 2; ++bj)
#pragma unroll
                    for (int n = 0; n < 2; ++n) { const f32x4 x = acc[ai][bj][m][n]; t = __builtin_fmaxf(t, __builtin_fmaxf(__builtin_fmaxf(x[0], x[1]), __builtin_fmaxf(x[2], x[3]))); }
                t = comb16<true>(t); t = comb32<true>(t);
                if (fq == 0) Pm[(ai * HALF + wr * 64 + m * 16 + fr) * 4 + wc] = t; }
        asm volatile("s_waitcnt lgkmcnt(0)" ::: "memory"); __builtin_amdgcn_s_barrier(); asm volatile("" ::: "memory");
#pragma unroll
        for (int ai = 0; ai < 2; ++ai)
#pragma unroll
            for (int m = 0; m < 4; ++m) { const int r = ai * HALF + wr * 64 + m * 16 + fr; const f32x4 mm = *(const PG8_LAS f32x4*)(Pm + r * 4);
                const float mx = __builtin_fmaxf(__builtin_fmaxf(mm[0], mm[1]), __builtin_fmaxf(mm[2], mm[3])); float s = 0.f;
#pragma unroll
                for (int bj = 0; bj < 2; ++bj)
#pragma unroll
                    for (int n = 0; n < 2; ++n) { f32x4 x = acc[ai][bj][m][n];
#pragma unroll
                        for (int i = 0; i < 4; ++i) x[i] = __builtin_amdgcn_exp2f(x[i] - mx);
                        acc[ai][bj][m][n] = x; s += (x[0] + x[1]) + (x[2] + x[3]); }
                s = comb16<false>(s); s = comb32<false>(s);
                if (fq == 0) Ps[r * 4 + wc] = s; }
        asm volatile("s_waitcnt lgkmcnt(0)" ::: "memory"); __builtin_amdgcn_s_barrier(); asm volatile("" ::: "memory");
        bf16_t* base = P + ((size_t)u.pn * TOK + (size_t)u.pm * BM) * 256; const int col0 = wc * 32 + 8 * fq;
#pragma unroll
        for (int ai = 0; ai < 2; ++ai)
#pragma unroll
            for (int m = 0; m < 4; ++m) { const int r = ai * HALF + wr * 64 + m * 16 + fr; const f32x4 sm = *(const PG8_LAS f32x4*)(Ps + r * 4);
                const float inv = 1.0f / ((sm[0] + sm[1]) + (sm[2] + sm[3])); bf16_t* rowp = base + (size_t)r * 256 + col0;
#pragma unroll
                for (int bj = 0; bj < 2; ++bj) { const f32x4 v0 = acc[ai][bj][m][0] * inv, v1 = acc[ai][bj][m][1] * inv;
                    u32x4 w; w.x = cvt_pk_bf16(v0[0], v0[1]); w.y = cvt_pk_bf16(v0[2], v0[3]); w.z = cvt_pk_bf16(v1[0], v1[1]); w.w = cvt_pk_bf16(v1[2], v1[3]);
                    *(u32x4*)(rowp + bj * HALF) = w; } }
        asm volatile("s_waitcnt lgkmcnt(0)" ::: "memory"); __builtin_amdgcn_s_barrier(); asm volatile("" ::: "memory");
    }
};
}

#include <hip/hip_bf16.h>
#include <cmath>
namespace attn_body {
using bf16=__hip_bfloat16;
using bf16x8=__attribute__((ext_vector_type(8)))short;
using s16x4=__attribute__((ext_vector_type(4)))short;
using f32x16=__attribute__((ext_vector_type(16)))float;
using u32x4=__attribute__((ext_vector_type(4)))unsigned;
constexpr int BATCH=8,NHEAD=8,SEQ=2048,D=64,DM=NHEAD*D;
constexpr int NW=8,QBLK=32,QB=QBLK*NW,KVBLK=64,NQB=SEQ/QB;
constexpr int ATTN_PITCH=DM, ATTN_UNIT_ROWS=QB;
__device__ __forceinline__ int crow(int r,int hi){return (r&3)+8*(r>>2)+4*hi;}
#define SBAR() __builtin_amdgcn_sched_barrier(0)
__device__ __forceinline__ void cmask(f32x16&p0,f32x16&p1,int jb,int qrel,int hi){
  const float NEG=-INFINITY; int kb=64*jb+4*hi;
  #pragma unroll
  for(int r=0;r<16;++r){int kv=kb+(r&3)+8*(r>>2); if(kv>qrel)p0[r]=NEG; if(kv+32>qrel)p1[r]=NEG;}
}

constexpr int NSLOT=3, SLOTB=8192;
constexpr int LDS_K=0, LDS_V=NSLOT*SLOTB, LDS_WS=2*NSLOT*SLOTB, LDS_OST=LDS_WS+NW*64*4, LDS_BYTES=LDS_OST+NW*4096, LDS_NB=LDS_BYTES;
constexpr float C2=0.125f*1.4426950408889634f;
__device__ __forceinline__ void glds16(const void*gsrc,unsigned lds_dst){unsigned keep;
  asm volatile("s_mov_b32 %0, m0\n\ts_mov_b32 m0, %2\n\ts_nop 0\n\tglobal_load_lds_dwordx4 %1, off\n\ts_mov_b32 m0, %0":"=&s"(keep):"v"(gsrc),"s"(lds_dst):"memory");}
__device__ __forceinline__ float max3f(float a,float b,float c){float r;asm("v_max3_f32 %0, %1, %2, %3":"=v"(r):"v"(a),"v"(b),"v"(c));return r;}
__device__ __forceinline__ float max2f(float a,float b){float r;asm("v_max_f32_e32 %0, %1, %2":"=v"(r):"v"(a),"v"(b));return r;}
__device__ __forceinline__ float fadd_s(float a,float b){float r;asm("v_add_f32_e32 %0, %1, %2":"=v"(r):"v"(a),"v"(b));return r;}
__device__ __forceinline__ float fsub_s(float a,float b){float r;asm("v_sub_f32_e32 %0, %1, %2":"=v"(r):"v"(a),"v"(b));return r;}
typedef float f32x2_t __attribute__((ext_vector_type(2))); typedef __bf16 bf16x2_t __attribute__((ext_vector_type(2)));
__device__ __forceinline__ unsigned cvtpk_s(float lo,float hi){f32x2_t v={lo,hi};bf16x2_t b=__builtin_convertvector(v,bf16x2_t);return __builtin_bit_cast(unsigned,b);}
#define WAIT_BAR(N) asm volatile("s_waitcnt vmcnt(" #N ") lgkmcnt(0)\n\ts_barrier":::"memory")

__device__ __forceinline__ void qkt(f32x16&p0,f32x16&p1,const char*Kslot,const bf16x8*qr,int r32,int hi){
  const char*kb=Kslot+hi*1024+r32*16;
  #pragma unroll
  for(int d0=0;d0<4;++d0){
    const bf16x8 b0=*reinterpret_cast<const bf16x8*>(kb+d0*2048);
    const bf16x8 b1=*reinterpret_cast<const bf16x8*>(kb+d0*2048+512);
    p0=__builtin_amdgcn_mfma_f32_32x32x16_bf16(b0,qr[d0],p0,0,0,0);p1=__builtin_amdgcn_mfma_f32_32x32x16_bf16(b1,qr[d0],p1,0,0,0);}
}
typedef __attribute__((address_space(3))) const char* lds_cptr;
typedef short v4i16_t __attribute__((ext_vector_type(4)));
__device__ __forceinline__ void kload8(bf16x8*kf,lds_cptr kp){
  kf[0]=*(const __attribute__((address_space(3))) bf16x8*)(kp);      kf[1]=*(const __attribute__((address_space(3))) bf16x8*)(kp+512);
  kf[2]=*(const __attribute__((address_space(3))) bf16x8*)(kp+2048); kf[3]=*(const __attribute__((address_space(3))) bf16x8*)(kp+2560);
  kf[4]=*(const __attribute__((address_space(3))) bf16x8*)(kp+4096); kf[5]=*(const __attribute__((address_space(3))) bf16x8*)(kp+4608);
  kf[6]=*(const __attribute__((address_space(3))) bf16x8*)(kp+6144); kf[7]=*(const __attribute__((address_space(3))) bf16x8*)(kp+6656);
}
__device__ __forceinline__ void kload2(bf16x8*kf,lds_cptr kp,int j){ kf[2*j]=*(const __attribute__((address_space(3))) bf16x8*)(kp+j*2048); kf[2*j+1]=*(const __attribute__((address_space(3))) bf16x8*)(kp+j*2048+512); }
__device__ __forceinline__ s16x4 vtr(lds_cptr p){ return __builtin_bit_cast(s16x4,__builtin_amdgcn_ds_read_tr16_b64_v4i16((__attribute__((address_space(3))) v4i16_t*)p)); }
__device__ __forceinline__ float rowmax(const f32x16&p0,const f32x16&p1){
  float a=max3f(p0[0],p0[1],p1[0]),b=max3f(p0[2],p0[3],p1[1]);a=max3f(a,p1[2],p1[3]);
  #pragma unroll
  for(int r=4;r<16;r+=4){a=max3f(a,p0[r],p0[r+1]);b=max3f(b,p0[r+2],p0[r+3]);a=max3f(a,p1[r],p1[r+1]);b=max3f(b,p1[r+2],p1[r+3]);}
  const float m=max2f(a,b);
  auto rr=__builtin_amdgcn_permlane32_swap(__float_as_uint(m),__float_as_uint(m),false,false);
  return max2f(__uint_as_float(rr[0]),__uint_as_float(rr[1]));
}
__device__ __forceinline__ void pv(f32x16*o,int vb,bf16x8 pa0,bf16x8 pa1,bf16x8 pa2,bf16x8 pa3){
  #pragma unroll
  for(int d0=0;d0<2;++d0){s16x4 lo[4],hi[4];
    #pragma unroll
    for(int ks=0;ks<4;++ks){
      asm volatile("ds_read_b64_tr_b16 %0,%1 offset:%c2":"=&v"(lo[ks]):"v"(vb),"i"(d0*4096+ks*1024):"memory");
      asm volatile("ds_read_b64_tr_b16 %0,%1 offset:%c2":"=&v"(hi[ks]):"v"(vb),"i"(d0*4096+ks*1024+512):"memory");}
    asm volatile("s_waitcnt lgkmcnt(0)":::"memory");SBAR();
    #define PK(k) (bf16x8){lo[k][0],lo[k][1],lo[k][2],lo[k][3],hi[k][0],hi[k][1],hi[k][2],hi[k][3]}
    o[d0]=__builtin_amdgcn_mfma_f32_32x32x16_bf16(pa0,PK(0),o[d0],0,0,0);
    o[d0]=__builtin_amdgcn_mfma_f32_32x32x16_bf16(pa1,PK(1),o[d0],0,0,0);
    o[d0]=__builtin_amdgcn_mfma_f32_32x32x16_bf16(pa2,PK(2),o[d0],0,0,0);
    o[d0]=__builtin_amdgcn_mfma_f32_32x32x16_bf16(pa3,PK(3),o[d0],0,0,0);
    #undef PK
  }
}

#ifndef ATTN_STORE16
#define ATTN_STORE16(p,v) (*(u32x4*)(p)=(v))
#endif
template<int THRL> __device__ __forceinline__ void attn_unit(int b,int h,int qb,const bf16*Q,const bf16*__restrict__ K,const bf16*__restrict__ V,bf16*O,char*shm){
  int tid_=threadIdx.x; asm volatile("":"+v"(tid_)); const int tid=tid_,lane=tid&63,r32=lane&31,hi=lane>>5; const int wid=__builtin_amdgcn_readfirstlane(tid>>6);
  const long rowbase=(long)b*SEQ; const int q0=qb*QB;
  const bf16*Qw=Q+(rowbase+q0+wid*QBLK)*DM+h*D;
  const bf16*Kh=K+rowbase*DM+h*D,*Vh=V+rowbase*DM+h*D;
  const unsigned lds0=(unsigned)(uintptr_t)shm;
  float*wsf=(float*)(shm+LDS_WS)+wid*64;
  const bf16*ksrc=Kh+(long)lane*DM+wid*8;
  const bf16*vsrc=Vh+(long)(16*(wid&3)+(lane>>2))*DM+(wid>>2)*32+(lane&3)*8;
  const unsigned kdst=lds0+LDS_K+wid*1024, vdst=lds0+LDS_V+wid*1024;
  #define DMA_K(t,slot) glds16(ksrc+(long)(t)*KVBLK*DM,(unsigned)__builtin_amdgcn_readfirstlane(kdst+(slot)))
  #define DMA_V(t,slot) glds16(vsrc+(long)(t)*KVBLK*DM,(unsigned)__builtin_amdgcn_readfirstlane(vdst+(slot)))
  const int vb0=(int)(lds0+LDS_V)+((lane>>4)&1)*32+(lane&3)*8+(4*hi+((lane&15)>>2))*64;
  const char*Kbase=shm+LDS_K; bf16x8 kf[8];
  const lds_cptr shm3=(lds_cptr)shm; const lds_cptr kp0=shm3+LDS_K+hi*1024+r32*16; const lds_cptr vp0=shm3+LDS_V+((lane>>4)&1)*32+(lane&3)*8+(4*hi+((lane&15)>>2))*64;
  const int NT=(q0+QB)/KVBLK;
  DMA_K(0,0);DMA_V(0,0);DMA_K(1,SLOTB);
  bf16x8 qr[4];
  #pragma unroll
  for(int d0=0;d0<4;++d0)qr[d0]=*reinterpret_cast<const bf16x8*>(&Qw[(long)r32*DM+d0*16+hi*8]);
  float mhat=0.f,l_reg=0.f;f32x16 o[2];o[0]=f32x16{};o[1]=f32x16{};
  typedef float f32x4_t __attribute__((ext_vector_type(4)));
  const __attribute__((address_space(3))) f32x4_t* nb3=(const __attribute__((address_space(3))) f32x4_t*)((lds_cptr)shm+LDS_NB+hi*16);
  #define LDBIAS(C0,C1,t) do{ const __attribute__((address_space(3))) f32x4_t* nb_=nb3+16*(t); \
    _Pragma("unroll") for(int g_=0;g_<4;++g_){ const f32x4_t a_=nb_[2*g_], b_=nb_[8+2*g_]; \
      C0[4*g_]=a_[0];C0[4*g_+1]=a_[1];C0[4*g_+2]=a_[2];C0[4*g_+3]=a_[3]; C1[4*g_]=b_[0];C1[4*g_+1]=b_[1];C1[4*g_+2]=b_[2];C1[4*g_+3]=b_[3]; } }while(0)
  const int qrel=wid*QBLK+r32;
  #define CMASK(P0,P1,t) do{int jb_=(t)-(NT-4); if(jb_>=0)cmask(P0,P1,jb_,qrel,hi);}while(0)
  bool resc=false;
  #define START(P0,P1) do{ const float rm=rowmax(P0,P1); resc=false; mhat=rm; \
    _Pragma("unroll") for(int r=0;r<16;++r)P0[r]=__builtin_amdgcn_exp2f(P0[r]-mhat); }while(0)
  #define RESC() do{ if(resc){ asm volatile("s_waitcnt lgkmcnt(0)":::"memory"); \
      _Pragma("unroll") for(int d_=0;d_<2;++d_) _Pragma("unroll") for(int r=0;r<16;++r)o[d_][r]*=wsf[crow(r,hi)]; } }while(0)
  f32x16 pA0,pA1,pB0,pB1;
  int sl_prev=0,sl_cur=0,sl_next=SLOTB;
  #define ROT() do{sl_prev=sl_cur;sl_cur=sl_next;sl_next=(sl_next==(NSLOT-1)*SLOTB)?0:sl_next+SLOTB;}while(0)
  DMA_K(2,2*SLOTB);
  WAIT_BAR(3);
  LDBIAS(pA0,pA1,0); qkt(pA0,pA1,Kbase,qr,r32,hi);asm volatile("s_nop 15\n\ts_nop 7":"+v"(pA0),"+v"(pA1));CMASK(pA0,pA1,0);
  START(pA0,pA1);
  _Pragma("unroll") for(int r=0;r<16;++r)pA1[r]=__builtin_amdgcn_exp2f(pA1[r]-mhat);
  WAIT_BAR(0);
  DMA_K(3,0);DMA_V(1,SLOTB);
  ROT();
  kload8(kf,kp0+sl_cur);
  WAIT_BAR(2);
  s16x4 vlo[8],vhi[8]; u32x4 pw0,pw1,pw2,pw3;
  #define PKW(P,B) cvtpk_s(P[B],P[B+1])
  #define PAF(k) __builtin_bit_cast(bf16x8,pw##k)
  #define VFR(i) (bf16x8){vlo[i][0],vlo[i][1],vlo[i][2],vlo[i][3],vhi[i][0],vhi[i][1],vhi[i][2],vhi[i][3]}
  #define PIN(x) asm volatile("":"+v"(x))
  #define MX3(a,b,c) __builtin_fmaxf(__builtin_fmaxf((a),(b)),(c))
  #define GAPA(MF,A0,A1,A2,A3,W0,W1,PW) do{ MF; sacc+=A0; sacc+=A1; sacc+=A2; sacc+=A3; PIN(sacc); W0; W1; PIN(PW); SBAR(); }while(0)
  #define EX(v) __builtin_amdgcn_exp2f((v)-mhat)
  #define GAPB(MF,X,B) do{ MF; X[B]=EX(X[B]); X[B+1]=EX(X[B+1]); X[B+2]=EX(X[B+2]); X[B+3]=EX(X[B+3]); PIN(X); SBAR(); }while(0)
  #define VRD(i) do{ vlo[i]=vtr(vp_+(((i)>>2)*4096+((i)&3)*1024)); vhi[i]=vtr(vp_+(((i)>>2)*4096+((i)&3)*1024+512)); }while(0)
  #define KRD(G,j) do{ if(G){ kload2(kf,kp0+sl_next,j); SBAR(); } }while(0)
  #define STEP(C0,C1,P0,P1,t,GK,GV,GL) do{ SBAR(); LDBIAS(C0,C1,t); \
    const lds_cptr vp_=vp0+sl_prev; \
    VRD(0); SBAR(); float sacc=(P0[0]+P0[1]); \
    GAPA(C0=__builtin_amdgcn_mfma_f32_32x32x16_bf16(kf[0],qr[0],C0,0,0,0), P0[2],P0[3],P0[4],P0[5],     pw0[0]=PKW(P0,0), pw0[1]=PKW(P0,2), pw0); \
    VRD(4); SBAR(); GAPA(C1=__builtin_amdgcn_mfma_f32_32x32x16_bf16(kf[1],qr[0],C1,0,0,0), P0[6],P0[7],P0[8],P0[9],     pw0[2]=PKW(P0,4), pw0[3]=PKW(P0,6), pw0); \
    VRD(1); SBAR(); GAPA(C0=__builtin_amdgcn_mfma_f32_32x32x16_bf16(kf[2],qr[1],C0,0,0,0),   P0[10],P0[11],P0[12],P0[13], pw1[0]=PKW(P0,8), pw1[1]=PKW(P0,10), pw1); \
    VRD(5); SBAR(); GAPA(C1=__builtin_amdgcn_mfma_f32_32x32x16_bf16(kf[3],qr[1],C1,0,0,0),   P0[14],P0[15],P1[0],P1[1],   pw1[2]=PKW(P0,12),pw1[3]=PKW(P0,14), pw1); \
    VRD(2); SBAR(); GAPA(C0=__builtin_amdgcn_mfma_f32_32x32x16_bf16(kf[4],qr[2],C0,0,0,0),   P1[2],P1[3],P1[4],P1[5],     pw2[0]=PKW(P1,0), pw2[1]=PKW(P1,2), pw2); \
    VRD(6); SBAR(); GAPA(C1=__builtin_amdgcn_mfma_f32_32x32x16_bf16(kf[5],qr[2],C1,0,0,0),   P1[6],P1[7],P1[8],P1[9],     pw2[2]=PKW(P1,4), pw2[3]=PKW(P1,6), pw2); \
    VRD(3); SBAR(); GAPA(C0=__builtin_amdgcn_mfma_f32_32x32x16_bf16(kf[6],qr[3],C0,0,0,0),   P1[10],P1[11],P1[12],P1[13], pw3[0]=PKW(P1,8), pw3[1]=PKW(P1,10), pw3); \
    VRD(7); SBAR(); GAPA(C1=__builtin_amdgcn_mfma_f32_32x32x16_bf16(kf[7],qr[3],C1,0,0,0),   P1[14],P1[15],0.f,0.f,       pw3[2]=PKW(P1,12),pw3[3]=PKW(P1,14), pw3); \
    l_reg+=sacc; \
    if(GK){DMA_K((t)+3,sl_cur);} if(GV){DMA_V((t)+1,sl_next);} \
    CMASK(C0,C1,t); \
    { float a=MX3(C0[0],C0[1],C1[0]),b=MX3(C0[2],C0[3],C1[1]); a=MX3(a,C1[2],C1[3]); \
      _Pragma("unroll") for(int r=4;r<16;r+=4){a=MX3(a,C0[r],C0[r+1]);b=MX3(b,C0[r+2],C0[r+3]);a=MX3(a,C1[r],C1[r+1]);b=MX3(b,C1[r+2],C1[r+3]);} \
      float rm=__builtin_fmaxf(a,b); { auto rr=__builtin_amdgcn_permlane32_swap(__float_as_uint(rm),__float_as_uint(rm),false,false); rm=__builtin_fmaxf(__uint_as_float(rr[0]),__uint_as_float(rr[1])); } \
      resc=false; rm-=mhat; \
      if(__builtin_expect(__any(rm>(float)THRL),0)){ const float dl=__builtin_fmaxf(rm,0.f); mhat+=dl; \
        const float f=__builtin_amdgcn_exp2f(-dl); l_reg*=f; if(hi==0)wsf[r32]=f; resc=true; } } \
    SBAR(); \
    GAPB(o[0]=__builtin_amdgcn_mfma_f32_32x32x16_bf16(PAF(0),VFR(0),o[0],0,0,0), C0,0); \
    GAPB(o[1]=__builtin_amdgcn_mfma_f32_32x32x16_bf16(PAF(0),VFR(4),o[1],0,0,0), C0,4); \
    KRD(GL,0); GAPB(o[0]=__builtin_amdgcn_mfma_f32_32x32x16_bf16(PAF(1),VFR(1),o[0],0,0,0), C0,8); \
    KRD(GL,1); GAPB(o[1]=__builtin_amdgcn_mfma_f32_32x32x16_bf16(PAF(1),VFR(5),o[1],0,0,0), C0,12); \
    KRD(GL,2); GAPB(o[0]=__builtin_amdgcn_mfma_f32_32x32x16_bf16(PAF(2),VFR(2),o[0],0,0,0), C1,0); \
    KRD(GL,3); GAPB(o[1]=__builtin_amdgcn_mfma_f32_32x32x16_bf16(PAF(2),VFR(6),o[1],0,0,0), C1,4); \
    GAPB(o[0]=__builtin_amdgcn_mfma_f32_32x32x16_bf16(PAF(3),VFR(3),o[0],0,0,0), C1,8); \
    GAPB(o[1]=__builtin_amdgcn_mfma_f32_32x32x16_bf16(PAF(3),VFR(7),o[1],0,0,0), C1,12); \
    }while(0)
  int t=1;
  #undef CMASK
  #define CMASK(P0,P1,t) do{}while(0)
  for(;t+5<NT;t+=2){
    STEP(pB0,pB1,pA0,pA1,t,true,true,true);     WAIT_BAR(2); RESC(); ROT();
    STEP(pA0,pA1,pB0,pB1,t+1,true,true,true);   WAIT_BAR(2); RESC(); ROT();
  }
  #undef CMASK
  #define CMASK(P0,P1,t) do{int jb_=(t)-(NT-4); if(jb_>=0)cmask(P0,P1,jb_,qrel,hi);}while(0)
  #define ENDW(tt) do{ if((tt)+3<NT){WAIT_BAR(2);} else if((tt)+2<NT){WAIT_BAR(1);} else {WAIT_BAR(0);} }while(0)
  for(;t+1<NT;t+=2){
    STEP(pB0,pB1,pA0,pA1,t,(t+3<NT),(t+1<NT),(t+1<NT));       ENDW(t);   RESC(); ROT();
    STEP(pA0,pA1,pB0,pB1,t+1,(t+4<NT),(t+2<NT),(t+2<NT));     ENDW(t+1); RESC(); ROT();
  }
  STEP(pB0,pB1,pA0,pA1,NT-1,false,false,false); RESC();
  { float sacc=pB0[0]+pB0[1]; _Pragma("unroll") for(int r=2;r<16;++r)sacc+=pB0[r]; _Pragma("unroll") for(int r=0;r<16;++r)sacc+=pB1[r]; l_reg+=sacc;
    pw0=(u32x4){PKW(pB0,0),PKW(pB0,2),PKW(pB0,4),PKW(pB0,6)};pw1=(u32x4){PKW(pB0,8),PKW(pB0,10),PKW(pB0,12),PKW(pB0,14)};pw2=(u32x4){PKW(pB1,0),PKW(pB1,2),PKW(pB1,4),PKW(pB1,6)};pw3=(u32x4){PKW(pB1,8),PKW(pB1,10),PKW(pB1,12),PKW(pB1,14)};
    SBAR(); pv(o,vb0+sl_cur,PAF(0),PAF(1),PAF(2),PAF(3)); }
  #undef PKW
  #undef PAF
  #undef VFR
  #undef PIN
  #undef MX3
  #undef GAPA
  #undef GAPB
  #undef EX
  #undef VRD
  #undef KRD
  #undef STEP
  #undef ENDW
  {auto rr=__builtin_amdgcn_permlane32_swap(__float_as_uint(l_reg),__float_as_uint(l_reg),false,false);l_reg=__uint_as_float(rr[0])+__uint_as_float(rr[1]);}
  if(hi==0)wsf[32+r32]=l_reg;asm volatile("s_waitcnt lgkmcnt(0)":::"memory");
  float rli[16];
  #pragma unroll
  for(int r=0;r<16;++r)rli[r]=__builtin_amdgcn_rcpf(wsf[32+crow(r,hi)]);
  bf16*Ow=O+(rowbase+q0+wid*QBLK)*DM+h*D;
  { bf16*stg=(bf16*)(shm+LDS_OST)+wid*2048;
    #pragma unroll
    for(int r=0;r<16;++r){const int orow=crow(r,hi);
      #pragma unroll
      for(int d0=0;d0<2;++d0)stg[orow*64+d0*32+r32]=__float2bfloat16(o[d0][r]*rli[r]);}
    asm volatile("s_waitcnt lgkmcnt(0)":::"memory");
    #pragma unroll
    for(int i=0;i<4;++i){const int row=i*8+(lane>>3),ch=lane&7; const u32x4 v=*(const u32x4*)(stg+row*64+ch*8); ATTN_STORE16(Ow+(long)row*DM+ch*8,v);} }
  asm volatile("s_waitcnt lgkmcnt(0)\n\ts_barrier":::"memory");
  #undef DMA_K
  #undef DMA_V
  #undef CMASK
  #undef START
  #undef RESC
  #undef ROT
  #undef LDBIAS
}
constexpr int ATTN_LDS_BYTES=LDS_BYTES;
#undef SBAR
#undef WAIT_BAR
}

#define GAS __attribute__((address_space(1)))
#define LAS __attribute__((address_space(3)))
typedef unsigned short bf16;
typedef unsigned v4u __attribute__((ext_vector_type(4)));
typedef float f32x4 __attribute__((ext_vector_type(4)));
typedef short bf16x8 __attribute__((ext_vector_type(8)));
typedef GAS unsigned gu32;
typedef GAS unsigned long long gu64;
#define RLX_AGENT __ATOMIC_RELAXED, __HIP_MEMORY_SCOPE_AGENT
#define LDS_WAIT() asm volatile("s_waitcnt lgkmcnt(0)" ::: "memory")
#define VM_WAIT() asm volatile("s_waitcnt vmcnt(0)" ::: "memory")
__device__ __forceinline__ unsigned long long rt() { return __builtin_amdgcn_s_memrealtime(); }
__device__ __forceinline__ unsigned f2bf(float f) { unsigned u = __builtin_bit_cast(unsigned, f); return (u + 0x7fffu + ((u >> 16) & 1u)) >> 16; }
__device__ __forceinline__ unsigned pk2(float lo, float hi) { return f2bf(lo) | (f2bf(hi) << 16); }

#define XB_TMO      128
#define XB_XCNT(j)  (256  + 64 * (j))
#define XB_XSUB(j)  (1280 + 64 * (j))
#define XB_XGEN(j)  (2304 + 64 * (j))
#define XB_TOP      3328
#define XB_TOPGEN   3392
#define XCD_BAR_WORDS 3456
#define XB_SPIN_CAP (1u << 18)

__device__ __forceinline__ unsigned xb_ld(unsigned* p)              { return __hip_atomic_load(p, __ATOMIC_RELAXED, __HIP_MEMORY_SCOPE_AGENT); }
__device__ __forceinline__ unsigned xb_add(unsigned* p, unsigned v) { return __hip_atomic_fetch_add(p, v, __ATOMIC_RELAXED, __HIP_MEMORY_SCOPE_AGENT); }
__device__ __forceinline__ unsigned xb_xcc_id() { return (unsigned)__builtin_amdgcn_s_getreg((3 << 11) | 20) & 0xFu; }
#define XB_SPIN(cond, bar) do { unsigned _sp = 0; while (cond) { __builtin_amdgcn_s_sleep(1); \
    if ((++_sp & 255u) == 0u) { if (xb_ld(&(bar)[XB_TMO])) break; if (_sp > XB_SPIN_CAP) { atomicAdd(&(bar)[XB_TMO], 1u); break; } } } } while (0)

struct XcdBarrier {
    unsigned* bar; unsigned x;
    volatile LAS unsigned* st;
};

__device__ __forceinline__ XcdBarrier xcd_barrier_post(unsigned* bar, volatile LAS unsigned* st) {
    XcdBarrier b; b.bar = bar; b.x = xb_xcc_id(); b.st = st;
    if (threadIdx.x == 0) (void)xb_add(&bar[XB_XCNT(b.x)], 1u);
    return b;
}
__device__ __forceinline__ void xcd_barrier_complete(unsigned* bar, unsigned x, unsigned& nloc, unsigned& nx) {
    const unsigned G = gridDim.x * gridDim.y * gridDim.z;
    unsigned sum, cnt, mine, sp = 0u;
    for (;;) {
        sum = 0u; cnt = 0u; mine = 0u;
#pragma unroll
        for (unsigned j = 0; j < 16; ++j) { const unsigned c = xb_ld(&bar[XB_XCNT(j)]); sum += c; cnt += (c > 0u) ? 1u : 0u; mine = (j == x) ? c : mine; }
        if (sum == G) break;
        __builtin_amdgcn_s_sleep(1);
        if ((++sp & 255u) == 0u) { if (xb_ld(&bar[XB_TMO])) break; if (sp > XB_SPIN_CAP) { atomicAdd(&bar[XB_TMO], 1u); break; } }
    }
    nloc = mine > 0u ? mine : 1u; nx = cnt > 0u ? cnt : 1u;
}

__device__ __forceinline__ void xcd_barrier(const XcdBarrier& b) {
    asm volatile("s_waitcnt vmcnt(0)" ::: "memory");
    __syncthreads();
    int tb_ = threadIdx.x; asm volatile("" : "+v"(tb_));
    if (tb_ == 0) {
        unsigned* bar = b.bar;
        __builtin_amdgcn_s_waitcnt(0);
        unsigned nloc = b.st[0], nx = b.st[1];
        if (nloc == 0u) { xcd_barrier_complete(bar, b.x, nloc, nx); b.st[0] = nloc; b.st[1] = nx; }
        const unsigned old = xb_add(&bar[XB_XSUB(b.x)], 1u);
        const unsigned gen = old / nloc;
        if (old + 1u == (gen + 1u) * nloc) {
            __builtin_amdgcn_fence(__ATOMIC_RELEASE, "agent");
            asm volatile("s_waitcnt vmcnt(0)" ::: "memory");
            const unsigned og = xb_add(&bar[XB_TOP], 1u);
            const unsigned tg = og / nx;
            if (og + 1u == (tg + 1u) * nx) xb_add(&bar[XB_TOPGEN], 1u);
            else XB_SPIN(xb_ld(&bar[XB_TOPGEN]) == tg, bar);
            __builtin_amdgcn_fence(__ATOMIC_ACQUIRE, "agent");
            xb_add(&bar[XB_XGEN(b.x)], 1u);
            asm volatile("s_waitcnt vmcnt(0)" ::: "memory");
        } else {
            XB_SPIN(xb_ld(&bar[XB_XGEN(b.x)]) == gen, bar);
            __builtin_amdgcn_fence(__ATOMIC_ACQUIRE, "agent");
            asm volatile("s_waitcnt vmcnt(0)" ::: "memory");
        }
    }
    __syncthreads();
}

constexpr int NWAVES = 8, NCU = 256;
constexpr int BATCH = 8, SEQ = 2048, D = 1024, TOK = BATCH * SEQ, DEPTH = 2, MEMLEN = 256, FF = 4096;
constexpr int N_IN = 5384, OFF_F = 1792, OFF_C = 1800, OFF_G = 2312;
constexpr float EPSF = 1e-6f, LOG2E = 1.4426950408889634f;
constexpr size_t MiB = 1u << 20;
constexpr size_t WS_CTL = 0, CTL_ZERO_BYTES = 1 * MiB;
constexpr size_t WS_SS = 1 * MiB;
constexpr size_t WS_LOGF = 2 * MiB;
constexpr size_t WS_W = 3 * MiB;
constexpr size_t OW_IN = 0, OW_G = OW_IN + (size_t)2304 * 1024 * 2, OW_A = OW_G + (size_t)3072 * 1024 * 2, OW_B = OW_A + (size_t)1024 * 256 * 2, OW_C = OW_B + (size_t)1024 * 512 * 2,
                 OW_OUT = OW_C + (size_t)1024 * 256 * 2, OW_XQ = OW_OUT + (size_t)1024 * 1024 * 2, OW_XKV = OW_XQ + (size_t)1024 * 1024 * 2, OW_XO = OW_XKV + (size_t)2048 * 1024 * 2,
                 OW_FF1 = OW_XO + (size_t)1024 * 1024 * 2, OW_FF2 = OW_FF1 + (size_t)4096 * 1024 * 2, LW = OW_FF2 + (size_t)1024 * 4096 * 2;
static_assert(LW == 40370176 && WS_W + 2 * LW <= 80 * MiB, "weight map");
constexpr size_t WS_XKV1 = 80 * MiB;
constexpr size_t WS_XB = 88 * MiB;
constexpr size_t WS_DYN = 120 * MiB;
constexpr size_t WS_Q = WS_DYN, WS_K = WS_DYN + 16 * MiB, WS_V = WS_DYN + 32 * MiB, WS_PA = WS_DYN + 48 * MiB, WS_DD = WS_DYN + 56 * MiB, WS_ZC = WS_DYN + 64 * MiB,
                 WS_SG = WS_DYN + 80 * MiB, WS_T2 = WS_DYN + 88 * MiB, WS_HM = WS_DYN + 120 * MiB, WS_XKV0 = WS_DYN + 128 * MiB;
constexpr size_t WS_MG = WS_DYN + 16 * MiB;
constexpr size_t WS_XQH = WS_DYN, WS_PP = WS_DYN + 32 * MiB, WS_XO = WS_DYN + 64 * MiB;
constexpr size_t WS_FFH = WS_DYN;
constexpr size_t WS_END = 256 * MiB;
static_assert(WS_XKV0 + 8 * MiB <= WS_END, "d_ws map");
constexpr int CW_TMO = 0, CW_CODE = 1, CW_BAR = 4096;
constexpr int RING_OFF = 0, RING_BYTES = 131072, LDSCTL_OFF = RING_BYTES, MISC_OFF = LDSCTL_OFF + 320, LDS_BYTES = 147456;

template <int CTRL> __device__ __forceinline__ float dppf(float v) { return __uint_as_float(__builtin_amdgcn_update_dpp(0u, __float_as_uint(v), CTRL, 0xf, 0xf, false)); }
__device__ __forceinline__ float wave_sum(float v) {
    v += dppf<0xB1>(v); v += dppf<0x4E>(v); v += dppf<0x141>(v); v += dppf<0x140>(v);
    v = pg8::comb16<false>(v); v = pg8::comb32<false>(v);
    return v;
}
__device__ __forceinline__ float wave_scan(float v) {
    v += dppf<0x111>(v); v += dppf<0x112>(v); v += dppf<0x114>(v); v += dppf<0x118>(v);
    v += __uint_as_float(__builtin_amdgcn_update_dpp(0u, __float_as_uint(v), 0x142, 0xa, 0xf, false));
    v += __uint_as_float(__builtin_amdgcn_update_dpp(0u, __float_as_uint(v), 0x143, 0xc, 0xf, false));
    return v;
}

struct Frame {
    LAS unsigned char* lds;
    volatile LAS unsigned* MISC;
    gu32* ctl;
    int tid, lane, wave, vcu, G;
    float* out; unsigned char* ws;
};
constexpr int PTRS_OFF = LDSCTL_OFF + 512;
__device__ __forceinline__ const float* inp(const Frame& F, int i) {
    const unsigned long long v = *(volatile LAS unsigned long long*)(F.lds + PTRS_OFF + 8 * i);
    const unsigned lo = __builtin_amdgcn_readfirstlane((unsigned)v), hi = __builtin_amdgcn_readfirstlane((unsigned)(v >> 32));
    return (const float*)(const GAS float*)(((unsigned long long)hi << 32) | lo); }
__device__ __forceinline__ bf16* wsb(const Frame& F, size_t off) { return (bf16*)(F.ws + off); }
__device__ __forceinline__ bf16* wlay(const Frame& F, int l, size_t off) { return (bf16*)(F.ws + WS_W + (size_t)l * LW + off); }

__device__ __forceinline__ void tr_item(const float* W, int ldw, int K, int scol0, bf16* WT, int drow0, const float* gain, LAS float* scr, int kb, int nb, int lane) {
    const int k0 = 64 * kb, n0 = 32 * nb;
    float vv[32];
#pragma unroll
    for (int i = 0; i < 32; ++i) vv[i] = W[(size_t)(k0 + 2 * i + (lane >> 5)) * ldw + scol0 + n0 + (lane & 31)];
    if (gain) {
#pragma unroll
        for (int i = 0; i < 32; ++i) vv[i] *= gain[k0 + 2 * i + (lane >> 5)];
    }
#pragma unroll
    for (int i = 0; i < 32; ++i) scr[(2 * i + (lane >> 5)) * 33 + (lane & 31)] = vv[i];
    LDS_WAIT(); asm volatile("" ::: "memory");
    const int c = lane & 7;
#pragma unroll
    for (int j = 0; j < 4; ++j) { const int n = (lane >> 3) + 8 * j; const LAS float* s = scr + (8 * c) * 33 + n;
        v4u o; o.x = pk2(s[0 * 33], s[1 * 33]); o.y = pk2(s[2 * 33], s[3 * 33]); o.z = pk2(s[4 * 33], s[5 * 33]); o.w = pk2(s[6 * 33], s[7 * 33]);
        *(GAS v4u*)(WT + (size_t)(drow0 + n0 + n) * K + k0 + 8 * c) = o; }
    LDS_WAIT(); asm volatile("" ::: "memory");
}
constexpr int I_IN1 = 16 * 56, I_IN2 = 16 * 16, I_G = 16 * 96, I_B = 8 * 32, I_C = 4 * 32, I_OUT = 16 * 32, I_XQ = 16 * 32, I_XKV = 16 * 64, I_XO = 16 * 32, I_FF1 = 16 * 128, I_FF2 = 64 * 32;
constexpr int I_LAYER = I_IN1 + I_IN2 + I_G + I_B + I_C + I_OUT + I_XQ + I_XKV + I_XO + I_FF1 + I_FF2;

__device__ __forceinline__ void p0_prologue(Frame& F) {
    LAS float* scr = (LAS float*)(F.lds + RING_OFF + F.wave * 16384);
    const int gw = F.vcu * NWAVES + F.wave, NGW = F.G * NWAVES, lane = F.lane;
    for (int it = gw; it < DEPTH * I_LAYER; it += NGW) {
        const int l = it / I_LAYER; int r = it % I_LAYER;
        const float* w_in = inp(F, 3) + (size_t)l * D * N_IN;
        if (r < I_IN1) { tr_item(w_in, N_IN, D, 0, wlay(F, l, OW_IN), 0, inp(F, 2) + l * D, scr, r / 56, r % 56, lane); continue; } r -= I_IN1;
        if (r < I_IN2) { tr_item(w_in, N_IN, D, OFF_C, wlay(F, l, OW_IN), 1792, inp(F, 2) + l * D, scr, r / 16, r % 16, lane); continue; } r -= I_IN2;
        if (r < I_G) { tr_item(w_in, N_IN, D, OFF_G, wlay(F, l, OW_G), 0, inp(F, 2) + l * D, scr, r / 96, r % 96, lane); continue; } r -= I_G;
        if (r < I_B) { tr_item(inp(F, 11) + (size_t)l * 512 * D, D, 512, 0, wlay(F, l, OW_B), 0, nullptr, scr, r / 32, r % 32, lane); continue; } r -= I_B;
        if (r < I_C) { tr_item(inp(F, 12) + (size_t)l * 256 * D, D, 256, 0, wlay(F, l, OW_C), 0, nullptr, scr, r / 32, r % 32, lane); continue; } r -= I_C;
        if (r < I_OUT) { tr_item(inp(F, 14) + (size_t)l * D * D, D, D, 0, wlay(F, l, OW_OUT), 0, nullptr, scr, r / 32, r % 32, lane); continue; } r -= I_OUT;
        if (r < I_XQ) { tr_item(inp(F, 17) + (size_t)l * D * D, D, D, 0, wlay(F, l, OW_XQ), 0, inp(F, 15) + l * D, scr, r / 32, r % 32, lane); continue; } r -= I_XQ;
        if (r < I_XKV) { tr_item(inp(F, 18) + (size_t)l * D * 2 * D, 2 * D, D, 0, wlay(F, l, OW_XKV), 0, nullptr, scr, r / 64, r % 64, lane); continue; } r -= I_XKV;
        if (r < I_XO) { tr_item(inp(F, 19) + (size_t)l * D * D, D, D, 0, wlay(F, l, OW_XO), 0, nullptr, scr, r / 32, r % 32, lane); continue; } r -= I_XO;
        if (r < I_FF1) { tr_item(inp(F, 21) + (size_t)l * D * FF, FF, D, 0, wlay(F, l, OW_FF1), 0, inp(F, 20) + l * D, scr, r / 128, r % 128, lane); continue; } r -= I_FF1;
        tr_item(inp(F, 22) + (size_t)l * FF * D, D, FF, 0, wlay(F, l, OW_FF2), 0, nullptr, scr, r / 32, r % 32, lane);
    }
    for (int it = gw; it < DEPTH * 256 * 16; it += NGW) {
        const int l = it / 4096, r = it % 4096, cp = r / 16, n = (r % 16) * 64 + lane, g = cp >> 6;
        const float* pw = inp(F, 5) + ((size_t)l * 256 + cp) * 64; const float* ps = inp(F, 6) + l * 256 + g * 64; const float* wa = inp(F, 10) + ((size_t)l * 256 + g * 64) * D + n;
        float a = 0.f;
#pragma unroll 8
        for (int d = 0; d < 64; ++d) a += pw[d] * ps[d] * wa[(size_t)d * D];
        wlay(F, l, OW_A)[(size_t)n * 256 + cp] = (bf16)f2bf(a);
    }
    for (int it = gw; it < DEPTH * BATCH * MEMLEN; it += NGW) {
        const int l = it / (BATCH * MEMLEN), m = it % (BATCH * MEMLEN);
        const GAS f32x4* xr = (const GAS f32x4*)(inp(F, 1) + (size_t)m * D) + lane; const GAS f32x4* gr = (const GAS f32x4*)(inp(F, 16) + l * D) + lane;
        f32x4 v[4]; float s = 0.f;
#pragma unroll
        for (int j = 0; j < 4; ++j) { v[j] = xr[64 * j]; s += (v[j].x * v[j].x + v[j].y * v[j].y) + (v[j].z * v[j].z + v[j].w * v[j].w); }
        const float rstd = 1.0f / sqrtf(wave_sum(s) * (1.f / D) + EPSF);
        GAS unsigned long long* o8 = (GAS unsigned long long*)(wsb(F, WS_HM) + ((size_t)l * BATCH * MEMLEN + m) * D) + lane;
#pragma unroll
        for (int j = 0; j < 4; ++j) { const f32x4 g = gr[64 * j]; o8[64 * j] = (unsigned long long)pk2(v[j].x * rstd * g.x, v[j].y * rstd * g.y) | ((unsigned long long)pk2(v[j].z * rstd * g.z, v[j].w * rstd * g.w) << 32); }
    }
    for (int m = gw; m < TOK; m += NGW) {
        const GAS f32x4* xr = (const GAS f32x4*)(inp(F, 0) + (size_t)m * D) + lane;
        f32x4 v[4]; float s = 0.f;
#pragma unroll
        for (int j = 0; j < 4; ++j) { v[j] = xr[64 * j]; s += (v[j].x * v[j].x + v[j].y * v[j].y) + (v[j].z * v[j].z + v[j].w * v[j].w); }
        s = wave_sum(s);
        GAS unsigned long long* o8 = (GAS unsigned long long*)(wsb(F, WS_XB) + (size_t)m * D) + lane;
#pragma unroll
        for (int j = 0; j < 4; ++j) o8[64 * j] = (unsigned long long)pk2(v[j].x, v[j].y) | ((unsigned long long)pk2(v[j].z, v[j].w) << 32);
        if (lane < 16) ((float*)(F.ws + WS_SS))[(size_t)m * 16 + lane] = lane == 0 ? s : 0.f;
    }
}

__device__ __forceinline__ float row_rstd(const Frame& F, int row) {
    const f32x4* p = (const f32x4*)((const float*)(F.ws + WS_SS) + (size_t)row * 16);
    const f32x4 a = p[0], b = p[1], c = p[2], d = p[3];
    const float s = ((a[0] + a[1]) + (a[2] + a[3])) + ((b[0] + b[1]) + (b[2] + b[3])) + ((c[0] + c[1]) + (c[2] + c[3])) + ((d[0] + d[1]) + (d[2] + d[3]));
    return 1.0f / sqrtf(s * (1.f / D) + EPSF);
}

__device__ __forceinline__ void logf_pass(Frame& F, int l) {
    const int gw = F.vcu * NWAVES + F.wave, NGW = F.G * NWAVES, lane = F.lane;
    LAS float* WF = (LAS float*)(F.lds + RING_OFF);
    {
        const float* w_in = inp(F, 3) + (size_t)l * D * N_IN; const float* g = inp(F, 2) + l * D;
#pragma unroll
        for (int i = 0; i < 2; ++i) { const int k = F.tid + 512 * i; const float gk = g[k]; const float* p = w_in + (size_t)k * N_IN + OFF_F;
            const f32x4 a = *(const f32x4*)p * gk, b = *(const f32x4*)(p + 4) * gk;
            LAS f32x4* dst = (LAS f32x4*)(WF + (k >> 4) * 132 + (k & 15) * 8); dst[0] = a; dst[1] = b; }
    }
    LDS_WAIT(); __syncthreads();
    const float bfl = (lane < 8) ? (inp(F, 4) + l * 8)[lane] : 0.f;
    float* LOGF = (float*)(F.ws + WS_LOGF);
    const LAS f32x4* wl = (const LAS f32x4*)(WF + lane * 132);
    for (int m = gw; m < TOK; m += NGW) {
        const v4u* xp = (const v4u*)(wsb(F, WS_XB) + (size_t)m * D + 16 * lane);
        const v4u x0 = xp[0], x1 = xp[1];
        float xv[16];
        xv[0] = __uint_as_float(x0.x << 16); xv[1] = __uint_as_float(x0.x & 0xffff0000u); xv[2] = __uint_as_float(x0.y << 16); xv[3] = __uint_as_float(x0.y & 0xffff0000u);
        xv[4] = __uint_as_float(x0.z << 16); xv[5] = __uint_as_float(x0.z & 0xffff0000u); xv[6] = __uint_as_float(x0.w << 16); xv[7] = __uint_as_float(x0.w & 0xffff0000u);
        xv[8] = __uint_as_float(x1.x << 16); xv[9] = __uint_as_float(x1.x & 0xffff0000u); xv[10] = __uint_as_float(x1.y << 16); xv[11] = __uint_as_float(x1.y & 0xffff0000u);
        xv[12] = __uint_as_float(x1.z << 16); xv[13] = __uint_as_float(x1.z & 0xffff0000u); xv[14] = __uint_as_float(x1.w << 16); xv[15] = __uint_as_float(x1.w & 0xffff0000u);
        f32x4 a0 = (f32x4){0.f, 0.f, 0.f, 0.f}, a1 = a0;
#pragma unroll
        for (int j = 0; j < 16; ++j) { a0 += wl[2 * j] * xv[j]; a1 += wl[2 * j + 1] * xv[j]; }
        float d[8] = {a0[0], a0[1], a0[2], a0[3], a1[0], a1[1], a1[2], a1[3]};
#pragma unroll
        for (int h = 0; h < 8; ++h) d[h] = wave_sum(d[h]);
        const float rstd = row_rstd(F, m);
        if (lane < 8) {
            float dv = d[0];
#pragma unroll
            for (int h = 1; h < 8; ++h) dv = (lane == h) ? d[h] : dv;
            const float z = dv * rstd + bfl;
            const float ls = fminf(z, 0.f) - 0.6931471805599453f * __builtin_amdgcn_logf(1.0f + __builtin_amdgcn_exp2f(-LOG2E * fabsf(z)));
            LOGF[((size_t)(m / SEQ) * 8 + lane) * SEQ + (m % SEQ)] = ls;
        }
    }
    LDS_WAIT(); __syncthreads();
}

__device__ __forceinline__ void cumsum_bias(Frame& F, int bh, LAS float* nb, LAS float* scr) {
    const f32x4 v = *((const f32x4*)((const float*)(F.ws + WS_LOGF) + (size_t)bh * SEQ) + F.tid);
    const float p0 = v[0], p1 = p0 + v[1], p2 = p1 + v[2], p3 = p2 + v[3];
    const float incl = wave_scan(p3);
    if (F.lane == 63) scr[F.wave] = incl;
    LDS_WAIT(); __syncthreads();
    float woff = 0.f;
#pragma unroll
    for (int w = 0; w < 8; ++w) woff += (w < F.wave) ? scr[w] : 0.f;
    const float base = woff + (incl - p3);
    *((LAS f32x4*)nb + F.tid) = (f32x4){-(base + p0) * LOG2E, -(base + p1) * LOG2E, -(base + p2) * LOG2E, -(base + p3) * LOG2E};
    LDS_WAIT(); __syncthreads();
}

__device__ __forceinline__ void pool_diff(Frame& F) {
    const bf16* PA = wsb(F, WS_PA); bf16* DD = wsb(F, WS_DD);
    const int ch = F.tid & 31, seg = F.tid >> 5, g = ch >> 3, win = 2 << g, r0 = 64 * F.vcu + 4 * seg, tl0 = r0 & (SEQ - 1);
    v4u a[19];
#pragma unroll
    for (int i = 0; i < 19; ++i) { const int dt = i - 15;
        a[i] = (tl0 + dt >= 0) ? *(const v4u*)(PA + (size_t)(r0 + dt) * 256 + 8 * ch) : (v4u){0u, 0u, 0u, 0u}; }
    float s[8] = {0.f, 0.f, 0.f, 0.f, 0.f, 0.f, 0.f, 0.f};
#define PD_ACC(W, SG) do { s[0] += SG __uint_as_float((W).x << 16); s[1] += SG __uint_as_float((W).x & 0xffff0000u); s[2] += SG __uint_as_float((W).y << 16); s[3] += SG __uint_as_float((W).y & 0xffff0000u); \
        s[4] += SG __uint_as_float((W).z << 16); s[5] += SG __uint_as_float((W).z & 0xffff0000u); s[6] += SG __uint_as_float((W).w << 16); s[7] += SG __uint_as_float((W).w & 0xffff0000u); } while (0)
#pragma unroll
    for (int k = 0; k < 16; ++k) if (k < win) PD_ACC(a[15 - k], +);
#pragma unroll
    for (int o = 0; o < 4; ++o) {
        if (o > 0) { PD_ACC(a[15 + o], +);
            const v4u old = (g == 0) ? a[13 + o] : (g == 1) ? a[11 + o] : (g == 2) ? a[7 + o] : a[o - 1]; PD_ACC(old, -); }
        const int tl = tl0 + o; const float inv = 1.0f / (float)((tl + 1 < win) ? tl + 1 : win);
        const v4u cur = a[15 + o]; v4u w;
        w.x = pk2(s[0] * inv - __uint_as_float(cur.x << 16), s[1] * inv - __uint_as_float(cur.x & 0xffff0000u));
        w.y = pk2(s[2] * inv - __uint_as_float(cur.y << 16), s[3] * inv - __uint_as_float(cur.y & 0xffff0000u));
        w.z = pk2(s[4] * inv - __uint_as_float(cur.z << 16), s[5] * inv - __uint_as_float(cur.z & 0xffff0000u));
        w.w = pk2(s[6] * inv - __uint_as_float(cur.w << 16), s[7] * inv - __uint_as_float(cur.w & 0xffff0000u));
        *(v4u*)(DD + (size_t)(r0 + o) * 256 + 8 * ch) = w;
    }
#undef PD_ACC
}

__device__ __forceinline__ void sgu_unit(Frame& F, int l, int unit) {
    const int chunk = unit >> 2, g = unit & 3, row0 = chunk * 128, lane = F.lane, w = F.wave;
    const bf16* ZC = wsb(F, WS_ZC); bf16* SG = wsb(F, WS_SG);
    LAS bf16* vnT = (LAS bf16*)(F.lds + RING_OFF);
    const float* gain = inp(F, 7) + l * 256;
    const float g0 = gain[4 * lane], g1 = gain[4 * lane + 1], g2 = gain[4 * lane + 2], g3 = gain[4 * lane + 3];
    unsigned long long qv[16];
#pragma unroll
    for (int i = 0; i < 16; ++i) qv[i] = *(const unsigned long long*)(ZC + (size_t)(row0 + 16 * w + i) * 512 + 256 + 4 * lane);
#pragma unroll
    for (int i = 0; i < 16; ++i) {
        const int s = 16 * w + i;
        const unsigned long long q = qv[i];
        const unsigned lo = (unsigned)q, hi = (unsigned)(q >> 32);
        const float v0 = __uint_as_float(lo << 16), v1 = __uint_as_float(lo & 0xffff0000u), v2 = __uint_as_float(hi << 16), v3 = __uint_as_float(hi & 0xffff0000u);
        const float ss = wave_sum((v0 * v0 + v1 * v1) + (v2 * v2 + v3 * v3));
        const float r = 1.0f / sqrtf(ss * (1.f / 256.f) + EPSF);
        if ((lane >> 4) == g) { const int d = 4 * (lane & 15);
            vnT[(d + 0) * 136 + s] = (bf16)f2bf(v0 * r * g0); vnT[(d + 1) * 136 + s] = (bf16)f2bf(v1 * r * g1); vnT[(d + 2) * 136 + s] = (bf16)f2bf(v2 * r * g2); vnT[(d + 3) * 136 + s] = (bf16)f2bf(v3 * r * g3); }
    }
    LDS_WAIT(); __syncthreads();
    const float* Wg = inp(F, 8) + ((size_t)(l * 4 + g) * 128) * 128;
    const int t = 16 * w + (lane & 15), kq = lane >> 4;
    f32x4 acc[4];
#pragma unroll
    for (int n = 0; n < 4; ++n) acc[n] = (f32x4){0.f, 0.f, 0.f, 0.f};
#pragma unroll
    for (int kk = 0; kk < 4; ++kk) {
        if (32 * kk <= 16 * w + 15) {
            const int s0 = 32 * kk + 8 * kq;
            const f32x4 wa = *(const f32x4*)(Wg + (size_t)t * 128 + s0), wb = *(const f32x4*)(Wg + (size_t)t * 128 + s0 + 4);
            float wv[8] = {wa[0], wa[1], wa[2], wa[3], wb[0], wb[1], wb[2], wb[3]};
#pragma unroll
            for (int j = 0; j < 8; ++j) wv[j] = (s0 + j <= t) ? wv[j] : 0.f;
            v4u bw; bw.x = pk2(wv[0], wv[1]); bw.y = pk2(wv[2], wv[3]); bw.z = pk2(wv[4], wv[5]); bw.w = pk2(wv[6], wv[7]);
            const bf16x8 bfrag = __builtin_bit_cast(bf16x8, bw);
#pragma unroll
            for (int n = 0; n < 4; ++n) { const bf16x8 afrag = *(const LAS bf16x8*)(vnT + (16 * n + (lane & 15)) * 136 + s0);
                acc[n] = __builtin_amdgcn_mfma_f32_16x16x32_bf16(afrag, bfrag, acc[n], 0, 0, 0); }
        }
    }
    const float bt = inp(F, 9)[(l * 4 + g) * 128 + t];
#pragma unroll
    for (int n = 0; n < 4; ++n) { const int d = 64 * g + 16 * n + 4 * kq;
        const unsigned long long q = *(const unsigned long long*)(ZC + (size_t)(row0 + t) * 512 + d);
        const unsigned lo = (unsigned)q, hi = (unsigned)(q >> 32);
        const float o0 = __uint_as_float(lo << 16) * (acc[n][0] + bt), o1 = __uint_as_float(lo & 0xffff0000u) * (acc[n][1] + bt), o2 = __uint_as_float(hi << 16) * (acc[n][2] + bt), o3 = __uint_as_float(hi & 0xffff0000u) * (acc[n][3] + bt);
        *(unsigned long long*)(SG + (size_t)(row0 + t) * 256 + d) = (unsigned long long)pk2(o0, o1) | ((unsigned long long)pk2(o2, o3) << 32); }
    LDS_WAIT(); __syncthreads();
}

__device__ __forceinline__ void final_norm(Frame& F) {
    const int gw = F.vcu * NWAVES + F.wave, NGW = F.G * NWAVES, lane = F.lane;
    const GAS f32x4* gr = (const GAS f32x4*)inp(F, 23) + lane;
    for (int m = gw; m < TOK; m += NGW) {
        const float rstd = row_rstd(F, m);
        GAS f32x4* xr = (GAS f32x4*)(F.out + (size_t)m * D) + lane;
#pragma unroll
        for (int j = 0; j < 4; ++j) { const f32x4 v = xr[64 * j]; xr[64 * j] = v * rstd * gr[64 * j]; }
    }
}

struct Args { const float* in[24]; float* out; unsigned char* ws; };
__global__ void __launch_bounds__(NWAVES * 64, 2) mega_fwd(Args args) {
    extern __shared__ __attribute__((aligned(16))) unsigned char lds[];
    Frame F;
    F.lds = (LAS unsigned char*)lds;
    F.MISC = (volatile LAS unsigned*)(F.lds + MISC_OFF);
    int c = 0;
#define REFRESH() do { int t_ = threadIdx.x, b_ = blockIdx.x; asm volatile("" : "+v"(t_)); asm volatile("" : "+s"(b_)); F.tid = t_; F.lane = t_ & 63; F.wave = __builtin_amdgcn_readfirstlane(t_ >> 6); \
        F.G = NCU; F.vcu = (b_ % 8) * (NCU / 8) + b_ / 8; c = b_; \
        unsigned lb_ = (unsigned)(uintptr_t)(LAS unsigned char*)lds; asm volatile("" : "+s"(lb_)); F.lds = (LAS unsigned char*)(uintptr_t)lb_; F.MISC = (volatile LAS unsigned*)(F.lds + MISC_OFF); } while (0)
    REFRESH();
    F.ws = args.ws; F.out = args.out; F.ctl = (gu32*)(args.ws + WS_CTL);
    for (int u = F.tid; u < (LDS_BYTES - LDSCTL_OFF) / 4; u += NWAVES * 64) ((LAS unsigned*)(F.lds + LDSCTL_OFF))[u] = 0u;
    __syncthreads();
    if (F.tid < 24) *(LAS unsigned long long*)(F.lds + PTRS_OFF + 8 * F.tid) = (unsigned long long)args.in[F.tid];
    LDS_WAIT(); __syncthreads();
    (void)xcd_barrier_post((unsigned*)(F.ctl + CW_BAR), F.MISC + 8);
#define GRID_BAR() do { XcdBarrier b_; b_.bar = (unsigned*)(F.ws + WS_CTL) + CW_BAR; b_.x = xb_xcc_id(); asm volatile("" : "+s"(b_.x)); b_.st = F.MISC + 8; REP(9) xcd_barrier(b_); } while (0)
    float* SS = (float*)(F.ws + WS_SS);

#ifndef PROBE
#define PROBE 0
#endif
#define REP(n) for (int rep_ = 0; rep_ < ((PROBE == (n)) ? 2 : 1); ++rep_)
    REP(1) p0_prologue(F);
    GRID_BAR();
    for (int l = 0; l < DEPTH; ++l) {
        const float* xres = (l == 0) ? inp(F, 0) : F.out;
        REFRESH();
        REP(2) logf_pass(F, l);
        REP(3)
        { pg8::GemmProj g{wsb(F, WS_XB), wlay(F, l, OW_IN), wsb(F, WS_HM), wlay(F, 0, OW_XKV), LW / 2, D, D, D};
          pg8::StaticOrder S; S.init(TOK, l == 0 ? 11 * 256 : 9 * 256, F.G, c);
          pg8::EpiProj E{wsb(F, WS_PA), wsb(F, WS_Q), wsb(F, WS_K), wsb(F, WS_V), wsb(F, WS_ZC), SS, attn_body::C2, wsb(F, WS_XKV0), wsb(F, WS_XKV1)};
          pg8::gemm_phase<pg8::EpiProj, pg8::StaticOrder, pg8::GemmProj, true, true>(F.lds + RING_OFF, g, S, E); }
        GRID_BAR();
        REFRESH();
        {
            const int bh = F.vcu >> 2, s4 = F.vcu & 3;
            LAS float* nb = (LAS float*)(F.lds + RING_OFF + attn_body::LDS_NB);
            cumsum_bias(F, bh, nb, (LAS float*)(F.lds + RING_OFF + attn_body::LDS_NB + 8192));
#if PROBE == 4
            attn_body::attn_unit<8>(bh >> 3, bh & 7, 7 - s4, (const attn_body::bf16*)wsb(F, WS_Q), (const attn_body::bf16*)wsb(F, WS_K), (const attn_body::bf16*)wsb(F, WS_V), (attn_body::bf16*)wsb(F, WS_T2), (char*)F.lds + RING_OFF);
            attn_body::attn_unit<8>(bh >> 3, bh & 7, s4, (const attn_body::bf16*)wsb(F, WS_Q), (const attn_body::bf16*)wsb(F, WS_K), (const attn_body::bf16*)wsb(F, WS_V), (attn_body::bf16*)wsb(F, WS_T2), (char*)F.lds + RING_OFF);
#endif
            attn_body::attn_unit<8>(bh >> 3, bh & 7, 7 - s4, (const attn_body::bf16*)wsb(F, WS_Q), (const attn_body::bf16*)wsb(F, WS_K), (const attn_body::bf16*)wsb(F, WS_V), (attn_body::bf16*)wsb(F, WS_Q), (char*)F.lds + RING_OFF);
            attn_body::attn_unit<8>(bh >> 3, bh & 7, s4, (const attn_body::bf16*)wsb(F, WS_Q), (const attn_body::bf16*)wsb(F, WS_K), (const attn_body::bf16*)wsb(F, WS_V), (attn_body::bf16*)wsb(F, WS_Q), (char*)F.lds + RING_OFF);
            REP(5) { pool_diff(F); sgu_unit(F, l, 2 * F.vcu); sgu_unit(F, l, 2 * F.vcu + 1); }
        }
        GRID_BAR();
        REFRESH();
        REP(6) {
            pg8::StaticOrder S; S.init(TOK, D, F.G, c);
            const float* bg = inp(F, 13) + (size_t)l * 3 * D;
            { pg8::GemmP g{wsb(F, WS_DD), wlay(F, l, OW_A), 256, 256, 256}; pg8::EpiStore<0, false, false> E{wsb(F, WS_T2), D, nullptr, 1.f};
              pg8::gemm_phase<pg8::EpiStore<0, false, false>, pg8::StaticOrder, pg8::GemmP, true, true>(F.lds + RING_OFF, g, S, E); }
            { pg8::GemmP g{wsb(F, WS_XB), wlay(F, l, OW_G), D, D, D}; pg8::EpiGate<true> E{wsb(F, WS_T2), wsb(F, WS_MG), bg, SS};
              pg8::gemm_phase<pg8::EpiGate<true>, pg8::StaticOrder, pg8::GemmP, true, true>(F.lds + RING_OFF, g, S, E); }
            { pg8::GemmP g{wsb(F, WS_Q), wlay(F, l, OW_B), 512, 512, 512}; pg8::EpiStore<0, false, false> E{wsb(F, WS_T2), D, nullptr, 1.f};
              pg8::gemm_phase<pg8::EpiStore<0, false, false>, pg8::StaticOrder, pg8::GemmP, true, true>(F.lds + RING_OFF, g, S, E); }
            { pg8::GemmP g{wsb(F, WS_XB), wlay(F, l, OW_G) + (size_t)D * D, D, D, D}; pg8::EpiGate<false> E{wsb(F, WS_T2), wsb(F, WS_MG), bg + D, SS};
              pg8::gemm_phase<pg8::EpiGate<false>, pg8::StaticOrder, pg8::GemmP, true, true>(F.lds + RING_OFF, g, S, E); }
            { pg8::GemmP g{wsb(F, WS_SG), wlay(F, l, OW_C), 256, 256, 256}; pg8::EpiStore<0, false, false> E{wsb(F, WS_T2), D, nullptr, 1.f};
              pg8::gemm_phase<pg8::EpiStore<0, false, false>, pg8::StaticOrder, pg8::GemmP, true, true>(F.lds + RING_OFF, g, S, E); }
            { pg8::GemmP g{wsb(F, WS_XB), wlay(F, l, OW_G) + (size_t)2 * D * D, D, D, D}; pg8::EpiGate<false> E{wsb(F, WS_T2), wsb(F, WS_MG), bg + 2 * D, SS};
              pg8::gemm_phase<pg8::EpiGate<false>, pg8::StaticOrder, pg8::GemmP, true, true>(F.lds + RING_OFF, g, S, E); }
        }
        GRID_BAR();
        REFRESH();
        { pg8::GemmP g{wsb(F, WS_MG), wlay(F, l, OW_OUT), D, D, D}; pg8::StaticOrder S; S.init(TOK, D, F.G, c); pg8::EpiRes E{xres, F.out, wsb(F, WS_XB), SS};
          pg8::gemm_phase<pg8::EpiRes, pg8::StaticOrder, pg8::GemmP, true, true>(F.lds + RING_OFF, g, S, E); }
        GRID_BAR();
        REFRESH();
        REP(7) {
            pg8::StaticOrder S; S.init(TOK, D, F.G, c);
            const bf16* xk = wsb(F, l == 0 ? WS_XKV0 : WS_XKV1); const bf16* xvt = xk + (size_t)BATCH * 4 * 65536;
            { pg8::GemmP g{wsb(F, WS_XB), wlay(F, l, OW_XQ), D, D, D}; pg8::EpiStore<0, true, true> E{wsb(F, WS_XQH), 256, SS, 0.0625f * LOG2E};
              pg8::gemm_phase<pg8::EpiStore<0, true, true>, pg8::StaticOrder, pg8::GemmP, true, true>(F.lds + RING_OFF, g, S, E); }
            { pg8::GemmX g{wsb(F, WS_XQH), xk, 256, 256, 256}; pg8::EpiSoftmax E{wsb(F, WS_PP)};
              pg8::gemm_phase<pg8::EpiSoftmax, pg8::StaticOrder, pg8::GemmX, false, true>(F.lds + RING_OFF, g, S, E); }
            { pg8::GemmX g{wsb(F, WS_PP), xvt, 256, 256, 256}; pg8::EpiStore<0, false, false> E{wsb(F, WS_XO), D, nullptr, 1.f};
              pg8::gemm_phase<pg8::EpiStore<0, false, false>, pg8::StaticOrder, pg8::GemmX, true, true>(F.lds + RING_OFF, g, S, E); }
        }
        GRID_BAR();
        REFRESH();
        { pg8::GemmP g{wsb(F, WS_XO), wlay(F, l, OW_XO), D, D, D}; pg8::StaticOrder S; S.init(TOK, D, F.G, c); pg8::EpiRes E{F.out, F.out, wsb(F, WS_XB), SS};
          pg8::gemm_phase<pg8::EpiRes, pg8::StaticOrder, pg8::GemmP, true, true>(F.lds + RING_OFF, g, S, E); }
        GRID_BAR();
        REFRESH();
        REP(8) { pg8::GemmP g{wsb(F, WS_XB), wlay(F, l, OW_FF1), D, D, D}; pg8::StaticOrder S; S.init(TOK, FF, F.G, c); pg8::EpiStore<1, true, false> E{wsb(F, WS_FFH), FF, SS, 1.f};
          pg8::gemm_phase<pg8::EpiStore<1, true, false>, pg8::StaticOrder, pg8::GemmP, true, true>(F.lds + RING_OFF, g, S, E); }
        GRID_BAR();
        REFRESH();
        { pg8::GemmP g{wsb(F, WS_FFH), wlay(F, l, OW_FF2), FF, FF, FF}; pg8::StaticOrder S; S.init(TOK, D, F.G, c); pg8::EpiRes E{F.out, F.out, wsb(F, WS_XB), SS};
          pg8::gemm_phase<pg8::EpiRes, pg8::StaticOrder, pg8::GemmP, true, true>(F.lds + RING_OFF, g, S, E); }
        GRID_BAR();
    }
    REFRESH();
    final_norm(F);
    if (__hip_atomic_load((gu32*)((unsigned*)(F.ctl + CW_BAR) + XB_TMO), RLX_AGENT) != 0u && blockIdx.x == 0 && F.tid < 64) F.out[F.tid] = __builtin_nanf("");
}

extern "C" void kernel_launch(void* const* d_in, const int* in_sizes, int n_in, void* d_out, int out_size, void* d_ws, size_t ws_size, hipStream_t stream) {
    static int grid = 0;
    if (grid == 0) {
        if (n_in != 24 || out_size != TOK * D || ws_size < WS_END) { fprintf(stderr, "kernel_launch: unexpected problem shape (n_in %d, out %d, ws %zu); nothing launched\n", n_in, out_size, ws_size); grid = -1; return; }
        int dev = 0, cus = 0;
        if (hipGetDevice(&dev) != hipSuccess || hipDeviceGetAttribute(&cus, hipDeviceAttributeMultiprocessorCount, dev) != hipSuccess) { grid = -1; return; }
        if (hipFuncSetAttribute((const void*)mega_fwd, hipFuncAttributeMaxDynamicSharedMemorySize, LDS_BYTES) != hipSuccess) { fprintf(stderr, "kernel_launch: hipFuncSetAttribute failed\n"); grid = -1; return; }
        int per_cu = 0;
        if (hipOccupancyMaxActiveBlocksPerMultiprocessor(&per_cu, (const void*)mega_fwd, NWAVES * 64, LDS_BYTES) != hipSuccess || per_cu < 1) fprintf(stderr, "kernel_launch: occupancy query reports %d workgroups per CU\n", per_cu);
        (void)hipGetLastError();
        if (cus != 256) fprintf(stderr, "kernel_launch: built for a 256-CU device, found %d CUs\n", cus);
        grid = NCU;
    }
    if (grid < 0) return;
    (void)in_sizes;
    if (hipMemsetAsync((char*)d_ws + WS_CTL, 0, CTL_ZERO_BYTES, stream) != hipSuccess) return;
    Args a{};
    for (int i = 0; i < 24; ++i) a.in[i] = (const float*)d_in[i];
    a.out = (float*)d_out; a.ws = (unsigned char*)d_ws;
    hipLaunchKernelGGL(mega_fwd, dim3(grid), dim3(NWAVES * 64), LDS_BYTES, stream, a);
}
```

```cpp
#include <hip/hip_runtime.h>
#include <cstdio>
#include <cstdint>
namespace pg8 {
#define PG8_LAS __attribute__((address_space(3)))
typedef unsigned short bf16_t;
typedef short bf16x8 __attribute__((ext_vector_type(8)));
typedef float f32x4 __attribute__((ext_vector_type(4)));
typedef unsigned u32x4 __attribute__((ext_vector_type(4)));
constexpr int BM = 256, BK = 64, HALF = 128, HTB = HALF * BK * 2  , STAGE_BYTES = 8 * HTB, NXCD = 8, WGM = 8;

__host__ __device__ __forceinline__ int lds_byte(int r, int c) { const int st = (r >> 4) * 2 + (c >> 5), rr = r & 15, cc = c & 31, ob = rr * 64 + cc * 2; return st * 1024 + (ob ^ (((ob >> 9) & 1) << 5)); }
__host__ __device__ __forceinline__ void stage_rc(int b, int& R, int& C) { const int st = b / 1024, sb = b % 1024, swz = sb ^ (((sb >> 9) & 1) << 5); R = (st >> 1) * 16 + swz / 64; C = (st & 1) * 32 + (swz % 64) / 2; }
__host__ __device__ __forceinline__ int perm32(int rho) { const int n = rho >> 4, i = rho & 15; return 8 * (i >> 2) + 4 * n + (i & 3); }

struct Unit { int pm, pn; };

struct StaticOrder {
    int nM, nN, nwg, G, c;
    __host__ __device__ void init(int M, int N, int G_, int c_) { nM = M / BM; nN = N / BM; nwg = nM * nN; G = G_; c = c_; }
    __host__ __device__ bool next(int i, Unit& u) const {
        const long L = (long)i * G + c; if (L >= nwg) return false;
        int wgid = (int)L; { const int q = nwg / NXCD, r = nwg % NXCD, xcd = wgid % NXCD, off = wgid / NXCD; wgid = (xcd < r ? xcd * (q + 1) : r * (q + 1) + (xcd - r) * q) + off; }
        const int nig = WGM * nN, gid = wgid / nig, fm = gid * WGM, gsz = (nM - fm) < WGM ? (nM - fm) : WGM;
        u.pm = fm + ((wgid % nig) % gsz); u.pn = (wgid % nig) / gsz; return true;
    }
    __device__ __forceinline__ void a_ready(const Unit&) const {}
    __device__ __forceinline__ void done(const Unit&) const {}
};
__device__ __forceinline__ unsigned cvt_pk_bf16(float lo, float hi) { unsigned r; asm volatile("v_cvt_pk_bf16_f32 %0, %1, %2" : "=v"(r) : "v"(lo), "v"(hi)); return r; }
template <class Epi, class Sched, class G, bool ALIGN_EPI = false, bool SP2 = false>
__device__ __forceinline__ void gemm_phase(PG8_LAS unsigned char* lds, const G g, const Sched& S, const Epi& E) {
    int tid_ = threadIdx.x; asm volatile("" : "+v"(tid_));
    const int tid = tid_, wid = __builtin_amdgcn_readfirstlane(tid >> 6), lane = tid & 63, wr = wid >> 2, wc = wid & 3, fr = lane & 15, fq = lane >> 4;
    const int K = g.K, nt = K / BK;
    unsigned voffA[2], voffB[2];
#pragma unroll
    for (int i = 0; i < 2; ++i) { int R, C; stage_rc(tid * 16 + i * 8192, R, C); const int Rb = Epi::PERM ? ((R & ~31) + perm32(R & 31)) : R;
        voffA[i] = (unsigned)(R * g.lda + C) * 2u; voffB[i] = (unsigned)(Rb * g.ldb + C) * 2u; }
    const size_t kstep = (size_t)(BK * 2);
    const size_t hstepA = (size_t)HALF * g.lda * 2, hstepB = (size_t)HALF * g.ldb * 2;
    const unsigned ldsw = (unsigned)wid * 1024u;
    const int aoff = lds_byte(wr * 64 + fr, fq * 8), boff = lds_byte(wc * 32 + fr, fq * 8);
#define PG8_SA(b, h) (((b) * 2 + (h)) * HTB)
#define PG8_SB(b, h) ((4 + (b) * 2 + (h)) * HTB)
#define PG8_STAGE(bufoff, gbase, voff) do { _Pragma("unroll") for (int _i = 0; _i < 2; ++_i) \
        __builtin_amdgcn_global_load_lds((const unsigned*)((const char*)(gbase) + (voff)[_i]), (PG8_LAS unsigned*)(lds + (bufoff) + ldsw + _i * 8192), 16, 0, 0); } while (0)
#define PG8_LDA(dst, b, h) do { _Pragma("unroll") for (int m = 0; m < 4; ++m) _Pragma("unroll") for (int k = 0; k < 2; ++k) dst[m][k] = *(const PG8_LAS bf16x8*)(lds + PG8_SA(b, h) + aoff + m * 2048 + k * 1024); } while (0)
#define PG8_LDB(dst, b, h) do { _Pragma("unroll") for (int n = 0; n < 2; ++n) _Pragma("unroll") for (int k = 0; k < 2; ++k) dst[n][k] = *(const PG8_LAS bf16x8*)(lds + PG8_SB(b, h) + boff + n * 2048 + k * 1024); } while (0)
#define PG8_MMA(ai, bj, At, Bt) do { __builtin_amdgcn_s_setprio(1); _Pragma("unroll") for (int m = 0; m < 4; ++m) _Pragma("unroll") for (int n = 0; n < 2; ++n) _Pragma("unroll") for (int k = 0; k < 2; ++k) \
        acc[ai][bj][m][n] = __builtin_amdgcn_mfma_f32_16x16x32_bf16(Bt[n][k], At[m][k], acc[ai][bj][m][n], 0, 0, 0); __builtin_amdgcn_s_setprio(0); } while (0)
#define PG8_WAIT_V(n) asm volatile("s_waitcnt vmcnt(" #n ")" ::: "memory")
#define PG8_WAIT_L(n) asm volatile("s_waitcnt lgkmcnt(" #n ")" ::: "memory")
#define PG8_BAR __builtin_amdgcn_s_barrier()
#define PG8_SCHED __builtin_amdgcn_sched_barrier(0)
    Unit cur, nxt; int ui = 0;
    if (!S.next(0, cur)) return;
    f32x4 acc[2][2][4][2];
#pragma unroll
    for (int a = 0; a < 2; ++a)
#pragma unroll
        for (int b = 0; b < 2; ++b)
#pragma unroll
            for (int m = 0; m < 4; ++m)
#pragma unroll
                for (int n = 0; n < 2; ++n) acc[a][b][m][n] = (f32x4){0.f, 0.f, 0.f, 0.f};
    bf16x8 At[4][2], B0[2][2], B1[2][2];
    const char* cA = g.a_ptr(cur); const char* cB = g.b_ptr(cur);
    S.a_ready(cur);
    if constexpr (SP2) {
        PG8_STAGE(PG8_SB(0, 0), cB, voffB); PG8_STAGE(PG8_SB(0, 1), cB + hstepB, voffB); PG8_STAGE(PG8_SA(0, 0), cA, voffA); PG8_STAGE(PG8_SA(0, 1), cA + hstepA, voffA);
        if (wr == 1) PG8_BAR;
        PG8_WAIT_V(2); PG8_BAR;
        PG8_STAGE(PG8_SB(1, 0), cB + kstep, voffB); PG8_STAGE(PG8_SA(1, 0), cA + kstep, voffA); PG8_STAGE(PG8_SB(1, 1), cB + hstepB + kstep, voffB);
        PG8_WAIT_V(6); PG8_BAR;
    } else {
        PG8_STAGE(PG8_SB(0, 0), cB, voffB); PG8_STAGE(PG8_SA(0, 0), cA, voffA); PG8_STAGE(PG8_SB(0, 1), cB + hstepB, voffB); PG8_STAGE(PG8_SA(0, 1), cA + hstepA, voffA);
        if (wr == 1) PG8_BAR;
        PG8_WAIT_V(4); PG8_BAR;
        PG8_STAGE(PG8_SB(1, 0), cB + kstep, voffB); PG8_STAGE(PG8_SA(1, 0), cA + kstep, voffA); PG8_STAGE(PG8_SB(1, 1), cB + hstepB + kstep, voffB);
        PG8_WAIT_V(6); PG8_BAR;
    }
    for (;;) {
        const bool has_next = S.next(ui + 1, nxt);
        const char* nA = has_next ? g.a_ptr(nxt) : cA; const char* nB = has_next ? g.b_ptr(nxt) : cB;
        for (int t = 0; t < nt; t += 2) {
            const bool last = (t == nt - 2);
            const char* a1 = cA + (size_t)(t + 1) * kstep;
            const char* a2 = last ? nA : cA + (size_t)(t + 2) * kstep; const char* b2 = last ? nB : cB + (size_t)(t + 2) * kstep;
            const char* a3 = a2 + kstep; const char* b3 = b2 + kstep;
            if (last && has_next) S.a_ready(nxt);
            if constexpr (SP2) {
            PG8_LDB(B0, 0, 0); PG8_LDB(B1, 0, 1); PG8_SCHED; PG8_LDA(At, 0, 0); PG8_STAGE(PG8_SA(1, 1), a1 + hstepA, voffA);
            PG8_WAIT_V(8); PG8_WAIT_L(0); PG8_BAR; PG8_MMA(0, 0, At, B0); PG8_MMA(0, 1, At, B1); PG8_BAR; PG8_SCHED;
            PG8_LDA(At, 0, 1); PG8_STAGE(PG8_SB(0, 0), b2, voffB); PG8_STAGE(PG8_SB(0, 1), b2 + hstepB, voffB); PG8_STAGE(PG8_SA(0, 0), a2, voffA);
            PG8_WAIT_V(8); PG8_WAIT_L(0); PG8_BAR; PG8_MMA(1, 0, At, B0); PG8_MMA(1, 1, At, B1); PG8_BAR; PG8_SCHED;
            PG8_LDB(B0, 1, 0); PG8_LDB(B1, 1, 1); PG8_SCHED; PG8_LDA(At, 1, 0); PG8_STAGE(PG8_SA(0, 1), a2 + hstepA, voffA);
            PG8_WAIT_V(8); PG8_WAIT_L(0); PG8_BAR; PG8_MMA(0, 0, At, B0); PG8_MMA(0, 1, At, B1); PG8_BAR; PG8_SCHED;
            PG8_LDA(At, 1, 1); PG8_STAGE(PG8_SB(1, 0), b3, voffB); PG8_STAGE(PG8_SB(1, 1), b3 + hstepB, voffB); PG8_STAGE(PG8_SA(1, 0), a3, voffA);
            PG8_WAIT_V(8); PG8_WAIT_L(0); PG8_BAR; PG8_MMA(1, 0, At, B0); PG8_MMA(1, 1, At, B1); PG8_BAR; PG8_SCHED;
            } else {
            PG8_LDB(B0, 0, 0); PG8_SCHED; PG8_LDA(At, 0, 0); PG8_STAGE(PG8_SA(1, 1), a1 + hstepA, voffA);
            PG8_WAIT_L(8); PG8_BAR; PG8_WAIT_L(0); PG8_MMA(0, 0, At, B0); PG8_BAR; PG8_SCHED;
            PG8_LDB(B1, 0, 1); PG8_STAGE(PG8_SB(0, 0), b2, voffB);
            PG8_BAR; PG8_WAIT_L(0); PG8_MMA(0, 1, At, B1); PG8_BAR;
            PG8_LDA(At, 0, 1); PG8_STAGE(PG8_SA(0, 0), a2, voffA);
            PG8_BAR; PG8_WAIT_L(0); PG8_MMA(1, 0, At, B0); PG8_BAR; PG8_SCHED;
            PG8_STAGE(PG8_SB(0, 1), b2 + hstepB, voffB);
            PG8_WAIT_V(6); PG8_BAR; PG8_MMA(1, 1, At, B1); PG8_BAR;
            PG8_LDB(B0, 1, 0); PG8_SCHED; PG8_LDA(At, 1, 0); PG8_STAGE(PG8_SA(0, 1), a2 + hstepA, voffA);
            PG8_WAIT_L(8); PG8_BAR; PG8_WAIT_L(0); PG8_MMA(0, 0, At, B0); PG8_BAR; PG8_SCHED;
            PG8_LDB(B1, 1, 1); PG8_STAGE(PG8_SB(1, 0), b3, voffB);
            PG8_BAR; PG8_WAIT_L(0); PG8_MMA(0, 1, At, B1); PG8_BAR;
            PG8_LDA(At, 1, 1); PG8_STAGE(PG8_SA(1, 0), a3, voffA);
            PG8_BAR; PG8_WAIT_L(0); PG8_MMA(1, 0, At, B0); PG8_BAR; PG8_SCHED;
            PG8_STAGE(PG8_SB(1, 1), b3 + hstepB, voffB);
            PG8_WAIT_V(6); PG8_BAR; PG8_MMA(1, 1, At, B1); PG8_BAR;
            }
        }
        if constexpr (ALIGN_EPI) { if (wr == 0) PG8_BAR; }
        if constexpr (!Epi::AFTER_DRAIN) { int te_ = threadIdx.x; asm volatile("" : "+v"(te_)); E(acc, cur, wr, wc, te_ & 15, (te_ & 63) >> 4); S.done(cur); }
        if (!has_next) break;
#pragma unroll
        for (int a = 0; a < 2; ++a)
#pragma unroll
            for (int b = 0; b < 2; ++b)
#pragma unroll
                for (int m = 0; m < 4; ++m)
#pragma unroll
                    for (int n = 0; n < 2; ++n) acc[a][b][m][n] = (f32x4){0.f, 0.f, 0.f, 0.f};
        cur = nxt; cA = nA; cB = nB; ++ui;
        if constexpr (ALIGN_EPI) { if (wr == 1) PG8_BAR; }
    }
    PG8_WAIT_V(0);
    if constexpr (!ALIGN_EPI) { if (wr == 0) PG8_BAR; }
    PG8_BAR;
    if constexpr (Epi::AFTER_DRAIN) { int te_ = threadIdx.x; asm volatile("" : "+v"(te_)); E.fused(acc, cur, wr, wc, te_ & 15, (te_ & 63) >> 4, lds, wid, te_ & 63); S.done(cur); }
#undef PG8_SA
#undef PG8_SB
#undef PG8_STAGE
#undef PG8_LDA
#undef PG8_LDB
#undef PG8_MMA
#undef PG8_WAIT_V
#undef PG8_WAIT_L
#undef PG8_BAR
#undef PG8_SCHED
}
constexpr int TOK = 16384;
constexpr float RMS_EPS = 1e-6f;
struct GemmP { const bf16_t* A; const bf16_t* Bt; int lda, ldb, K;
    __device__ __forceinline__ const char* a_ptr(const Unit& u) const { return (const char*)(A + (size_t)u.pm * BM * lda); }
    __device__ __forceinline__ const char* b_ptr(const Unit& u) const { return (const char*)(Bt + (size_t)u.pn * BM * ldb); } };
struct GemmX { const bf16_t* A; const bf16_t* Bt; int lda, ldb, K;
    __device__ __forceinline__ const char* a_ptr(const Unit& u) const { return (const char*)(A + ((size_t)u.pn * TOK + (size_t)u.pm * BM) * 256); }
    __device__ __forceinline__ const char* b_ptr(const Unit& u) const { return (const char*)(Bt + (size_t)((u.pm >> 3) * 4 + u.pn) * 65536); } };

struct GemmProj { const bf16_t* XB; const bf16_t* WIN; const bf16_t* HM; const bf16_t* WKV0; size_t wkv_lstride; int lda, ldb, K;
    __device__ __forceinline__ const char* a_ptr(const Unit& u) const {
        if (u.pn < 9) return (const char*)(XB + (size_t)u.pm * BM * 1024);
        const int idx = 2 * u.pm + (u.pn - 9), l = idx >> 6, part = (idx >> 5) & 1, b = (idx >> 2) & 7, h = idx & 3;
        return part == 0 ? (const char*)(HM + ((size_t)l * 2048 + b * 256) * 1024) : (const char*)(WKV0 + (size_t)l * wkv_lstride + (size_t)(1024 + h * 256) * 1024); }
    __device__ __forceinline__ const char* b_ptr(const Unit& u) const {
        if (u.pn < 9) return (const char*)(WIN + (size_t)u.pn * BM * 1024);
        const int idx = 2 * u.pm + (u.pn - 9), l = idx >> 6, part = (idx >> 5) & 1, b = (idx >> 2) & 7, h = idx & 3;
        return part == 0 ? (const char*)(WKV0 + (size_t)l * wkv_lstride + (size_t)(h * 256) * 1024) : (const char*)(HM + ((size_t)l * 2048 + b * 256) * 1024); } };
typedef unsigned u32x2 __attribute__((ext_vector_type(2)));
template <bool MAX> __device__ __forceinline__ float comb16(float s) { const auto r = __builtin_amdgcn_permlane16_swap(__float_as_uint(s), __float_as_uint(s), false, false);
    const float a = __uint_as_float(r[0]), b = __uint_as_float(r[1]); return MAX ? __builtin_fmaxf(a, b) : a + b; }
template <bool MAX> __device__ __forceinline__ float comb32(float s) { const auto r = __builtin_amdgcn_permlane32_swap(__float_as_uint(s), __float_as_uint(s), false, false);
    const float a = __uint_as_float(r[0]), b = __uint_as_float(r[1]); return MAX ? __builtin_fmaxf(a, b) : a + b; }
__device__ __forceinline__ float bf_lo(unsigned w) { return __uint_as_float(w << 16); }
__device__ __forceinline__ float bf_hi(unsigned w) { return __uint_as_float(w & 0xffff0000u); }
__device__ __forceinline__ float fast_sigmoid(float z) { return __builtin_amdgcn_rcpf(1.0f + __builtin_amdgcn_exp2f(-1.4426950408889634f * z)); }
__device__ __forceinline__ float gelu_tanh(float x) {
    const float u = x * (0.7978845608028654f + 0.035677408136300125f * x * x);
    return x * __builtin_amdgcn_rcpf(1.0f + __builtin_amdgcn_exp2f(-2.8853900817779268f * u)); }
__device__ __forceinline__ void load_rstd(float (&rs)[2][4], const float* SS, const Unit& u, int wr, int fr, int fq) {
#pragma unroll
    for (int ai = 0; ai < 2; ++ai)
#pragma unroll
        for (int m = 0; m < 4; ++m) { const f32x4 a = *((const f32x4*)(SS + (size_t)(u.pm * BM + ai * HALF + wr * 64 + m * 16 + fr) * 16) + fq);
            float s = (a[0] + a[1]) + (a[2] + a[3]); s = comb16<false>(s); s = comb32<false>(s);
            rs[ai][m] = __builtin_amdgcn_rsqf(s * (1.0f / 1024.0f) + RMS_EPS); }
}
struct EpiProj { static constexpr bool PERM = true, AFTER_DRAIN = false;
    bf16_t *PA, *Q, *K, *V, *ZC; const float* SS; float qscale; bf16_t *XKV0, *XKV1;
    __device__ __forceinline__ void operator()(const f32x4 (&acc)[2][2][4][2], const Unit& u, int wr, int wc, int fr, int fq) const {
        const int pn = u.pn; bf16_t* base; int ldc, colt, mode;
        if (pn >= 9) {
            const int idx = 2 * u.pm + (pn - 9), l = idx >> 6, part = (idx >> 5) & 1, b = (idx >> 2) & 7, h = idx & 3;
            bf16_t* tb = (l == 0 ? XKV0 : XKV1) + (size_t)(part * 32 + b * 4 + h) * 65536; const int r0 = wr * 64 + fr, c0 = wc * 32 + 8 * fq;
#pragma unroll
            for (int ai = 0; ai < 2; ++ai)
#pragma unroll
                for (int m = 0; m < 4; ++m) { bf16_t* rowp = tb + (size_t)(r0 + ai * HALF + m * 16) * 256 + c0;
#pragma unroll
                    for (int bj = 0; bj < 2; ++bj) { const f32x4 v0 = acc[ai][bj][m][0], v1 = acc[ai][bj][m][1];
                        u32x4 w; w.x = cvt_pk_bf16(v0[0], v0[1]); w.y = cvt_pk_bf16(v0[2], v0[3]); w.z = cvt_pk_bf16(v1[0], v1[1]); w.w = cvt_pk_bf16(v1[2], v1[3]);
                        *(u32x4*)(rowp + bj * HALF) = w; } }
            return; }
        if (pn == 0) { base = PA; ldc = 256; colt = 0; mode = 0; }
        else if (pn <= 2) { base = Q; ldc = 512; colt = (pn - 1) * 256; mode = 1; }
        else if (pn <= 4) { base = K; ldc = 512; colt = (pn - 3) * 256; mode = 0; }
        else if (pn <= 6) { base = V; ldc = 512; colt = (pn - 5) * 256; mode = 0; }
        else { base = ZC; ldc = 512; colt = (pn - 7) * 256; mode = 2; }
        float rs[2][4]; load_rstd(rs, SS, u, wr, fr, fq);
        const float sc = (mode == 1) ? qscale : 1.0f;
        const int row0 = u.pm * BM + wr * 64 + fr, col0 = colt + wc * 32 + 8 * fq;
#pragma unroll
        for (int ai = 0; ai < 2; ++ai)
#pragma unroll
            for (int m = 0; m < 4; ++m) { bf16_t* rowp = base + (size_t)(row0 + ai * HALF + m * 16) * ldc + col0; const float r = rs[ai][m] * sc;
#pragma unroll
                for (int bj = 0; bj < 2; ++bj) { f32x4 v0 = acc[ai][bj][m][0] * r, v1 = acc[ai][bj][m][1] * r;
                    if (mode == 2) { v0 = (f32x4){gelu_tanh(v0[0]), gelu_tanh(v0[1]), gelu_tanh(v0[2]), gelu_tanh(v0[3])}; v1 = (f32x4){gelu_tanh(v1[0]), gelu_tanh(v1[1]), gelu_tanh(v1[2]), gelu_tanh(v1[3])}; }
                    u32x4 w; w.x = cvt_pk_bf16(v0[0], v0[1]); w.y = cvt_pk_bf16(v0[2], v0[3]); w.z = cvt_pk_bf16(v1[0], v1[1]); w.w = cvt_pk_bf16(v1[2], v1[3]);
                    *(u32x4*)(rowp + bj * HALF) = w; } }
    }
};
struct EpiTile { static constexpr bool PERM = true, AFTER_DRAIN = false;
    bf16_t* O; int mm, mn;
    __device__ __forceinline__ void operator()(const f32x4 (&acc)[2][2][4][2], const Unit& u, int wr, int wc, int fr, int fq) const {
        bf16_t* base = O + (size_t)(mm * u.pm + mn * u.pn) * 65536; const int row0 = wr * 64 + fr, col0 = wc * 32 + 8 * fq;
#pragma unroll
        for (int ai = 0; ai < 2; ++ai)
#pragma unroll
            for (int m = 0; m < 4; ++m) { bf16_t* rowp = base + (size_t)(row0 + ai * HALF + m * 16) * 256 + col0;
#pragma unroll
                for (int bj = 0; bj < 2; ++bj) { const f32x4 v0 = acc[ai][bj][m][0], v1 = acc[ai][bj][m][1];
                    u32x4 w; w.x = cvt_pk_bf16(v0[0], v0[1]); w.y = cvt_pk_bf16(v0[2], v0[3]); w.z = cvt_pk_bf16(v1[0], v1[1]); w.w = cvt_pk_bf16(v1[2], v1[3]);
                    *(u32x4*)(rowp + bj * HALF) = w; } }
    }
};
template <int ACT  , bool ROWSCALE, bool HEADMAJOR> struct EpiStore { static constexpr bool PERM = true, AFTER_DRAIN = false;
    bf16_t* O; int ldc; const float* SS; float scale;
    __device__ __forceinline__ void operator()(const f32x4 (&acc)[2][2][4][2], const Unit& u, int wr, int wc, int fr, int fq) const {
        float rs[2][4];
        if (ROWSCALE) load_rstd(rs, SS, u, wr, fr, fq);
        bf16_t* base = O; int colt = u.pn * BM;
        if (HEADMAJOR) { base += (size_t)u.pn * TOK * 256; colt = 0; }
        const int row0 = u.pm * BM + wr * 64 + fr, col0 = colt + wc * 32 + 8 * fq;
#pragma unroll
        for (int ai = 0; ai < 2; ++ai)
#pragma unroll
            for (int m = 0; m < 4; ++m) { bf16_t* rowp = base + (size_t)(row0 + ai * HALF + m * 16) * ldc + col0; const float r = ROWSCALE ? rs[ai][m] * scale : scale;
#pragma unroll
                for (int bj = 0; bj < 2; ++bj) { f32x4 v0 = acc[ai][bj][m][0] * r, v1 = acc[ai][bj][m][1] * r;
                    if (ACT == 1) {
#pragma unroll
                        for (int i = 0; i < 4; ++i) { const float a = __builtin_fmaxf(v0[i], 0.f), b = __builtin_fmaxf(v1[i], 0.f); v0[i] = a * a; v1[i] = b * b; } }
                    u32x4 w; w.x = cvt_pk_bf16(v0[0], v0[1]); w.y = cvt_pk_bf16(v0[2], v0[3]); w.z = cvt_pk_bf16(v1[0], v1[1]); w.w = cvt_pk_bf16(v1[2], v1[3]);
                    *(u32x4*)(rowp + bj * HALF) = w; } }
    }
};
template <bool FIRST> struct EpiGate { static constexpr bool PERM = true, AFTER_DRAIN = false;
    const bf16_t* Y; bf16_t* MG; const float* bias; const float* SS;
    __device__ __forceinline__ void operator()(const f32x4 (&acc)[2][2][4][2], const Unit& u, int wr, int wc, int fr, int fq) const {
        float rs[2][4]; load_rstd(rs, SS, u, wr, fr, fq);
        const int row0 = u.pm * BM + wr * 64 + fr, col0 = u.pn * BM + wc * 32 + 8 * fq;
        f32x4 bv[2][2];
#pragma unroll
        for (int bj = 0; bj < 2; ++bj)
#pragma unroll
            for (int n = 0; n < 2; ++n) bv[bj][n] = *(const f32x4*)(bias + col0 + bj * HALF + 4 * n);
#pragma unroll
        for (int ai = 0; ai < 2; ++ai)
#pragma unroll
            for (int m = 0; m < 4; ++m) { const size_t off = (size_t)(row0 + ai * HALF + m * 16) * 1024 + col0; const float r = rs[ai][m];
#pragma unroll
                for (int bj = 0; bj < 2; ++bj) { const f32x4 z0 = acc[ai][bj][m][0] * r + bv[bj][0], z1 = acc[ai][bj][m][1] * r + bv[bj][1];
                    const u32x4 y = *(const u32x4*)(Y + off + bj * HALF);
                    float o0 = fast_sigmoid(z0[0]) * bf_lo(y.x), o1 = fast_sigmoid(z0[1]) * bf_hi(y.x), o2 = fast_sigmoid(z0[2]) * bf_lo(y.y), o3 = fast_sigmoid(z0[3]) * bf_hi(y.y);
                    float o4 = fast_sigmoid(z1[0]) * bf_lo(y.z), o5 = fast_sigmoid(z1[1]) * bf_hi(y.z), o6 = fast_sigmoid(z1[2]) * bf_lo(y.w), o7 = fast_sigmoid(z1[3]) * bf_hi(y.w);
                    if (!FIRST) { const u32x4 p = *(const u32x4*)(MG + off + bj * HALF);
                        o0 += bf_lo(p.x); o1 += bf_hi(p.x); o2 += bf_lo(p.y); o3 += bf_hi(p.y); o4 += bf_lo(p.z); o5 += bf_hi(p.z); o6 += bf_lo(p.w); o7 += bf_hi(p.w); }
                    u32x4 w; w.x = cvt_pk_bf16(o0, o1); w.y = cvt_pk_bf16(o2, o3); w.z = cvt_pk_bf16(o4, o5); w.w = cvt_pk_bf16(o6, o7);
                    *(u32x4*)(MG + off + bj * HALF) = w; }
                if (m & 1) asm volatile("" ::: "memory"); }
    }
};
struct EpiRes { static constexpr bool PERM = true, AFTER_DRAIN = false;
    bf16_t* xb; float* outf; float* SS;
    __device__ __forceinline__ void operator()(const f32x4 (&acc)[2][2][4][2], const Unit& u, int wr, int wc, int fr, int fq) const {
        const int row0 = u.pm * BM + wr * 64 + fr, col0 = u.pn * BM + wc * 32 + 8 * fq;
#pragma unroll
        for (int ai = 0; ai < 2; ++ai)
#pragma unroll
            for (int m = 0; m < 4; ++m) { const int row = row0 + ai * HALF + m * 16; const size_t off = (size_t)row * 1024 + col0; float ss = 0.f;
#pragma unroll
                for (int bj = 0; bj < 2; ++bj) { const u32x4 y = *(const u32x4*)(xb + off + bj * HALF);
                    const f32x4 v0 = acc[ai][bj][m][0] + (f32x4){bf_lo(y.x), bf_hi(y.x), bf_lo(y.y), bf_hi(y.y)}, v1 = acc[ai][bj][m][1] + (f32x4){bf_lo(y.z), bf_hi(y.z), bf_lo(y.w), bf_hi(y.w)};
                    ss += ((v0[0] * v0[0] + v0[1] * v0[1]) + (v0[2] * v0[2] + v0[3] * v0[3])) + ((v1[0] * v1[0] + v1[1] * v1[1]) + (v1[2] * v1[2] + v1[3] * v1[3]));
                    if (outf) { *(f32x4*)(outf + off + bj * HALF) = v0; *(f32x4*)(outf + off + bj * HALF + 4) = v1; }
                    else { u32x4 w; w.x = cvt_pk_bf16(v0[0], v0[1]); w.y = cvt_pk_bf16(v0[2], v0[3]); w.z = cvt_pk_bf16(v1[0], v1[1]); w.w = cvt_pk_bf16(v1[2], v1[3]); *(u32x4*)(xb + off + bj * HALF) = w; } }
                ss = comb16<false>(ss); ss = comb32<false>(ss);
                if (fq == 0) SS[(size_t)row * 16 + u.pn * 4 + wc] = ss;
                if (m & 1) asm volatile("" ::: "memory"); }
    }
};
struct EpiSoftmax { static constexpr bool PERM = true, AFTER_DRAIN = true;
    bf16_t* P;
    __device__ __forceinline__ void fused(f32x4 (&acc)[2][2][4][2], const Unit& u, int wr, int wc, int fr, int fq, PG8_LAS unsigned char* lds, int wid, int lane) const {
        PG8_LAS float* Pm = (PG8_LAS float*)lds; PG8_LAS float* Ps = Pm + 1024;
#pragma unroll
        for (int ai = 0; ai < 2; ++ai)
#pragma unroll
            for (int m = 0; m < 4; ++m) { float t = -INFINITY;
#pragma unroll
                for (int bj = 0; bj < 2; ++bj)
#pragma unroll
                    for (int n = 0; n < 2; ++n) { const f32x4 x = acc[ai][bj][m][n]; t = __builtin_fmaxf(t, __builtin_fmaxf(__builtin_fmaxf(x[0], x[1]), __builtin_fmaxf(x[2], x[3]))); }
                t = comb16<true>(t); t = comb32<true>(t);
                if (fq == 0) Pm[(ai * HALF + wr * 64 + m * 16 + fr) * 4 + wc] = t; }
        asm volatile("s_waitcnt lgkmcnt(0)" ::: "memory"); __builtin_amdgcn_s_barrier(); asm volatile("" ::: "memory");
#pragma unroll
        for (int ai = 0; ai < 2; ++ai)
#pragma unroll
            for (int m = 0; m < 4; ++m) { const int r = ai * HALF + wr * 64 + m * 16 + fr; const f32x4 mm = *(const PG8_LAS f32x4*)(Pm + r * 4);
                const float mx = __builtin_fmaxf(__builtin_fmaxf(mm[0], mm[1]), __builtin_fmaxf(mm[2], mm[3])); float s = 0.f;
#pragma unroll
                for (int bj = 0; bj < 2; ++bj)
#pragma unroll
                    for (int n = 0; n < 2; ++n) { f32x4 x = acc[ai][bj][m][n];
#pragma unroll
                        for (int i = 0; i < 4; ++i) x[i] = __builtin_amdgcn_exp2f(x[i] - mx);
                        acc[ai][bj][m][n] = x; s += (x[0] + x[1]) + (x[2] + x[3]); }
                s = comb16<false>(s); s = comb32<false>(s);
                if (fq == 0) Ps[r * 4 + wc] = s; }
        asm volatile("s_waitcnt lgkmcnt(0)" ::: "memory"); __builtin_amdgcn_s_barrier(); asm volatile("" ::: "memory");
        bf16_t* base = P + ((size_t)u.pn * TOK + (size_t)u.pm * BM) * 256; const int col0 = wc * 32 + 8 * fq;
#pragma unroll
        for (int ai = 0; ai < 2; ++ai)
#pragma unroll
            for (int m = 0; m < 4; ++m) { const int r = ai * HALF + wr * 64 + m * 16 + fr; const f32x4 sm = *(const PG8_LAS f32x4*)(Ps + r * 4);
                const float inv = 1.0f / ((sm[0] + sm[1]) + (sm[2] + sm[3])); bf16_t* rowp = base + (size_t)r * 256 + col0;
#pragma unroll
                for (int bj = 0; bj < 2; ++bj) { const f32x4 v0 = acc[ai][bj][m][0] * inv, v1 = acc[ai][bj][m][1] * inv;
                    u32x4 w; w.x = cvt_pk_bf16(v0[0], v0[1]); w.y = cvt_pk_bf16(v0[2], v0[3]); w.z = cvt_pk_bf16(v1[0], v1[1]); w.w = cvt_pk_bf16(v1[2], v1[3]);
                    *(u32x4*)(rowp + bj * HALF) = w; } }
        asm volatile("s_waitcnt lgkmcnt(0)" ::: "memory"); __builtin_amdgcn_s_barrier(); asm volatile("" ::: "memory");
    }
};
}

#include <hip/hip_bf16.h>
#include <cmath>
namespace attn_body {
using bf16=__hip_bfloat16;
using bf16x8=__attribute__((ext_vector_type(8)))short;
using s16x4=__attribute__((ext_vector_type(4)))short;
using f32x16=__attribute__((ext_vector_type(16)))float;
using u32x4=__attribute__((ext_vector_type(4)))unsigned;
constexpr int BATCH=8,NHEAD=8,SEQ=2048,D=64,DM=NHEAD*D;
constexpr int NW=8,QBLK=32,QB=QBLK*NW,KVBLK=64,NQB=SEQ/QB;
constexpr int ATTN_PITCH=DM, ATTN_UNIT_ROWS=QB;
__device__ __forceinline__ int crow(int r,int hi){return (r&3)+8*(r>>2)+4*hi;}
#define SBAR() __builtin_amdgcn_sched_barrier(0)
__device__ __forceinline__ void cmask(f32x16&p0,f32x16&p1,int jb,int qrel,int hi){
  const float NEG=-INFINITY; int kb=64*jb+4*hi;
  #pragma unroll
  for(int r=0;r<16;++r){int kv=kb+(r&3)+8*(r>>2); if(kv>qrel)p0[r]=NEG; if(kv+32>qrel)p1[r]=NEG;}
}

constexpr int NSLOT=3, SLOTB=8192;
constexpr int LDS_K=0, LDS_V=NSLOT*SLOTB, LDS_WS=2*NSLOT*SLOTB, LDS_OST=LDS_WS+NW*64*4, LDS_BYTES=LDS_OST+NW*4096, LDS_NB=LDS_BYTES;
constexpr float C2=0.125f*1.4426950408889634f;
__device__ __forceinline__ void glds16(const void*gsrc,unsigned lds_dst){unsigned keep;
  asm volatile("s_mov_b32 %0, m0\n\ts_mov_b32 m0, %2\n\ts_nop 0\n\tglobal_load_lds_dwordx4 %1, off\n\ts_mov_b32 m0, %0":"=&s"(keep):"v"(gsrc),"s"(lds_dst):"memory");}
__device__ __forceinline__ float max3f(float a,float b,float c){float r;asm("v_max3_f32 %0, %1, %2, %3":"=v"(r):"v"(a),"v"(b),"v"(c));return r;}
__device__ __forceinline__ float max2f(float a,float b){float r;asm("v_max_f32_e32 %0, %1, %2":"=v"(r):"v"(a),"v"(b));return r;}
__device__ __forceinline__ float fadd_s(float a,float b){float r;asm("v_add_f32_e32 %0, %1, %2":"=v"(r):"v"(a),"v"(b));return r;}
__device__ __forceinline__ float fsub_s(float a,float b){float r;asm("v_sub_f32_e32 %0, %1, %2":"=v"(r):"v"(a),"v"(b));return r;}
typedef float f32x2_t __attribute__((ext_vector_type(2))); typedef __bf16 bf16x2_t __attribute__((ext_vector_type(2)));
__device__ __forceinline__ unsigned cvtpk_s(float lo,float hi){f32x2_t v={lo,hi};bf16x2_t b=__builtin_convertvector(v,bf16x2_t);return __builtin_bit_cast(unsigned,b);}
#define WAIT_BAR(N) asm volatile("s_waitcnt vmcnt(" #N ") lgkmcnt(0)\n\ts_barrier":::"memory")

__device__ __forceinline__ void qkt(f32x16&p0,f32x16&p1,const char*Kslot,const bf16x8*qr,int r32,int hi){
  const char*kb=Kslot+hi*1024+r32*16;
  #pragma unroll
  for(int d0=0;d0<4;++d0){
    const bf16x8 b0=*reinterpret_cast<const bf16x8*>(kb+d0*2048);
    const bf16x8 b1=*reinterpret_cast<const bf16x8*>(kb+d0*2048+512);
    p0=__builtin_amdgcn_mfma_f32_32x32x16_bf16(b0,qr[d0],p0,0,0,0);p1=__builtin_amdgcn_mfma_f32_32x32x16_bf16(b1,qr[d0],p1,0,0,0);}
}
typedef __attribute__((address_space(3))) const char* lds_cptr;
typedef short v4i16_t __attribute__((ext_vector_type(4)));
__device__ __forceinline__ void kload8(bf16x8*kf,lds_cptr kp){
  kf[0]=*(const __attribute__((address_space(3))) bf16x8*)(kp);      kf[1]=*(const __attribute__((address_space(3))) bf16x8*)(kp+512);
  kf[2]=*(const __attribute__((address_space(3))) bf16x8*)(kp+2048); kf[3]=*(const __attribute__((address_space(3))) bf16x8*)(kp+2560);
  kf[4]=*(const __attribute__((address_space(3))) bf16x8*)(kp+4096); kf[5]=*(const __attribute__((address_space(3))) bf16x8*)(kp+4608);
  kf[6]=*(const __attribute__((address_space(3))) bf16x8*)(kp+6144); kf[7]=*(const __attribute__((address_space(3))) bf16x8*)(kp+6656);
}
__device__ __forceinline__ void kload2(bf16x8*kf,lds_cptr kp,int j){ kf[2*j]=*(const __attribute__((address_space(3))) bf16x8*)(kp+j*2048); kf[2*j+1]=*(const __attribute__((address_space(3))) bf16x8*)(kp+j*2048+512); }
__device__ __forceinline__ s16x4 vtr(lds_cptr p){ return __builtin_bit_cast(s16x4,__builtin_amdgcn_ds_read_tr16_b64_v4i16((__attribute__((address_space(3))) v4i16_t*)p)); }
__device__ __forceinline__ float rowmax(const f32x16&p0,const f32x16&p1){
  float a=max3f(p0[0],p0[1],p1[0]),b=max3f(p0[2],p0[3],p1[1]);a=max3f(a,p1[2],p1[3]);
  #pragma unroll
  for(int r=4;r<16;r+=4){a=max3f(a,p0[r],p0[r+1]);b=max3f(b,p0[r+2],p0[r+3]);a=max3f(a,p1[r],p1[r+1]);b=max3f(b,p1[r+2],p1[r+3]);}
  const float m=max2f(a,b);
  auto rr=__builtin_amdgcn_permlane32_swap(__float_as_uint(m),__float_as_uint(m),false,false);
  return max2f(__uint_as_float(rr[0]),__uint_as_float(rr[1]));
}
__device__ __forceinline__ void pv(f32x16*o,int vb,bf16x8 pa0,bf16x8 pa1,bf16x8 pa2,bf16x8 pa3){
  #pragma unroll
  for(int d0=0;d0<2;++d0){s16x4 lo[4],hi[4];
    #pragma unroll
    for(int ks=0;ks<4;++ks){
      asm volatile("ds_read_b64_tr_b16 %0,%1 offset:%c2":"=&v"(lo[ks]):"v"(vb),"i"(d0*4096+ks*1024):"memory");
      asm volatile("ds_read_b64_tr_b16 %0,%1 offset:%c2":"=&v"(hi[ks]):"v"(vb),"i"(d0*4096+ks*1024+512):"memory");}
    asm volatile("s_waitcnt lgkmcnt(0)":::"memory");SBAR();
    #define PK(k) (bf16x8){lo[k][0],lo[k][1],lo[k][2],lo[k][3],hi[k][0],hi[k][1],hi[k][2],hi[k][3]}
    o[d0]=__builtin_amdgcn_mfma_f32_32x32x16_bf16(pa0,PK(0),o[d0],0,0,0);
    o[d0]=__builtin_amdgcn_mfma_f32_32x32x16_bf16(pa1,PK(1),o[d0],0,0,0);
    o[d0]=__builtin_amdgcn_mfma_f32_32x32x16_bf16(pa2,PK(2),o[d0],0,0,0);
    o[d0]=__builtin_amdgcn_mfma_f32_32x32x16_bf16(pa3,PK(3),o[d0],0,0,0);
    #undef PK
  }
}

#ifndef ATTN_STORE16
#define ATTN_STORE16(p,v) (*(u32x4*)(p)=(v))
#endif
template<int THRL> __device__ __forceinline__ void attn_unit(int b,int h,int qb,const bf16*Q,const bf16*__restrict__ K,const bf16*__restrict__ V,bf16*O,char*shm){
  int tid_=threadIdx.x; asm volatile("":"+v"(tid_)); const int tid=tid_,lane=tid&63,r32=lane&31,hi=lane>>5; const int wid=__builtin_amdgcn_readfirstlane(tid>>6);
  const long rowbase=(long)b*SEQ; const int q0=qb*QB;
  const bf16*Qw=Q+(rowbase+q0+wid*QBLK)*DM+h*D;
  const bf16*Kh=K+rowbase*DM+h*D,*Vh=V+rowbase*DM+h*D;
  const unsigned lds0=(unsigned)(uintptr_t)shm;
  float*wsf=(float*)(shm+LDS_WS)+wid*64;
  const bf16*ksrc=Kh+(long)lane*DM+wid*8;
  const bf16*vsrc=Vh+(long)(16*(wid&3)+(lane>>2))*DM+(wid>>2)*32+(lane&3)*8;
  const unsigned kdst=lds0+LDS_K+wid*1024, vdst=lds0+LDS_V+wid*1024;
  #define DMA_K(t,slot) glds16(ksrc+(long)(t)*KVBLK*DM,(unsigned)__builtin_amdgcn_readfirstlane(kdst+(slot)))
  #define DMA_V(t,slot) glds16(vsrc+(long)(t)*KVBLK*DM,(unsigned)__builtin_amdgcn_readfirstlane(vdst+(slot)))
  const int vb0=(int)(lds0+LDS_V)+((lane>>4)&1)*32+(lane&3)*8+(4*hi+((lane&15)>>2))*64;
  const char*Kbase=shm+LDS_K; bf16x8 kf[8];
  const lds_cptr shm3=(lds_cptr)shm; const lds_cptr kp0=shm3+LDS_K+hi*1024+r32*16; const lds_cptr vp0=shm3+LDS_V+((lane>>4)&1)*32+(lane&3)*8+(4*hi+((lane&15)>>2))*64;
  const int NT=(q0+QB)/KVBLK;
  DMA_K(0,0);DMA_V(0,0);DMA_K(1,SLOTB);
  bf16x8 qr[4];
  #pragma unroll
  for(int d0=0;d0<4;++d0)qr[d0]=*reinterpret_cast<const bf16x8*>(&Qw[(long)r32*DM+d0*16+hi*8]);
  float mhat=0.f,l_reg=0.f;f32x16 o[2];o[0]=f32x16{};o[1]=f32x16{};
  typedef float f32x4_t __attribute__((ext_vector_type(4)));
  const __attribute__((address_space(3))) f32x4_t* nb3=(const __attribute__((address_space(3))) f32x4_t*)((lds_cptr)shm+LDS_NB+hi*16);
  #define LDBIAS(C0,C1,t) do{ const __attribute__((address_space(3))) f32x4_t* nb_=nb3+16*(t); \
    _Pragma("unroll") for(int g_=0;g_<4;++g_){ const f32x4_t a_=nb_[2*g_], b_=nb_[8+2*g_]; \
      C0[4*g_]=a_[0];C0[4*g_+1]=a_[1];C0[4*g_+2]=a_[2];C0[4*g_+3]=a_[3]; C1[4*g_]=b_[0];C1[4*g_+1]=b_[1];C1[4*g_+2]=b_[2];C1[4*g_+3]=b_[3]; } }while(0)
  const int qrel=wid*QBLK+r32;
  #define CMASK(P0,P1,t) do{int jb_=(t)-(NT-4); if(jb_>=0)cmask(P0,P1,jb_,qrel,hi);}while(0)
  bool resc=false;
  #define START(P0,P1) do{ const float rm=rowmax(P0,P1); resc=false; mhat=rm; \
    _Pragma("unroll") for(int r=0;r<16;++r)P0[r]=__builtin_amdgcn_exp2f(P0[r]-mhat); }while(0)
  #define RESC() do{ if(resc){ asm volatile("s_waitcnt lgkmcnt(0)":::"memory"); \
      _Pragma("unroll") for(int d_=0;d_<2;++d_) _Pragma("unroll") for(int r=0;r<16;++r)o[d_][r]*=wsf[crow(r,hi)]; } }while(0)
  f32x16 pA0,pA1,pB0,pB1;
  int sl_prev=0,sl_cur=0,sl_next=SLOTB;
  #define ROT() do{sl_prev=sl_cur;sl_cur=sl_next;sl_next=(sl_next==(NSLOT-1)*SLOTB)?0:sl_next+SLOTB;}while(0)
  DMA_K(2,2*SLOTB);
  WAIT_BAR(3);
  LDBIAS(pA0,pA1,0); qkt(pA0,pA1,Kbase,qr,r32,hi);asm volatile("s_nop 15\n\ts_nop 7":"+v"(pA0),"+v"(pA1));CMASK(pA0,pA1,0);
  START(pA0,pA1);
  _Pragma("unroll") for(int r=0;r<16;++r)pA1[r]=__builtin_amdgcn_exp2f(pA1[r]-mhat);
  WAIT_BAR(0);
  DMA_K(3,0);DMA_V(1,SLOTB);
  ROT();
  kload8(kf,kp0+sl_cur);
  WAIT_BAR(2);
  s16x4 vlo[8],vhi[8]; u32x4 pw0,pw1,pw2,pw3;
  #define PKW(P,B) cvtpk_s(P[B],P[B+1])
  #define PAF(k) __builtin_bit_cast(bf16x8,pw##k)
  #define VFR(i) (bf16x8){vlo[i][0],vlo[i][1],vlo[i][2],vlo[i][3],vhi[i][0],vhi[i][1],vhi[i][2],vhi[i][3]}
  #define PIN(x) asm volatile("":"+v"(x))
  #define MX3(a,b,c) __builtin_fmaxf(__builtin_fmaxf((a),(b)),(c))
  #define GAPA(MF,A0,A1,A2,A3,W0,W1,PW) do{ MF; sacc+=A0; sacc+=A1; sacc+=A2; sacc+=A3; PIN(sacc); W0; W1; PIN(PW); SBAR(); }while(0)
  #define EX(v) __builtin_amdgcn_exp2f((v)-mhat)
  #define GAPB(MF,X,B) do{ MF; X[B]=EX(X[B]); X[B+1]=EX(X[B+1]); X[B+2]=EX(X[B+2]); X[B+3]=EX(X[B+3]); PIN(X); SBAR(); }while(0)
  #define VRD(i) do{ vlo[i]=vtr(vp_+(((i)>>2)*4096+((i)&3)*1024)); vhi[i]=vtr(vp_+(((i)>>2)*4096+((i)&3)*1024+512)); }while(0)
  #define KRD(G,j) do{ if(G){ kload2(kf,kp0+sl_next,j); SBAR(); } }while(0)
  #define STEP(C0,C1,P0,P1,t,GK,GV,GL) do{ SBAR(); LDBIAS(C0,C1,t); \
    const lds_cptr vp_=vp0+sl_prev; \
    VRD(0); SBAR(); float sacc=(P0[0]+P0[1]); \
    GAPA(C0=__builtin_amdgcn_mfma_f32_32x32x16_bf16(kf[0],qr[0],C0,0,0,0), P0[2],P0[3],P0[4],P0[5],     pw0[0]=PKW(P0,0), pw0[1]=PKW(P0,2), pw0); \
    VRD(4); SBAR(); GAPA(C1=__builtin_amdgcn_mfma_f32_32x32x16_bf16(kf[1],qr[0],C1,0,0,0), P0[6],P0[7],P0[8],P0[9],     pw0[2]=PKW(P0,4), pw0[3]=PKW(P0,6), pw0); \
    VRD(1); SBAR(); GAPA(C0=__builtin_amdgcn_mfma_f32_32x32x16_bf16(kf[2],qr[1],C0,0,0,0),   P0[10],P0[11],P0[12],P0[13], pw1[0]=PKW(P0,8), pw1[1]=PKW(P0,10), pw1); \
    VRD(5); SBAR(); GAPA(C1=__builtin_amdgcn_mfma_f32_32x32x16_bf16(kf[3],qr[1],C1,0,0,0),   P0[14],P0[15],P1[0],P1[1],   pw1[2]=PKW(P0,12),pw1[3]=PKW(P0,14), pw1); \
    VRD(2); SBAR(); GAPA(C0=__builtin_amdgcn_mfma_f32_32x32x16_bf16(kf[4],qr[2],C0,0,0,0),   P1[2],P1[3],P1[4],P1[5],     pw2[0]=PKW(P1,0), pw2[1]=PKW(P1,2), pw2); \
    VRD(6); SBAR(); GAPA(C1=__builtin_amdgcn_mfma_f32_32x32x16_bf16(kf[5],qr[2],C1,0,0,0),   P1[6],P1[7],P1[8],P1[9],     pw2[2]=PKW(P1,4), pw2[3]=PKW(P1,6), pw2); \
    VRD(3); SBAR(); GAPA(C0=__builtin_amdgcn_mfma_f32_32x32x16_bf16(kf[6],qr[3],C0,0,0,0),   P1[10],P1[11],P1[12],P1[13], pw3[0]=PKW(P1,8), pw3[1]=PKW(P1,10), pw3); \
    VRD(7); SBAR(); GAPA(C1=__builtin_amdgcn_mfma_f32_32x32x16_bf16(kf[7],qr[3],C1,0,0,0),   P1[14],P1[15],0.f,0.f,       pw3[2]=PKW(P1,12),pw3[3]=PKW(P1,14), pw3); \
    l_reg+=sacc; \
    if(GK){DMA_K((t)+3,sl_cur);} if(GV){DMA_V((t)+1,sl_next);} \
    CMASK(C0,C1,t); \
    { float a=MX3(C0[0],C0[1],C1[0]),b=MX3(C0[2],C0[3],C1[1]); a=MX3(a,C1[2],C1[3]); \
      _Pragma("unroll") for(int r=4;r<16;r+=4){a=MX3(a,C0[r],C0[r+1]);b=MX3(b,C0[r+2],C0[r+3]);a=MX3(a,C1[r],C1[r+1]);b=MX3(b,C1[r+2],C1[r+3]);} \
      float rm=__builtin_fmaxf(a,b); { auto rr=__builtin_amdgcn_permlane32_swap(__float_as_uint(rm),__float_as_uint(rm),false,false); rm=__builtin_fmaxf(__uint_as_float(rr[0]),__uint_as_float(rr[1])); } \
      resc=false; rm-=mhat; \
      if(__builtin_expect(__any(rm>(float)THRL),0)){ const float dl=__builtin_fmaxf(rm,0.f); mhat+=dl; \
        const float f=__builtin_amdgcn_exp2f(-dl); l_reg*=f; if(hi==0)wsf[r32]=f; resc=true; } } \
    SBAR(); \
    GAPB(o[0]=__builtin_amdgcn_mfma_f32_32x32x16_bf16(PAF(0),VFR(0),o[0],0,0,0), C0,0); \
    GAPB(o[1]=__builtin_amdgcn_mfma_f32_32x32x16_bf16(PAF(0),VFR(4),o[1],0,0,0), C0,4); \
    KRD(GL,0); GAPB(o[0]=__builtin_amdgcn_mfma_f32_32x32x16_bf16(PAF(1),VFR(1),o[0],0,0,0), C0,8); \
    KRD(GL,1); GAPB(o[1]=__builtin_amdgcn_mfma_f32_32x32x16_bf16(PAF(1),VFR(5),o[1],0,0,0), C0,12); \
    KRD(GL,2); GAPB(o[0]=__builtin_amdgcn_mfma_f32_32x32x16_bf16(PAF(2),VFR(2),o[0],0,0,0), C1,0); \
    KRD(GL,3); GAPB(o[1]=__builtin_amdgcn_mfma_f32_32x32x16_bf16(PAF(2),VFR(6),o[1],0,0,0), C1,4); \
    GAPB(o[0]=__builtin_amdgcn_mfma_f32_32x32x16_bf16(PAF(3),VFR(3),o[0],0,0,0), C1,8); \
    GAPB(o[1]=__builtin_amdgcn_mfma_f32_32x32x16_bf16(PAF(3),VFR(7),o[1],0,0,0), C1,12); \
    }while(0)
  int t=1;
  #undef CMASK
  #define CMASK(P0,P1,t) do{}while(0)
  for(;t+5<NT;t+=2){
    STEP(pB0,pB1,pA0,pA1,t,true,true,true);     WAIT_BAR(2); RESC(); ROT();
    STEP(pA0,pA1,pB0,pB1,t+1,true,true,true);   WAIT_BAR(2); RESC(); ROT();
  }
  #undef CMASK
  #define CMASK(P0,P1,t) do{int jb_=(t)-(NT-4); if(jb_>=0)cmask(P0,P1,jb_,qrel,hi);}while(0)
  #define ENDW(tt) do{ if((tt)+3<NT){WAIT_BAR(2);} else if((tt)+2<NT){WAIT_BAR(1);} else {WAIT_BAR(0);} }while(0)
  for(;t+1<NT;t+=2){
    STEP(pB0,pB1,pA0,pA1,t,(t+3<NT),(t+1<NT),(t+1<NT));       ENDW(t);   RESC(); ROT();
    STEP(pA0,pA1,pB0,pB1,t+1,(t+4<NT),(t+2<NT),(t+2<NT));     ENDW(t+1); RESC(); ROT();
  }
  STEP(pB0,pB1,pA0,pA1,NT-1,false,false,false); RESC();
  { float sacc=pB0[0]+pB0[1]; _Pragma("unroll") for(int r=2;r<16;++r)sacc+=pB0[r]; _Pragma("unroll") for(int r=0;r<16;++r)sacc+=pB1[r]; l_reg+=sacc;
    pw0=(u32x4){PKW(pB0,0),PKW(pB0,2),PKW(pB0,4),PKW(pB0,6)};pw1=(u32x4){PKW(pB0,8),PKW(pB0,10),PKW(pB0,12),PKW(pB0,14)};pw2=(u32x4){PKW(pB1,0),PKW(pB1,2),PKW(pB1,4),PKW(pB1,6)};pw3=(u32x4){PKW(pB1,8),PKW(pB1,10),PKW(pB1,12),PKW(pB1,14)};
    SBAR(); pv(o,vb0+sl_cur,PAF(0),PAF(1),PAF(2),PAF(3)); }
  #undef PKW
  #undef PAF
  #undef VFR
  #undef PIN
  #undef MX3
  #undef GAPA
  #undef GAPB
  #undef EX
  #undef VRD
  #undef KRD
  #undef STEP
  #undef ENDW
  {auto rr=__builtin_amdgcn_permlane32_swap(__float_as_uint(l_reg),__float_as_uint(l_reg),false,false);l_reg=__uint_as_float(rr[0])+__uint_as_float(rr[1]);}
  if(hi==0)wsf[32+r32]=l_reg;asm volatile("s_waitcnt lgkmcnt(0)":::"memory");
  float rli[16];
  #pragma unroll
  for(int r=0;r<16;++r)rli[r]=__builtin_amdgcn_rcpf(wsf[32+crow(r,hi)]);
  bf16*Ow=O+(rowbase+q0+wid*QBLK)*DM+h*D;
  { bf16*stg=(bf16*)(shm+LDS_OST)+wid*2048;
    #pragma unroll
    for(int r=0;r<16;++r){const int orow=crow(r,hi);
      #pragma unroll
      for(int d0=0;d0<2;++d0)stg[orow*64+d0*32+r32]=__float2bfloat16(o[d0][r]*rli[r]);}
    asm volatile("s_waitcnt lgkmcnt(0)":::"memory");
    #pragma unroll
    for(int i=0;i<4;++i){const int row=i*8+(lane>>3),ch=lane&7; const u32x4 v=*(const u32x4*)(stg+row*64+ch*8); ATTN_STORE16(Ow+(long)row*DM+ch*8,v);} }
  asm volatile("s_waitcnt lgkmcnt(0)\n\ts_barrier":::"memory");
  #undef DMA_K
  #undef DMA_V
  #undef CMASK
  #undef START
  #undef RESC
  #undef ROT
  #undef LDBIAS
}
constexpr int ATTN_LDS_BYTES=LDS_BYTES;
#undef SBAR
#undef WAIT_BAR
}

#define GAS __attribute__((address_space(1)))
#define LAS __attribute__((address_space(3)))
typedef unsigned short bf16;
typedef unsigned v4u __attribute__((ext_vector_type(4)));
typedef float f32x4 __attribute__((ext_vector_type(4)));
typedef short bf16x8 __attribute__((ext_vector_type(8)));
typedef GAS unsigned gu32;
typedef GAS unsigned long long gu64;
#define RLX_AGENT __ATOMIC_RELAXED, __HIP_MEMORY_SCOPE_AGENT
#define LDS_WAIT() asm volatile("s_waitcnt lgkmcnt(0)" ::: "memory")
#define VM_WAIT() asm volatile("s_waitcnt vmcnt(0)" ::: "memory")
__device__ __forceinline__ unsigned long long rt() { return __builtin_amdgcn_s_memrealtime(); }
__device__ __forceinline__ unsigned f2bf(float f) { unsigned u = __builtin_bit_cast(unsigned, f); return (u + 0x7fffu + ((u >> 16) & 1u)) >> 16; }
__device__ __forceinline__ unsigned pk2(float lo, float hi) { return f2bf(lo) | (f2bf(hi) << 16); }

#define XB_TMO      128
#define XB_XCNT(j)  (256  + 64 * (j))
#define XB_XSUB(j)  (1280 + 64 * (j))
#define XB_XGEN(j)  (2304 + 64 * (j))
#define XB_TOP      3328
#define XB_TOPGEN   3392
#define XCD_BAR_WORDS 3456
#define XB_SPIN_CAP (1u << 18)

__device__ __forceinline__ unsigned xb_ld(unsigned* p)              { return __hip_atomic_load(p, __ATOMIC_RELAXED, __HIP_MEMORY_SCOPE_AGENT); }
__device__ __forceinline__ unsigned xb_add(unsigned* p, unsigned v) { return __hip_atomic_fetch_add(p, v, __ATOMIC_RELAXED, __HIP_MEMORY_SCOPE_AGENT); }
__device__ __forceinline__ unsigned xb_xcc_id() { return (unsigned)__builtin_amdgcn_s_getreg((3 << 11) | 20) & 0xFu; }
#define XB_SPIN(cond, bar) do { unsigned _sp = 0; while (cond) { __builtin_amdgcn_s_sleep(1); \
    if ((++_sp & 255u) == 0u) { if (xb_ld(&(bar)[XB_TMO])) break; if (_sp > XB_SPIN_CAP) { atomicAdd(&(bar)[XB_TMO], 1u); break; } } } } while (0)

struct XcdBarrier {
    unsigned* bar; unsigned x;
    volatile LAS unsigned* st;
};

__device__ __forceinline__ XcdBarrier xcd_barrier_post(unsigned* bar, volatile LAS unsigned* st) {
    XcdBarrier b; b.bar = bar; b.x = xb_xcc_id(); b.st = st;
    if (threadIdx.x == 0) (void)xb_add(&bar[XB_XCNT(b.x)], 1u);
    return b;
}
__device__ __forceinline__ void xcd_barrier_complete(unsigned* bar, unsigned x, unsigned& nloc, unsigned& nx) {
    const unsigned G = gridDim.x * gridDim.y * gridDim.z;
    unsigned sum, cnt, mine, sp = 0u;
    for (;;) {
        sum = 0u; cnt = 0u; mine = 0u;
#pragma unroll
        for (unsigned j = 0; j < 16; ++j) { const unsigned c = xb_ld(&bar[XB_XCNT(j)]); sum += c; cnt += (c > 0u) ? 1u : 0u; mine = (j == x) ? c : mine; }
        if (sum == G) break;
        __builtin_amdgcn_s_sleep(1);
        if ((++sp & 255u) == 0u) { if (xb_ld(&bar[XB_TMO])) break; if (sp > XB_SPIN_CAP) { atomicAdd(&bar[XB_TMO], 1u); break; } }
    }
    nloc = mine > 0u ? mine : 1u; nx = cnt > 0u ? cnt : 1u;
}

__device__ __forceinline__ void xcd_barrier(const XcdBarrier& b) {
    asm volatile("s_waitcnt vmcnt(0)" ::: "memory");
    __syncthreads();
    int tb_ = threadIdx.x; asm volatile("" : "+v"(tb_));
    if (tb_ == 0) {
        unsigned* bar = b.bar;
        __builtin_amdgcn_s_waitcnt(0);
        unsigned nloc = b.st[0], nx = b.st[1];
        if (nloc == 0u) { xcd_barrier_complete(bar, b.x, nloc, nx); b.st[0] = nloc; b.st[1] = nx; }
        const unsigned old = xb_add(&bar[XB_XSUB(b.x)], 1u);
        const unsigned gen = old / nloc;
        if (old + 1u == (gen + 1u) * nloc) {
            __builtin_amdgcn_fence(__ATOMIC_RELEASE, "agent");
            asm volatile("s_waitcnt vmcnt(0)" ::: "memory");
            const unsigned og = xb_add(&bar[XB_TOP], 1u);
            const unsigned tg = og / nx;
            if (og + 1u == (tg + 1u) * nx) xb_add(&bar[XB_TOPGEN], 1u);
            else XB_SPIN(xb_ld(&bar[XB_TOPGEN]) == tg, bar);
            __builtin_amdgcn_fence(__ATOMIC_ACQUIRE, "agent");
            xb_add(&bar[XB_XGEN(b.x)], 1u);
            asm volatile("s_waitcnt vmcnt(0)" ::: "memory");
        } else {
            XB_SPIN(xb_ld(&bar[XB_XGEN(b.x)]) == gen, bar);
            __builtin_amdgcn_fence(__ATOMIC_ACQUIRE, "agent");
            asm volatile("s_waitcnt vmcnt(0)" ::: "memory");
        }
    }
    __syncthreads();
}

constexpr int NWAVES = 8, NCU = 256;
constexpr int BATCH = 8, SEQ = 2048, D = 1024, TOK = BATCH * SEQ, DEPTH = 2, MEMLEN = 256, FF = 4096;
constexpr int N_IN = 5384, OFF_F = 1792, OFF_C = 1800, OFF_G = 2312;
constexpr float EPSF = 1e-6f, LOG2E = 1.4426950408889634f;
constexpr size_t MiB = 1u << 20;
constexpr size_t WS_CTL = 0, CTL_ZERO_BYTES = 1 * MiB;
constexpr size_t WS_SS = 1 * MiB;
constexpr size_t WS_LOGF = 2 * MiB;
constexpr size_t WS_W = 3 * MiB;
constexpr size_t OW_IN = 0, OW_G = OW_IN + (size_t)2304 * 1024 * 2, OW_A = OW_G + (size_t)3072 * 1024 * 2, OW_B = OW_A + (size_t)1024 * 256 * 2, OW_C = OW_B + (size_t)1024 * 512 * 2,
                 OW_OUT = OW_C + (size_t)1024 * 256 * 2, OW_XQ = OW_OUT + (size_t)1024 * 1024 * 2, OW_XKV = OW_XQ + (size_t)1024 * 1024 * 2, OW_XO = OW_XKV + (size_t)2048 * 1024 * 2,
                 OW_FF1 = OW_XO + (size_t)1024 * 1024 * 2, OW_FF2 = OW_FF1 + (size_t)4096 * 1024 * 2, LW = OW_FF2 + (size_t)1024 * 4096 * 2;
static_assert(LW == 40370176 && WS_W + 2 * LW <= 80 * MiB, "weight map");
constexpr size_t WS_XKV1 = 80 * MiB;
constexpr size_t WS_XB = 88 * MiB;
constexpr size_t WS_DYN = 120 * MiB;
constexpr size_t WS_Q = WS_DYN, WS_K = WS_DYN + 16 * MiB, WS_V = WS_DYN + 32 * MiB, WS_PA = WS_DYN + 48 * MiB, WS_DD = WS_DYN + 56 * MiB, WS_ZC = WS_DYN + 64 * MiB,
                 WS_SG = WS_DYN + 80 * MiB, WS_T2 = WS_DYN + 88 * MiB, WS_HM = WS_DYN + 120 * MiB, WS_XKV0 = WS_DYN + 128 * MiB;
constexpr size_t WS_MG = WS_DYN + 16 * MiB;
constexpr size_t WS_XQH = WS_DYN, WS_PP = WS_DYN + 32 * MiB, WS_XO = WS_DYN + 64 * MiB;
constexpr size_t WS_FFH = WS_DYN;
constexpr size_t WS_END = 256 * MiB;
static_assert(WS_XKV0 + 8 * MiB <= WS_END, "d_ws map");
constexpr int CW_TMO = 0, CW_CODE = 1, CW_BAR = 4096;
constexpr int RING_OFF = 0, RING_BYTES = 131072, LDSCTL_OFF = RING_BYTES, MISC_OFF = LDSCTL_OFF + 320, LDS_BYTES = 147456;

template <int CTRL> __device__ __forceinline__ float dppf(float v) { return __uint_as_float(__builtin_amdgcn_update_dpp(0u, __float_as_uint(v), CTRL, 0xf, 0xf, false)); }
__device__ __forceinline__ float wave_sum(float v) {
    v += dppf<0xB1>(v); v += dppf<0x4E>(v); v += dppf<0x141>(v); v += dppf<0x140>(v);
    v = pg8::comb16<false>(v); v = pg8::comb32<false>(v);
    return v;
}
__device__ __forceinline__ float wave_scan(float v) {
    v += dppf<0x111>(v); v += dppf<0x112>(v); v += dppf<0x114>(v); v += dppf<0x118>(v);
    v += __uint_as_float(__builtin_amdgcn_update_dpp(0u, __float_as_uint(v), 0x142, 0xa, 0xf, false));
    v += __uint_as_float(__builtin_amdgcn_update_dpp(0u, __float_as_uint(v), 0x143, 0xc, 0xf, false));
    return v;
}

struct Frame {
    LAS unsigned char* lds;
    volatile LAS unsigned* MISC;
    gu32* ctl;
    int tid, lane, wave, vcu, G;
    float* out; unsigned char* ws;
};
constexpr int PTRS_OFF = LDSCTL_OFF + 512;
__device__ __forceinline__ const float* inp(const Frame& F, int i) {
    const unsigned long long v = *(volatile LAS unsigned long long*)(F.lds + PTRS_OFF + 8 * i);
    const unsigned lo = __builtin_amdgcn_readfirstlane((unsigned)v), hi = __builtin_amdgcn_readfirstlane((unsigned)(v >> 32));
    return (const float*)(const GAS float*)(((unsigned long long)hi << 32) | lo); }
__device__ __forceinline__ bf16* wsb(const Frame& F, size_t off) { return (bf16*)(F.ws + off); }
__device__ __forceinline__ bf16* wlay(const Frame& F, int l, size_t off) { return (bf16*)(F.ws + WS_W + (size_t)l * LW + off); }

__device__ __forceinline__ void tr_item(const float* W, int ldw, int K, int scol0, bf16* WT, int drow0, const float* gain, LAS float* scr, int kb, int nb, int lane) {
    const int k0 = 64 * kb, n0 = 32 * nb;
    float vv[32];
#pragma unroll
    for (int i = 0; i < 32; ++i) vv[i] = W[(size_t)(k0 + 2 * i + (lane >> 5)) * ldw + scol0 + n0 + (lane & 31)];
    if (gain) {
#pragma unroll
        for (int i = 0; i < 32; ++i) vv[i] *= gain[k0 + 2 * i + (lane >> 5)];
    }
#pragma unroll
    for (int i = 0; i < 32; ++i) scr[(2 * i + (lane >> 5)) * 33 + (lane & 31)] = vv[i];
    LDS_WAIT(); asm volatile("" ::: "memory");
    const int c = lane & 7;
#pragma unroll
    for (int j = 0; j < 4; ++j) { const int n = (lane >> 3) + 8 * j; const LAS float* s = scr + (8 * c) * 33 + n;
        v4u o; o.x = pk2(s[0 * 33], s[1 * 33]); o.y = pk2(s[2 * 33], s[3 * 33]); o.z = pk2(s[4 * 33], s[5 * 33]); o.w = pk2(s[6 * 33], s[7 * 33]);
        *(GAS v4u*)(WT + (size_t)(drow0 + n0 + n) * K + k0 + 8 * c) = o; }
    LDS_WAIT(); asm volatile("" ::: "memory");
}
constexpr int I_IN1 = 16 * 56, I_IN2 = 16 * 16, I_G = 16 * 96, I_B = 8 * 32, I_C = 4 * 32, I_OUT = 16 * 32, I_XQ = 16 * 32, I_XKV = 16 * 64, I_XO = 16 * 32, I_FF1 = 16 * 128, I_FF2 = 64 * 32;
constexpr int I_LAYER = I_IN1 + I_IN2 + I_G + I_B + I_C + I_OUT + I_XQ + I_XKV + I_XO + I_FF1 + I_FF2;

__device__ __forceinline__ void p0_prologue(Frame& F) {
    LAS float* scr = (LAS float*)(F.lds + RING_OFF + F.wave * 16384);
    const int gw = F.vcu * NWAVES + F.wave, NGW = F.G * NWAVES, lane = F.lane;
    for (int it = gw; it < DEPTH * I_LAYER; it += NGW) {
        const int l = it / I_LAYER; int r = it % I_LAYER;
        const float* w_in = inp(F, 3) + (size_t)l * D * N_IN;
        if (r < I_IN1) { tr_item(w_in, N_IN, D, 0, wlay(F, l, OW_IN), 0, inp(F, 2) + l * D, scr, r / 56, r % 56, lane); continue; } r -= I_IN1;
        if (r < I_IN2) { tr_item(w_in, N_IN, D, OFF_C, wlay(F, l, OW_IN), 1792, inp(F, 2) + l * D, scr, r / 16, r % 16, lane); continue; } r -= I_IN2;
        if (r < I_G) { tr_item(w_in, N_IN, D, OFF_G, wlay(F, l, OW_G), 0, inp(F, 2) + l * D, scr, r / 96, r % 96, lane); continue; } r -= I_G;
        if (r < I_B) { tr_item(inp(F, 11) + (size_t)l * 512 * D, D, 512, 0, wlay(F, l, OW_B), 0, nullptr, scr, r / 32, r % 32, lane); continue; } r -= I_B;
        if (r < I_C) { tr_item(inp(F, 12) + (size_t)l * 256 * D, D, 256, 0, wlay(F, l, OW_C), 0, nullptr, scr, r / 32, r % 32, lane); continue; } r -= I_C;
        if (r < I_OUT) { tr_item(inp(F, 14) + (size_t)l * D * D, D, D, 0, wlay(F, l, OW_OUT), 0, nullptr, scr, r / 32, r % 32, lane); continue; } r -= I_OUT;
        if (r < I_XQ) { tr_item(inp(F, 17) + (size_t)l * D * D, D, D, 0, wlay(F, l, OW_XQ), 0, inp(F, 15) + l * D, scr, r / 32, r % 32, lane); continue; } r -= I_XQ;
        if (r < I_XKV) { tr_item(inp(F, 18) + (size_t)l * D * 2 * D, 2 * D, D, 0, wlay(F, l, OW_XKV), 0, nullptr, scr, r / 64, r % 64, lane); continue; } r -= I_XKV;
        if (r < I_XO) { tr_item(inp(F, 19) + (size_t)l * D * D, D, D, 0, wlay(F, l, OW_XO), 0, nullptr, scr, r / 32, r % 32, lane); continue; } r -= I_XO;
        if (r < I_FF1) { tr_item(inp(F, 21) + (size_t)l * D * FF, FF, D, 0, wlay(F, l, OW_FF1), 0, inp(F, 20) + l * D, scr, r / 128, r % 128, lane); continue; } r -= I_FF1;
        tr_item(inp(F, 22) + (size_t)l * FF * D, D, FF, 0, wlay(F, l, OW_FF2), 0, nullptr, scr, r / 32, r % 32, lane);
    }
    for (int it = gw; it < DEPTH * 256 * 16; it += NGW) {
        const int l = it / 4096, r = it % 4096, cp = r / 16, n = (r % 16) * 64 + lane, g = cp >> 6;
        const float* pw = inp(F, 5) + ((size_t)l * 256 + cp) * 64; const float* ps = inp(F, 6) + l * 256 + g * 64; const float* wa = inp(F, 10) + ((size_t)l * 256 + g * 64) * D + n;
        float a = 0.f;
#pragma unroll 8
        for (int d = 0; d < 64; ++d) a += pw[d] * ps[d] * wa[(size_t)d * D];
        wlay(F, l, OW_A)[(size_t)n * 256 + cp] = (bf16)f2bf(a);
    }
    for (int it = gw; it < DEPTH * BATCH * MEMLEN; it += NGW) {
        const int l = it / (BATCH * MEMLEN), m = it % (BATCH * MEMLEN);
        const GAS f32x4* xr = (const GAS f32x4*)(inp(F, 1) + (size_t)m * D) + lane; const GAS f32x4* gr = (const GAS f32x4*)(inp(F, 16) + l * D) + lane;
        f32x4 v[4]; float s = 0.f;
#pragma unroll
        for (int j = 0; j < 4; ++j) { v[j] = xr[64 * j]; s += (v[j].x * v[j].x + v[j].y * v[j].y) + (v[j].z * v[j].z + v[j].w * v[j].w); }
        const float rstd = 1.0f / sqrtf(wave_sum(s) * (1.f / D) + EPSF);
        GAS unsigned long long* o8 = (GAS unsigned long long*)(wsb(F, WS_HM) + ((size_t)l * BATCH * MEMLEN + m) * D) + lane;
#pragma unroll
        for (int j = 0; j < 4; ++j) { const f32x4 g = gr[64 * j]; o8[64 * j] = (unsigned long long)pk2(v[j].x * rstd * g.x, v[j].y * rstd * g.y) | ((unsigned long long)pk2(v[j].z * rstd * g.z, v[j].w * rstd * g.w) << 32); }
    }
    for (int m = gw; m < TOK; m += NGW) {
        const GAS f32x4* xr = (const GAS f32x4*)(inp(F, 0) + (size_t)m * D) + lane;
        f32x4 v[4]; float s = 0.f;
#pragma unroll
        for (int j = 0; j < 4; ++j) { v[j] = xr[64 * j]; s += (v[j].x * v[j].x + v[j].y * v[j].y) + (v[j].z * v[j].z + v[j].w * v[j].w); }
        s = wave_sum(s);
        GAS unsigned long long* o8 = (GAS unsigned long long*)(wsb(F, WS_XB) + (size_t)m * D) + lane;
#pragma unroll
        for (int j = 0; j < 4; ++j) o8[64 * j] = (unsigned long long)pk2(v[j].x, v[j].y) | ((unsigned long long)pk2(v[j].z, v[j].w) << 32);
        if (lane < 16) ((float*)(F.ws + WS_SS))[(size_t)m * 16 + lane] = lane == 0 ? s : 0.f;
    }
}

__device__ __forceinline__ float row_rstd(const Frame& F, int row) {
    const f32x4* p = (const f32x4*)((const float*)(F.ws + WS_SS) + (size_t)row * 16);
    const f32x4 a = p[0], b = p[1], c = p[2], d = p[3];
    const float s = ((a[0] + a[1]) + (a[2] + a[3])) + ((b[0] + b[1]) + (b[2] + b[3])) + ((c[0] + c[1]) + (c[2] + c[3])) + ((d[0] + d[1]) + (d[2] + d[3]));
    return 1.0f / sqrtf(s * (1.f / D) + EPSF);
}

__device__ __forceinline__ void logf_pass(Frame& F, int l) {
    const int gw = F.vcu * NWAVES + F.wave, NGW = F.G * NWAVES, lane = F.lane;
    LAS float* WF = (LAS float*)(F.lds + RING_OFF);
    {
        const float* w_in = inp(F, 3) + (size_t)l * D * N_IN; const float* g = inp(F, 2) + l * D;
#pragma unroll
        for (int i = 0; i < 2; ++i) { const int k = F.tid + 512 * i; const float gk = g[k]; const float* p = w_in + (size_t)k * N_IN + OFF_F;
            const f32x4 a = *(const f32x4*)p * gk, b = *(const f32x4*)(p + 4) * gk;
            LAS f32x4* dst = (LAS f32x4*)(WF + (k >> 4) * 132 + (k & 15) * 8); dst[0] = a; dst[1] = b; }
    }
    LDS_WAIT(); __syncthreads();
    const float bfl = (lane < 8) ? (inp(F, 4) + l * 8)[lane] : 0.f;
    float* LOGF = (float*)(F.ws + WS_LOGF);
    const LAS f32x4* wl = (const LAS f32x4*)(WF + lane * 132);
    for (int m = gw; m < TOK; m += NGW) {
        const v4u* xp = (const v4u*)(wsb(F, WS_XB) + (size_t)m * D + 16 * lane);
        const v4u x0 = xp[0], x1 = xp[1];
        float xv[16];
        xv[0] = __uint_as_float(x0.x << 16); xv[1] = __uint_as_float(x0.x & 0xffff0000u); xv[2] = __uint_as_float(x0.y << 16); xv[3] = __uint_as_float(x0.y & 0xffff0000u);
        xv[4] = __uint_as_float(x0.z << 16); xv[5] = __uint_as_float(x0.z & 0xffff0000u); xv[6] = __uint_as_float(x0.w << 16); xv[7] = __uint_as_float(x0.w & 0xffff0000u);
        xv[8] = __uint_as_float(x1.x << 16); xv[9] = __uint_as_float(x1.x & 0xffff0000u); xv[10] = __uint_as_float(x1.y << 16); xv[11] = __uint_as_float(x1.y & 0xffff0000u);
        xv[12] = __uint_as_float(x1.z << 16); xv[13] = __uint_as_float(x1.z & 0xffff0000u); xv[14] = __uint_as_float(x1.w << 16); xv[15] = __uint_as_float(x1.w & 0xffff0000u);
        f32x4 a0 = (f32x4){0.f, 0.f, 0.f, 0.f}, a1 = a0;
#pragma unroll
        for (int j = 0; j < 16; ++j) { a0 += wl[2 * j] * xv[j]; a1 += wl[2 * j + 1] * xv[j]; }
        float d[8] = {a0[0], a0[1], a0[2], a0[3], a1[0], a1[1], a1[2], a1[3]};
#pragma unroll
        for (int h = 0; h < 8; ++h) d[h] = wave_sum(d[h]);
        const float rstd = row_rstd(F, m);
        if (lane < 8) {
            float dv = d[0];
#pragma unroll
            for (int h = 1; h < 8; ++h) dv = (lane == h) ? d[h] : dv;
            const float z = dv * rstd + bfl;
            const float ls = fminf(z, 0.f) - 0.6931471805599453f * __builtin_amdgcn_logf(1.0f + __builtin_amdgcn_exp2f(-LOG2E * fabsf(z)));
            LOGF[((size_t)(m / SEQ) * 8 + lane) * SEQ + (m % SEQ)] = ls;
        }
    }
    LDS_WAIT(); __syncthreads();
}

__device__ __forceinline__ void cumsum_bias(Frame& F, int bh, LAS float* nb, LAS float* scr) {
    const f32x4 v = *((const f32x4*)((const float*)(F.ws + WS_LOGF) + (size_t)bh * SEQ) + F.tid);
    const float p0 = v[0], p1 = p0 + v[1], p2 = p1 + v[2], p3 = p2 + v[3];
    const float incl = wave_scan(p3);
    if (F.lane == 63) scr[F.wave] = incl;
    LDS_WAIT(); __syncthreads();
    float woff = 0.f;
#pragma unroll
    for (int w = 0; w < 8; ++w) woff += (w < F.wave) ? scr[w] : 0.f;
    const float base = woff + (incl - p3);
    *((LAS f32x4*)nb + F.tid) = (f32x4){-(base + p0) * LOG2E, -(base + p1) * LOG2E, -(base + p2) * LOG2E, -(base + p3) * LOG2E};
    LDS_WAIT(); __syncthreads();
}

__device__ __forceinline__ void pool_diff(Frame& F) {
    const bf16* PA = wsb(F, WS_PA); bf16* DD = wsb(F, WS_DD);
    const int ch = F.tid & 31, seg = F.tid >> 5, g = ch >> 3, win = 2 << g, r0 = 64 * F.vcu + 4 * seg, tl0 = r0 & (SEQ - 1);
    v4u a[19];
#pragma unroll
    for (int i = 0; i < 19; ++i) { const int dt = i - 15;
        a[i] = (tl0 + dt >= 0) ? *(const v4u*)(PA + (size_t)(r0 + dt) * 256 + 8 * ch) : (v4u){0u, 0u, 0u, 0u}; }
    float s[8] = {0.f, 0.f, 0.f, 0.f, 0.f, 0.f, 0.f, 0.f};
#define PD_ACC(W, SG) do { s[0] += SG __uint_as_float((W).x << 16); s[1] += SG __uint_as_float((W).x & 0xffff0000u); s[2] += SG __uint_as_float((W).y << 16); s[3] += SG __uint_as_float((W).y & 0xffff0000u); \
        s[4] += SG __uint_as_float((W).z << 16); s[5] += SG __uint_as_float((W).z & 0xffff0000u); s[6] += SG __uint_as_float((W).w << 16); s[7] += SG __uint_as_float((W).w & 0xffff0000u); } while (0)
#pragma unroll
    for (int k = 0; k < 16; ++k) if (k < win) PD_ACC(a[15 - k], +);
#pragma unroll
    for (int o = 0; o < 4; ++o) {
        if (o > 0) { PD_ACC(a[15 + o], +);
            const v4u old = (g == 0) ? a[13 + o] : (g == 1) ? a[11 + o] : (g == 2) ? a[7 + o] : a[o - 1]; PD_ACC(old, -); }
        const int tl = tl0 + o; const float inv = 1.0f / (float)((tl + 1 < win) ? tl + 1 : win);
        const v4u cur = a[15 + o]; v4u w;
        w.x = pk2(s[0] * inv - __uint_as_float(cur.x << 16), s[1] * inv - __uint_as_float(cur.x & 0xffff0000u));
        w.y = pk2(s[2] * inv - __uint_as_float(cur.y << 16), s[3] * inv - __uint_as_float(cur.y & 0xffff0000u));
        w.z = pk2(s[4] * inv - __uint_as_float(cur.z << 16), s[5] * inv - __uint_as_float(cur.z & 0xffff0000u));
        w.w = pk2(s[6] * inv - __uint_as_float(cur.w << 16), s[7] * inv - __uint_as_float(cur.w & 0xffff0000u));
        *(v4u*)(DD + (size_t)(r0 + o) * 256 + 8 * ch) = w;
    }
#undef PD_ACC
}

__device__ __forceinline__ void sgu_unit(Frame& F, int l, int unit) {
    const int chunk = unit >> 2, g = unit & 3, row0 = chunk * 128, lane = F.lane, w = F.wave;
    const bf16* ZC = wsb(F, WS_ZC); bf16* SG = wsb(F, WS_SG);
    LAS bf16* vnT = (LAS bf16*)(F.lds + RING_OFF);
    const float* gain = inp(F, 7) + l * 256;
    const float g0 = gain[4 * lane], g1 = gain[4 * lane + 1], g2 = gain[4 * lane + 2], g3 = gain[4 * lane + 3];
    unsigned long long qv[16];
#pragma unroll
    for (int i = 0; i < 16; ++i) qv[i] = *(const unsigned long long*)(ZC + (size_t)(row0 + 16 * w + i) * 512 + 256 + 4 * lane);
#pragma unroll
    for (int i = 0; i < 16; ++i) {
        const int s = 16 * w + i;
        const unsigned long long q = qv[i];
        const unsigned lo = (unsigned)q, hi = (unsigned)(q >> 32);
        const float v0 = __uint_as_float(lo << 16), v1 = __uint_as_float(lo & 0xffff0000u), v2 = __uint_as_float(hi << 16), v3 = __uint_as_float(hi & 0xffff0000u);
        const float ss = wave_sum((v0 * v0 + v1 * v1) + (v2 * v2 + v3 * v3));
        const float r = 1.0f / sqrtf(ss * (1.f / 256.f) + EPSF);
        if ((lane >> 4) == g) { const int d = 4 * (lane & 15);
            vnT[(d + 0) * 136 + s] = (bf16)f2bf(v0 * r * g0); vnT[(d + 1) * 136 + s] = (bf16)f2bf(v1 * r * g1); vnT[(d + 2) * 136 + s] = (bf16)f2bf(v2 * r * g2); vnT[(d + 3) * 136 + s] = (bf16)f2bf(v3 * r * g3); }
    }
    LDS_WAIT(); __syncthreads();
    const float* Wg = inp(F, 8) + ((size_t)(l * 4 + g) * 128) * 128;
    const int t = 16 * w + (lane & 15), kq = lane >> 4;
    f32x4 acc[4];
#pragma unroll
    for (int n = 0; n < 4; ++n) acc[n] = (f32x4){0.f, 0.f, 0.f, 0.f};
#pragma unroll
    for (int kk = 0; kk < 4; ++kk) {
        if (32 * kk <= 16 * w + 15) {
            const int s0 = 32 * kk + 8 * kq;
            const f32x4 wa = *(const f32x4*)(Wg + (size_t)t * 128 + s0), wb = *(const f32x4*)(Wg + (size_t)t * 128 + s0 + 4);
            float wv[8] = {wa[0], wa[1], wa[2], wa[3], wb[0], wb[1], wb[2], wb[3]};
#pragma unroll
            for (int j = 0; j < 8; ++j) wv[j] = (s0 + j <= t) ? wv[j] : 0.f;
            v4u bw; bw.x = pk2(wv[0], wv[1]); bw.y = pk2(wv[2], wv[3]); bw.z = pk2(wv[4], wv[5]); bw.w = pk2(wv[6], wv[7]);
            const bf16x8 bfrag = __builtin_bit_cast(bf16x8, bw);
#pragma unroll
            for (int n = 0; n < 4; ++n) { const bf16x8 afrag = *(const LAS bf16x8*)(vnT + (16 * n + (lane & 15)) * 136 + s0);
                acc[n] = __builtin_amdgcn_mfma_f32_16x16x32_bf16(afrag, bfrag, acc[n], 0, 0, 0); }
        }
    }
    const float bt = inp(F, 9)[(l * 4 + g) * 128 + t];
#pragma unroll
    for (int n = 0; n < 4; ++n) { const int d = 64 * g + 16 * n + 4 * kq;
        const unsigned long long q = *(const unsigned long long*)(ZC + (size_t)(row0 + t) * 512 + d);
        const unsigned lo = (unsigned)q, hi = (unsigned)(q >> 32);
        const float o0 = __uint_as_float(lo << 16) * (acc[n][0] + bt), o1 = __uint_as_float(lo & 0xffff0000u) * (acc[n][1] + bt), o2 = __uint_as_float(hi << 16) * (acc[n][2] + bt), o3 = __uint_as_float(hi & 0xffff0000u) * (acc[n][3] + bt);
        *(unsigned long long*)(SG + (size_t)(row0 + t) * 256 + d) = (unsigned long long)pk2(o0, o1) | ((unsigned long long)pk2(o2, o3) << 32); }
    LDS_WAIT(); __syncthreads();
}

__device__ __forceinline__ void final_norm(Frame& F) {
    const int gw = F.vcu * NWAVES + F.wave, NGW = F.G * NWAVES, lane = F.lane;
    const GAS f32x4* gr = (const GAS f32x4*)inp(F, 23) + lane;
    for (int m = gw; m < TOK; m += NGW) {
        const float rstd = row_rstd(F, m);
        GAS f32x4* xr = (GAS f32x4*)(F.out + (size_t)m * D) + lane;
#pragma unroll
        for (int j = 0; j < 4; ++j) { const f32x4 v = xr[64 * j]; xr[64 * j] = v * rstd * gr[64 * j]; }
    }
}

struct Args { const float* in[24]; float* out; unsigned char* ws; };
__global__ void __launch_bounds__(NWAVES * 64, 2) mega_fwd(Args args) {
    extern __shared__ __attribute__((aligned(16))) unsigned char lds[];
    Frame F;
    F.lds = (LAS unsigned char*)lds;
    F.MISC = (volatile LAS unsigned*)(F.lds + MISC_OFF);
    int c = 0;
#define REFRESH() do { int t_ = threadIdx.x, b_ = blockIdx.x; asm volatile("" : "+v"(t_)); asm volatile("" : "+s"(b_)); F.tid = t_; F.lane = t_ & 63; F.wave = __builtin_amdgcn_readfirstlane(t_ >> 6); \
        F.G = NCU; F.vcu = (b_ % 8) * (NCU / 8) + b_ / 8; c = b_; \
        unsigned lb_ = (unsigned)(uintptr_t)(LAS unsigned char*)lds; asm volatile("" : "+s"(lb_)); F.lds = (LAS unsigned char*)(uintptr_t)lb_; F.MISC = (volatile LAS unsigned*)(F.lds + MISC_OFF); } while (0)
    REFRESH();
    F.ws = args.ws; F.out = args.out; F.ctl = (gu32*)(args.ws + WS_CTL);
    for (int u = F.tid; u < (LDS_BYTES - LDSCTL_OFF) / 4; u += NWAVES * 64) ((LAS unsigned*)(F.lds + LDSCTL_OFF))[u] = 0u;
    __syncthreads();
    if (F.tid < 24) *(LAS unsigned long long*)(F.lds + PTRS_OFF + 8 * F.tid) = (unsigned long long)args.in[F.tid];
    LDS_WAIT(); __syncthreads();
    (void)xcd_barrier_post((unsigned*)(F.ctl + CW_BAR), F.MISC + 8);
#define GRID_BAR() do { XcdBarrier b_; b_.bar = (unsigned*)(F.ws + WS_CTL) + CW_BAR; b_.x = xb_xcc_id(); asm volatile("" : "+s"(b_.x)); b_.st = F.MISC + 8; REP(9) xcd_barrier(b_); } while (0)
    float* SS = (float*)(F.ws + WS_SS);

#ifndef PROBE
#define PROBE 0
#endif
#define REP(n) for (int rep_ = 0; rep_ < ((PROBE == (n)) ? 2 : 1); ++rep_)
    REP(1) p0_prologue(F);
    GRID_BAR();
    for (int l = 0; l < DEPTH; ++l) {
        REFRESH();
        REP(2) logf_pass(F, l);
        REP(3)
        { pg8::GemmProj g{wsb(F, WS_XB), wlay(F, l, OW_IN), wsb(F, WS_HM), wlay(F, 0, OW_XKV), LW / 2, D, D, D};
          pg8::StaticOrder S; S.init(TOK, l == 0 ? 11 * 256 : 9 * 256, F.G, c);
          pg8::EpiProj E{wsb(F, WS_PA), wsb(F, WS_Q), wsb(F, WS_K), wsb(F, WS_V), wsb(F, WS_ZC), SS, attn_body::C2, wsb(F, WS_XKV0), wsb(F, WS_XKV1)};
          pg8::gemm_phase<pg8::EpiProj, pg8::StaticOrder, pg8::GemmProj, true, true>(F.lds + RING_OFF, g, S, E); }
        GRID_BAR();
        REFRESH();
        {
            const int bh = F.vcu >> 2, s4 = F.vcu & 3;
            LAS float* nb = (LAS float*)(F.lds + RING_OFF + attn_body::LDS_NB);
            cumsum_bias(F, bh, nb, (LAS float*)(F.lds + RING_OFF + attn_body::LDS_NB + 8192));
#if PROBE == 4
            attn_body::attn_unit<8>(bh >> 3, bh & 7, 7 - s4, (const attn_body::bf16*)wsb(F, WS_Q), (const attn_body::bf16*)wsb(F, WS_K), (const attn_body::bf16*)wsb(F, WS_V), (attn_body::bf16*)wsb(F, WS_T2), (char*)F.lds + RING_OFF);
            attn_body::attn_unit<8>(bh >> 3, bh & 7, s4, (const attn_body::bf16*)wsb(F, WS_Q), (const attn_body::bf16*)wsb(F, WS_K), (const attn_body::bf16*)wsb(F, WS_V), (attn_body::bf16*)wsb(F, WS_T2), (char*)F.lds + RING_OFF);
#endif
            attn_body::attn_unit<8>(bh >> 3, bh & 7, 7 - s4, (const attn_body::bf16*)wsb(F, WS_Q), (const attn_body::bf16*)wsb(F, WS_K), (const attn_body::bf16*)wsb(F, WS_V), (attn_body::bf16*)wsb(F, WS_Q), (char*)F.lds + RING_OFF);
            attn_body::attn_unit<8>(bh >> 3, bh & 7, s4, (const attn_body::bf16*)wsb(F, WS_Q), (const attn_body::bf16*)wsb(F, WS_K), (const attn_body::bf16*)wsb(F, WS_V), (attn_body::bf16*)wsb(F, WS_Q), (char*)F.lds + RING_OFF);
            REP(5) { pool_diff(F); sgu_unit(F, l, 2 * F.vcu); sgu_unit(F, l, 2 * F.vcu + 1); }
        }
        GRID_BAR();
        REFRESH();
        REP(6) {
            pg8::StaticOrder S; S.init(TOK, D, F.G, c);
            const float* bg = inp(F, 13) + (size_t)l * 3 * D;
            { pg8::GemmP g{wsb(F, WS_DD), wlay(F, l, OW_A), 256, 256, 256}; pg8::EpiStore<0, false, false> E{wsb(F, WS_T2), D, nullptr, 1.f};
              pg8::gemm_phase<pg8::EpiStore<0, false, false>, pg8::StaticOrder, pg8::GemmP, true, true>(F.lds + RING_OFF, g, S, E); }
            { pg8::GemmP g{wsb(F, WS_XB), wlay(F, l, OW_G), D, D, D}; pg8::EpiGate<true> E{wsb(F, WS_T2), wsb(F, WS_MG), bg, SS};
              pg8::gemm_phase<pg8::EpiGate<true>, pg8::StaticOrder, pg8::GemmP, true, true>(F.lds + RING_OFF, g, S, E); }
            { pg8::GemmP g{wsb(F, WS_Q), wlay(F, l, OW_B), 512, 512, 512}; pg8::EpiStore<0, false, false> E{wsb(F, WS_T2), D, nullptr, 1.f};
              pg8::gemm_phase<pg8::EpiStore<0, false, false>, pg8::StaticOrder, pg8::GemmP, true, true>(F.lds + RING_OFF, g, S, E); }
            { pg8::GemmP g{wsb(F, WS_XB), wlay(F, l, OW_G) + (size_t)D * D, D, D, D}; pg8::EpiGate<false> E{wsb(F, WS_T2), wsb(F, WS_MG), bg + D, SS};
              pg8::gemm_phase<pg8::EpiGate<false>, pg8::StaticOrder, pg8::GemmP, true, true>(F.lds + RING_OFF, g, S, E); }
            { pg8::GemmP g{wsb(F, WS_SG), wlay(F, l, OW_C), 256, 256, 256}; pg8::EpiStore<0, false, false> E{wsb(F, WS_T2), D, nullptr, 1.f};
              pg8::gemm_phase<pg8::EpiStore<0, false, false>, pg8::StaticOrder, pg8::GemmP, true, true>(F.lds + RING_OFF, g, S, E); }
            { pg8::GemmP g{wsb(F, WS_XB), wlay(F, l, OW_G) + (size_t)2 * D * D, D, D, D}; pg8::EpiGate<false> E{wsb(F, WS_T2), wsb(F, WS_MG), bg + 2 * D, SS};
              pg8::gemm_phase<pg8::EpiGate<false>, pg8::StaticOrder, pg8::GemmP, true, true>(F.lds + RING_OFF, g, S, E); }
        }
        GRID_BAR();
        REFRESH();
        { pg8::GemmP g{wsb(F, WS_MG), wlay(F, l, OW_OUT), D, D, D}; pg8::StaticOrder S; S.init(TOK, D, F.G, c); pg8::EpiRes E{wsb(F, WS_XB), nullptr, SS};
          pg8::gemm_phase<pg8::EpiRes, pg8::StaticOrder, pg8::GemmP, true, true>(F.lds + RING_OFF, g, S, E); }
        GRID_BAR();
        REFRESH();
        REP(7) {
            pg8::StaticOrder S; S.init(TOK, D, F.G, c);
            const bf16* xk = wsb(F, l == 0 ? WS_XKV0 : WS_XKV1); const bf16* xvt = xk + (size_t)BATCH * 4 * 65536;
            { pg8::GemmP g{wsb(F, WS_XB), wlay(F, l, OW_XQ), D, D, D}; pg8::EpiStore<0, true, true> E{wsb(F, WS_XQH), 256, SS, 0.0625f * LOG2E};
              pg8::gemm_phase<pg8::EpiStore<0, true, true>, pg8::StaticOrder, pg8::GemmP, true, true>(F.lds + RING_OFF, g, S, E); }
            { pg8::GemmX g{wsb(F, WS_XQH), xk, 256, 256, 256}; pg8::EpiSoftmax E{wsb(F, WS_PP)};
              pg8::gemm_phase<pg8::EpiSoftmax, pg8::StaticOrder, pg8::GemmX, false, true>(F.lds + RING_OFF, g, S, E); }
            { pg8::GemmX g{wsb(F, WS_PP), xvt, 256, 256, 256}; pg8::EpiStore<0, false, false> E{wsb(F, WS_XO), D, nullptr, 1.f};
              pg8::gemm_phase<pg8::EpiStore<0, false, false>, pg8::StaticOrder, pg8::GemmX, true, true>(F.lds + RING_OFF, g, S, E); }
        }
        GRID_BAR();
        REFRESH();
        { pg8::GemmP g{wsb(F, WS_XO), wlay(F, l, OW_XO), D, D, D}; pg8::StaticOrder S; S.init(TOK, D, F.G, c); pg8::EpiRes E{wsb(F, WS_XB), nullptr, SS};
          pg8::gemm_phase<pg8::EpiRes, pg8::StaticOrder, pg8::GemmP, true, true>(F.lds + RING_OFF, g, S, E); }
        GRID_BAR();
        REFRESH();
        REP(8) { pg8::GemmP g{wsb(F, WS_XB), wlay(F, l, OW_FF1), D, D, D}; pg8::StaticOrder S; S.init(TOK, FF, F.G, c); pg8::EpiStore<1, true, false> E{wsb(F, WS_FFH), FF, SS, 1.f};
          pg8::gemm_phase<pg8::EpiStore<1, true, false>, pg8::StaticOrder, pg8::GemmP, true, true>(F.lds + RING_OFF, g, S, E); }
        GRID_BAR();
        REFRESH();
        { pg8::GemmP g{wsb(F, WS_FFH), wlay(F, l, OW_FF2), FF, FF, FF}; pg8::StaticOrder S; S.init(TOK, D, F.G, c); pg8::EpiRes E{wsb(F, WS_XB), (l == DEPTH - 1) ? F.out : nullptr, SS};
          pg8::gemm_phase<pg8::EpiRes, pg8::StaticOrder, pg8::GemmP, true, true>(F.lds + RING_OFF, g, S, E); }
        GRID_BAR();
    }
    REFRESH();
    final_norm(F);
    if (__hip_atomic_load((gu32*)((unsigned*)(F.ctl + CW_BAR) + XB_TMO), RLX_AGENT) != 0u && blockIdx.x == 0 && F.tid < 64) F.out[F.tid] = __builtin_nanf("");
}

extern "C" void kernel_launch(void* const* d_in, const int* in_sizes, int n_in, void* d_out, int out_size, void* d_ws, size_t ws_size, hipStream_t stream) {
    static int grid = 0;
    if (grid == 0) {
        if (n_in != 24 || out_size != TOK * D || ws_size < WS_END) { fprintf(stderr, "kernel_launch: unexpected problem shape (n_in %d, out %d, ws %zu); nothing launched\n", n_in, out_size, ws_size); grid = -1; return; }
        int dev = 0, cus = 0;
        if (hipGetDevice(&dev) != hipSuccess || hipDeviceGetAttribute(&cus, hipDeviceAttributeMultiprocessorCount, dev) != hipSuccess) { grid = -1; return; }
        if (hipFuncSetAttribute((const void*)mega_fwd, hipFuncAttributeMaxDynamicSharedMemorySize, LDS_BYTES) != hipSuccess) { fprintf(stderr, "kernel_launch: hipFuncSetAttribute failed\n"); grid = -1; return; }
        int per_cu = 0;
        if (hipOccupancyMaxActiveBlocksPerMultiprocessor(&per_cu, (const void*)mega_fwd, NWAVES * 64, LDS_BYTES) != hipSuccess || per_cu < 1) fprintf(stderr, "kernel_launch: occupancy query reports %d workgroups per CU\n", per_cu);
        (void)hipGetLastError();
        if (cus != 256) fprintf(stderr, "kernel_launch: built for a 256-CU device, found %d CUs\n", cus);
        grid = NCU;
    }
    if (grid < 0) return;
    (void)in_sizes;
    if (hipMemsetAsync((char*)d_ws + WS_CTL, 0, CTL_ZERO_BYTES, stream) != hipSuccess) return;
    Args a{};
    for (int i = 0; i < 24; ++i) a.in[i] = (const float*)d_in[i];
    a.out = (float*)d_out; a.ws = (unsigned char*)d_ws;
    hipLaunchKernelGGL(mega_fwd, dim3(grid), dim3(NWAVES * 64), LDS_BYTES, stream, a);
}
```

```cpp
#include <hip/hip_runtime.h>
#include <cstdio>
#include <cstdint>
namespace pg8 {
#define PG8_LAS __attribute__((address_space(3)))
typedef unsigned short bf16_t;
typedef short bf16x8 __attribute__((ext_vector_type(8)));
typedef float f32x4 __attribute__((ext_vector_type(4)));
typedef unsigned u32x4 __attribute__((ext_vector_type(4)));
constexpr int BM = 256, BK = 64, HALF = 128, HTB = HALF * BK * 2  , STAGE_BYTES = 8 * HTB, NXCD = 8, WGM = 8;

__host__ __device__ __forceinline__ int lds_byte(int r, int c) { const int st = (r >> 4) * 2 + (c >> 5), rr = r & 15, cc = c & 31, ob = rr * 64 + cc * 2; return st * 1024 + (ob ^ (((ob >> 9) & 1) << 5)); }
__host__ __device__ __forceinline__ void stage_rc(int b, int& R, int& C) { const int st = b / 1024, sb = b % 1024, swz = sb ^ (((sb >> 9) & 1) << 5); R = (st >> 1) * 16 + swz / 64; C = (st & 1) * 32 + (swz % 64) / 2; }
__host__ __device__ __forceinline__ int perm32(int rho) { const int n = rho >> 4, i = rho & 15; return 8 * (i >> 2) + 4 * n + (i & 3); }

struct Unit { int pm, pn; };

struct StaticOrder {
    int nM, nN, nwg, G, c;
    __host__ __device__ __forceinline__ void init(int M, int N, int G_, int c_) { nM = M / BM; nN = N / BM; nwg = nM * nN; G = G_; c = c_; }
    __host__ __device__ __forceinline__ bool next(int i, Unit& u) const {
        const long L = (long)i * G + c; if (L >= nwg) return false;
        int wgid = (int)L; { const int q = nwg / NXCD, r = nwg % NXCD, xcd = wgid % NXCD, off = wgid / NXCD; wgid = (xcd < r ? xcd * (q + 1) : r * (q + 1) + (xcd - r) * q) + off; }
        const int nig = WGM * nN, gid = wgid / nig, fm = gid * WGM, gsz = (nM - fm) < WGM ? (nM - fm) : WGM;
        u.pm = fm + ((wgid % nig) % gsz); u.pn = (wgid % nig) / gsz; return true;
    }
    __device__ __forceinline__ void a_ready(const Unit&) const {}
    __device__ __forceinline__ void done(const Unit&) const {}
};
__device__ __forceinline__ unsigned cvt_pk_bf16(float lo, float hi) { unsigned r; asm volatile("v_cvt_pk_bf16_f32 %0, %1, %2" : "=v"(r) : "v"(lo), "v"(hi)); return r; }
template <class Epi, class Sched, class G, bool ALIGN_EPI = false, bool SP2 = false>
__device__ __forceinline__ void gemm_phase(PG8_LAS unsigned char* lds, const G g, const Sched& S, const Epi& E) {
    int tid_ = threadIdx.x; asm volatile("" : "+v"(tid_));
    const int tid = tid_, wid = __builtin_amdgcn_readfirstlane(tid >> 6), lane = tid & 63, wr = wid >> 2, wc = wid & 3, fr = lane & 15, fq = lane >> 4;
    const int K = g.K, nt = K / BK;
    unsigned voffA[2], voffB[2];
#pragma unroll
    for (int i = 0; i < 2; ++i) { int R, C; stage_rc(tid * 16 + i * 8192, R, C); const int Rb = Epi::PERM ? ((R & ~31) + perm32(R & 31)) : R;
        voffA[i] = (unsigned)(R * g.lda + C) * 2u; voffB[i] = (unsigned)(Rb * g.ldb + C) * 2u; }
    const size_t kstep = (size_t)(BK * 2);
    const size_t hstepA = (size_t)HALF * g.lda * 2, hstepB = (size_t)HALF * g.ldb * 2;
    const unsigned ldsw = (unsigned)wid * 1024u;
    const int aoff = lds_byte(wr * 64 + fr, fq * 8), boff = lds_byte(wc * 32 + fr, fq * 8);
#define PG8_SA(b, h) (((b) * 2 + (h)) * HTB)
#define PG8_SB(b, h) ((4 + (b) * 2 + (h)) * HTB)
#define PG8_STAGE(bufoff, gbase, voff) do { _Pragma("unroll") for (int _i = 0; _i < 2; ++_i) \
        __builtin_amdgcn_global_load_lds((const unsigned*)((const char*)(gbase) + (voff)[_i]), (PG8_LAS unsigned*)(lds + (bufoff) + ldsw + _i * 8192), 16, 0, 0); } while (0)
#define PG8_LDA(dst, b, h) do { _Pragma("unroll") for (int m = 0; m < 4; ++m) _Pragma("unroll") for (int k = 0; k < 2; ++k) dst[m][k] = *(const PG8_LAS bf16x8*)(lds + PG8_SA(b, h) + aoff + m * 2048 + k * 1024); } while (0)
#define PG8_LDB(dst, b, h) do { _Pragma("unroll") for (int n = 0; n < 2; ++n) _Pragma("unroll") for (int k = 0; k < 2; ++k) dst[n][k] = *(const PG8_LAS bf16x8*)(lds + PG8_SB(b, h) + boff + n * 2048 + k * 1024); } while (0)
#define PG8_MMA(ai, bj, At, Bt) do { __builtin_amdgcn_s_setprio(1); _Pragma("unroll") for (int m = 0; m < 4; ++m) _Pragma("unroll") for (int n = 0; n < 2; ++n) _Pragma("unroll") for (int k = 0; k < 2; ++k) \
        acc[ai][bj][m][n] = __builtin_amdgcn_mfma_f32_16x16x32_bf16(Bt[n][k], At[m][k], acc[ai][bj][m][n], 0, 0, 0); __builtin_amdgcn_s_setprio(0); } while (0)
#define PG8_WAIT_V(n) asm volatile("s_waitcnt vmcnt(" #n ")" ::: "memory")
#define PG8_WAIT_L(n) asm volatile("s_waitcnt lgkmcnt(" #n ")" ::: "memory")
#define PG8_BAR __builtin_amdgcn_s_barrier()
#define PG8_SCHED __builtin_amdgcn_sched_barrier(0)
    Unit cur, nxt; int ui = 0;
    if (!S.next(0, cur)) return;
    f32x4 acc[2][2][4][2];
#pragma unroll
    for (int a = 0; a < 2; ++a)
#pragma unroll
        for (int b = 0; b < 2; ++b)
#pragma unroll
            for (int m = 0; m < 4; ++m)
#pragma unroll
                for (int n = 0; n < 2; ++n) acc[a][b][m][n] = (f32x4){0.f, 0.f, 0.f, 0.f};
    bf16x8 At[4][2], B0[2][2], B1[2][2];
    const char* cA = g.a_ptr(cur); const char* cB = g.b_ptr(cur);
    S.a_ready(cur);
    if constexpr (SP2) {
        PG8_STAGE(PG8_SB(0, 0), cB, voffB); PG8_STAGE(PG8_SB(0, 1), cB + hstepB, voffB); PG8_STAGE(PG8_SA(0, 0), cA, voffA); PG8_STAGE(PG8_SA(0, 1), cA + hstepA, voffA);
        if (wr == 1) PG8_BAR;
        PG8_WAIT_V(2); PG8_BAR;
        PG8_STAGE(PG8_SB(1, 0), cB + kstep, voffB); PG8_STAGE(PG8_SA(1, 0), cA + kstep, voffA); PG8_STAGE(PG8_SB(1, 1), cB + hstepB + kstep, voffB);
        PG8_WAIT_V(6); PG8_BAR;
    } else {
        PG8_STAGE(PG8_SB(0, 0), cB, voffB); PG8_STAGE(PG8_SA(0, 0), cA, voffA); PG8_STAGE(PG8_SB(0, 1), cB + hstepB, voffB); PG8_STAGE(PG8_SA(0, 1), cA + hstepA, voffA);
        if (wr == 1) PG8_BAR;
        PG8_WAIT_V(4); PG8_BAR;
        PG8_STAGE(PG8_SB(1, 0), cB + kstep, voffB); PG8_STAGE(PG8_SA(1, 0), cA + kstep, voffA); PG8_STAGE(PG8_SB(1, 1), cB + hstepB + kstep, voffB);
        PG8_WAIT_V(6); PG8_BAR;
    }
    for (;;) {
        const bool has_next = S.next(ui + 1, nxt);
        const char* nA = has_next ? g.a_ptr(nxt) : cA; const char* nB = has_next ? g.b_ptr(nxt) : cB;
        for (int t = 0; t < nt; t += 2) {
            const bool last = (t == nt - 2);
            const char* a1 = cA + (size_t)(t + 1) * kstep;
            const char* a2 = last ? nA : cA + (size_t)(t + 2) * kstep; const char* b2 = last ? nB : cB + (size_t)(t + 2) * kstep;
            const char* a3 = a2 + kstep; const char* b3 = b2 + kstep;
            if (last && has_next) S.a_ready(nxt);
            if constexpr (SP2) {
            PG8_LDB(B0, 0, 0); PG8_LDB(B1, 0, 1); PG8_SCHED; PG8_LDA(At, 0, 0); PG8_STAGE(PG8_SA(1, 1), a1 + hstepA, voffA);
            PG8_WAIT_V(8); PG8_WAIT_L(0); PG8_BAR; PG8_MMA(0, 0, At, B0); PG8_MMA(0, 1, At, B1); PG8_BAR; PG8_SCHED;
            PG8_LDA(At, 0, 1); PG8_STAGE(PG8_SB(0, 0), b2, voffB); PG8_STAGE(PG8_SB(0, 1), b2 + hstepB, voffB); PG8_STAGE(PG8_SA(0, 0), a2, voffA);
            PG8_WAIT_V(8); PG8_WAIT_L(0); PG8_BAR; PG8_MMA(1, 0, At, B0); PG8_MMA(1, 1, At, B1); PG8_BAR; PG8_SCHED;
            PG8_LDB(B0, 1, 0); PG8_LDB(B1, 1, 1); PG8_SCHED; PG8_LDA(At, 1, 0); PG8_STAGE(PG8_SA(0, 1), a2 + hstepA, voffA);
            PG8_WAIT_V(8); PG8_WAIT_L(0); PG8_BAR; PG8_MMA(0, 0, At, B0); PG8_MMA(0, 1, At, B1); PG8_BAR; PG8_SCHED;
            PG8_LDA(At, 1, 1); PG8_STAGE(PG8_SB(1, 0), b3, voffB); PG8_STAGE(PG8_SB(1, 1), b3 + hstepB, voffB); PG8_STAGE(PG8_SA(1, 0), a3, voffA);
            PG8_WAIT_V(8); PG8_WAIT_L(0); PG8_BAR; PG8_MMA(1, 0, At, B0); PG8_MMA(1, 1, At, B1); PG8_BAR; PG8_SCHED;
            } else {
            PG8_LDB(B0, 0, 0); PG8_SCHED; PG8_LDA(At, 0, 0); PG8_STAGE(PG8_SA(1, 1), a1 + hstepA, voffA);
            PG8_WAIT_L(8); PG8_BAR; PG8_WAIT_L(0); PG8_MMA(0, 0, At, B0); PG8_BAR; PG8_SCHED;
            PG8_LDB(B1, 0, 1); PG8_STAGE(PG8_SB(0, 0), b2, voffB);
            PG8_BAR; PG8_WAIT_L(0); PG8_MMA(0, 1, At, B1); PG8_BAR;
            PG8_LDA(At, 0, 1); PG8_STAGE(PG8_SA(0, 0), a2, voffA);
            PG8_BAR; PG8_WAIT_L(0); PG8_MMA(1, 0, At, B0); PG8_BAR; PG8_SCHED;
            PG8_STAGE(PG8_SB(0, 1), b2 + hstepB, voffB);
            PG8_WAIT_V(6); PG8_BAR; PG8_MMA(1, 1, At, B1); PG8_BAR;
            PG8_LDB(B0, 1, 0); PG8_SCHED; PG8_LDA(At, 1, 0); PG8_STAGE(PG8_SA(0, 1), a2 + hstepA, voffA);
            PG8_WAIT_L(8); PG8_BAR; PG8_WAIT_L(0); PG8_MMA(0, 0, At, B0); PG8_BAR; PG8_SCHED;
            PG8_LDB(B1, 1, 1); PG8_STAGE(PG8_SB(1, 0), b3, voffB);
            PG8_BAR; PG8_WAIT_L(0); PG8_MMA(0, 1, At, B1); PG8_BAR;
            PG8_LDA(At, 1, 1); PG8_STAGE(PG8_SA(1, 0), a3, voffA);
            PG8_BAR; PG8_WAIT_L(0); PG8_MMA(1, 0, At, B0); PG8_BAR; PG8_SCHED;
            PG8_STAGE(PG8_SB(1, 1), b3 + hstepB, voffB);
            PG8_WAIT_V(6); PG8_BAR; PG8_MMA(1, 1, At, B1); PG8_BAR;
            }
        }
        if constexpr (ALIGN_EPI) { if (wr == 0) PG8_BAR; }
        if constexpr (!Epi::AFTER_DRAIN) { int te_ = threadIdx.x; asm volatile("" : "+v"(te_)); E(acc, cur, wr, wc, te_ & 15, (te_ & 63) >> 4); S.done(cur); }
        if (!has_next) break;
#pragma unroll
        for (int a = 0; a < 2; ++a)
#pragma unroll
            for (int b = 0; b < 2; ++b)
#pragma unroll
                for (int m = 0; m < 4; ++m)
#pragma unroll
                    for (int n = 0; n < 2; ++n) acc[a][b][m][n] = (f32x4){0.f, 0.f, 0.f, 0.f};
        cur = nxt; cA = nA; cB = nB; ++ui;
        if constexpr (ALIGN_EPI) { if (wr == 1) PG8_BAR; }
    }
    PG8_WAIT_V(0);
    if constexpr (!ALIGN_EPI) { if (wr == 0) PG8_BAR; }
    PG8_BAR;
    if constexpr (Epi::AFTER_DRAIN) { int te_ = threadIdx.x; asm volatile("" : "+v"(te_)); E.fused(acc, cur, wr, wc, te_ & 15, (te_ & 63) >> 4, lds, wid, te_ & 63); S.done(cur); }
#undef PG8_SA
#undef PG8_SB
#undef PG8_STAGE
#undef PG8_LDA
#undef PG8_LDB
#undef PG8_MMA
#undef PG8_WAIT_V
#undef PG8_WAIT_L
#undef PG8_BAR
#undef PG8_SCHED
}
constexpr int TOK = 16384;
constexpr float RMS_EPS = 1e-6f;
struct GemmP { const bf16_t* A; const bf16_t* Bt; int lda, ldb, K;
    __device__ __forceinline__ const char* a_ptr(const Unit& u) const { return (const char*)(A + (size_t)u.pm * BM * lda); }
    __device__ __forceinline__ const char* b_ptr(const Unit& u) const { return (const char*)(Bt + (size_t)u.pn * BM * ldb); } };
struct GemmX { const bf16_t* A; const bf16_t* Bt; int lda, ldb, K;
    __device__ __forceinline__ const char* a_ptr(const Unit& u) const { return (const char*)(A + ((size_t)u.pn * TOK + (size_t)u.pm * BM) * 256); }
    __device__ __forceinline__ const char* b_ptr(const Unit& u) const { return (const char*)(Bt + (size_t)((u.pm >> 3) * 4 + u.pn) * 65536); } };

struct GemmProj { const bf16_t* XB; const bf16_t* WIN; const bf16_t* HM; const bf16_t* WKV0; size_t wkv_lstride; int lda, ldb, K;
    __device__ __forceinline__ const char* a_ptr(const Unit& u) const {
        if (u.pn < 9) return (const char*)(XB + (size_t)u.pm * BM * 1024);
        const int idx = 2 * u.pm + (u.pn - 9), l = idx >> 6, part = (idx >> 5) & 1, b = (idx >> 2) & 7, h = idx & 3;
        return part == 0 ? (const char*)(HM + ((size_t)l * 2048 + b * 256) * 1024) : (const char*)(WKV0 + (size_t)l * wkv_lstride + (size_t)(1024 + h * 256) * 1024); }
    __device__ __forceinline__ const char* b_ptr(const Unit& u) const {
        if (u.pn < 9) return (const char*)(WIN + (size_t)u.pn * BM * 1024);
        const int idx = 2 * u.pm + (u.pn - 9), l = idx >> 6, part = (idx >> 5) & 1, b = (idx >> 2) & 7, h = idx & 3;
        return part == 0 ? (const char*)(WKV0 + (size_t)l * wkv_lstride + (size_t)(h * 256) * 1024) : (const char*)(HM + ((size_t)l * 2048 + b * 256) * 1024); } };
typedef unsigned u32x2 __attribute__((ext_vector_type(2)));
__device__ __forceinline__ void store16_wt(void* p, u32x4 v) { asm volatile("global_store_dwordx4 %0, %1, off sc1\n\ts_nop 1" :: "v"(p), "v"(v) : "memory"); }
template <bool MAX> __device__ __forceinline__ float comb16(float s) { const auto r = __builtin_amdgcn_permlane16_swap(__float_as_uint(s), __float_as_uint(s), false, false);
    const float a = __uint_as_float(r[0]), b = __uint_as_float(r[1]); return MAX ? __builtin_fmaxf(a, b) : a + b; }
template <bool MAX> __device__ __forceinline__ float comb32(float s) { const auto r = __builtin_amdgcn_permlane32_swap(__float_as_uint(s), __float_as_uint(s), false, false);
    const float a = __uint_as_float(r[0]), b = __uint_as_float(r[1]); return MAX ? __builtin_fmaxf(a, b) : a + b; }
__device__ __forceinline__ float bf_lo(unsigned w) { return __uint_as_float(w << 16); }
__device__ __forceinline__ float bf_hi(unsigned w) { return __uint_as_float(w & 0xffff0000u); }
__device__ __forceinline__ float fast_sigmoid(float z) { return __builtin_amdgcn_rcpf(1.0f + __builtin_amdgcn_exp2f(-1.4426950408889634f * z)); }
__device__ __forceinline__ float gelu_tanh(float x) {
    const float u = x * (0.7978845608028654f + 0.035677408136300125f * x * x);
    return x * __builtin_amdgcn_rcpf(1.0f + __builtin_amdgcn_exp2f(-2.8853900817779268f * u)); }
__device__ __forceinline__ void load_rstd(float (&rs)[2][4], const float* SS, const Unit& u, int wr, int fr, int fq) {
#pragma unroll
    for (int ai = 0; ai < 2; ++ai)
#pragma unroll
        for (int m = 0; m < 4; ++m) { const f32x4 a = *((const f32x4*)(SS + (size_t)(u.pm * BM + ai * HALF + wr * 64 + m * 16 + fr) * 16) + fq);
            float s = (a[0] + a[1]) + (a[2] + a[3]); s = comb16<false>(s); s = comb32<false>(s);
            rs[ai][m] = __builtin_amdgcn_rsqf(s * (1.0f / 1024.0f) + RMS_EPS); }
}
struct EpiProj { static constexpr bool PERM = true, AFTER_DRAIN = false;
    bf16_t *PA, *Q, *K, *V, *ZC; const float* SS; float qscale; bf16_t *XKV0, *XKV1;
    __device__ __forceinline__ void operator()(const f32x4 (&acc)[2][2][4][2], const Unit& u, int wr, int wc, int fr, int fq) const {
        const int pn = u.pn; bf16_t* base; int ldc, colt, mode;
        if (pn >= 9) {
            const int idx = 2 * u.pm + (pn - 9), l = idx >> 6, part = (idx >> 5) & 1, b = (idx >> 2) & 7, h = idx & 3;
            bf16_t* tb = (l == 0 ? XKV0 : XKV1) + (size_t)(part * 32 + b * 4 + h) * 65536; const int r0 = wr * 64 + fr, c0 = wc * 32 + 8 * fq;
#pragma unroll
            for (int ai = 0; ai < 2; ++ai)
#pragma unroll
                for (int m = 0; m < 4; ++m) { bf16_t* rowp = tb + (size_t)(r0 + ai * HALF + m * 16) * 256 + c0;
#pragma unroll
                    for (int bj = 0; bj < 2; ++bj) { const f32x4 v0 = acc[ai][bj][m][0], v1 = acc[ai][bj][m][1];
                        u32x4 w; w.x = cvt_pk_bf16(v0[0], v0[1]); w.y = cvt_pk_bf16(v0[2], v0[3]); w.z = cvt_pk_bf16(v1[0], v1[1]); w.w = cvt_pk_bf16(v1[2], v1[3]);
                        store16_wt(rowp + bj * HALF, w); } }
            return; }
        if (pn == 0) { base = PA; ldc = 256; colt = 0; mode = 0; }
        else if (pn <= 2) { base = Q; ldc = 512; colt = (pn - 1) * 256; mode = 1; }
        else if (pn <= 4) { base = K; ldc = 512; colt = (pn - 3) * 256; mode = 0; }
        else if (pn <= 6) { base = V; ldc = 512; colt = (pn - 5) * 256; mode = 0; }
        else { base = ZC; ldc = 512; colt = (pn - 7) * 256; mode = 2; }
        float rs[2][4]; load_rstd(rs, SS, u, wr, fr, fq);
        const float sc = (mode == 1) ? qscale : 1.0f;
        const int row0 = u.pm * BM + wr * 64 + fr, col0 = colt + wc * 32 + 8 * fq;
#pragma unroll
        for (int ai = 0; ai < 2; ++ai)
#pragma unroll
            for (int m = 0; m < 4; ++m) { bf16_t* rowp = base + (size_t)(row0 + ai * HALF + m * 16) * ldc + col0; const float r = rs[ai][m] * sc;
#pragma unroll
                for (int bj = 0; bj < 2; ++bj) { f32x4 v0 = acc[ai][bj][m][0] * r, v1 = acc[ai][bj][m][1] * r;
                    if (mode == 2) { v0 = (f32x4){gelu_tanh(v0[0]), gelu_tanh(v0[1]), gelu_tanh(v0[2]), gelu_tanh(v0[3])}; v1 = (f32x4){gelu_tanh(v1[0]), gelu_tanh(v1[1]), gelu_tanh(v1[2]), gelu_tanh(v1[3])}; }
                    u32x4 w; w.x = cvt_pk_bf16(v0[0], v0[1]); w.y = cvt_pk_bf16(v0[2], v0[3]); w.z = cvt_pk_bf16(v1[0], v1[1]); w.w = cvt_pk_bf16(v1[2], v1[3]);
                    store16_wt(rowp + bj * HALF, w); } }
    }
};
struct EpiTile { static constexpr bool PERM = true, AFTER_DRAIN = false;
    bf16_t* O; int mm, mn;
    __device__ __forceinline__ void operator()(const f32x4 (&acc)[2][2][4][2], const Unit& u, int wr, int wc, int fr, int fq) const {
        bf16_t* base = O + (size_t)(mm * u.pm + mn * u.pn) * 65536; const int row0 = wr * 64 + fr, col0 = wc * 32 + 8 * fq;
#pragma unroll
        for (int ai = 0; ai < 2; ++ai)
#pragma unroll
            for (int m = 0; m < 4; ++m) { bf16_t* rowp = base + (size_t)(row0 + ai * HALF + m * 16) * 256 + col0;
#pragma unroll
                for (int bj = 0; bj < 2; ++bj) { const f32x4 v0 = acc[ai][bj][m][0], v1 = acc[ai][bj][m][1];
                    u32x4 w; w.x = cvt_pk_bf16(v0[0], v0[1]); w.y = cvt_pk_bf16(v0[2], v0[3]); w.z = cvt_pk_bf16(v1[0], v1[1]); w.w = cvt_pk_bf16(v1[2], v1[3]);
                    *(u32x4*)(rowp + bj * HALF) = w; } }
    }
};
template <int ACT  , bool ROWSCALE, bool HEADMAJOR> struct EpiStore { static constexpr bool PERM = true, AFTER_DRAIN = false;
    bf16_t* O; int ldc; const float* SS; float scale;
    __device__ __forceinline__ void operator()(const f32x4 (&acc)[2][2][4][2], const Unit& u, int wr, int wc, int fr, int fq) const {
        float rs[2][4];
        if (ROWSCALE) load_rstd(rs, SS, u, wr, fr, fq);
        bf16_t* base = O; int colt = u.pn * BM;
        if (HEADMAJOR) { base += (size_t)u.pn * TOK * 256; colt = 0; }
        const int row0 = u.pm * BM + wr * 64 + fr, col0 = colt + wc * 32 + 8 * fq;
#pragma unroll
        for (int ai = 0; ai < 2; ++ai)
#pragma unroll
            for (int m = 0; m < 4; ++m) { bf16_t* rowp = base + (size_t)(row0 + ai * HALF + m * 16) * ldc + col0; const float r = ROWSCALE ? rs[ai][m] * scale : scale;
#pragma unroll
                for (int bj = 0; bj < 2; ++bj) { f32x4 v0 = acc[ai][bj][m][0] * r, v1 = acc[ai][bj][m][1] * r;
                    if (ACT == 1) {
#pragma unroll
                        for (int i = 0; i < 4; ++i) { const float a = __builtin_fmaxf(v0[i], 0.f), b = __builtin_fmaxf(v1[i], 0.f); v0[i] = a * a; v1[i] = b * b; } }
                    u32x4 w; w.x = cvt_pk_bf16(v0[0], v0[1]); w.y = cvt_pk_bf16(v0[2], v0[3]); w.z = cvt_pk_bf16(v1[0], v1[1]); w.w = cvt_pk_bf16(v1[2], v1[3]);
                    store16_wt(rowp + bj * HALF, w); } }
    }
};
struct EpiNop { static constexpr bool PERM = true, AFTER_DRAIN = false;
    __device__ __forceinline__ void operator()(const f32x4 (&acc)[2][2][4][2], const Unit&, int, int, int, int) const {
#pragma unroll
        for (int ai = 0; ai < 2; ++ai)
#pragma unroll
            for (int bj = 0; bj < 2; ++bj)
#pragma unroll
                for (int m = 0; m < 4; ++m)
#pragma unroll
                    for (int n = 0; n < 2; ++n) asm volatile("" :: "v"(acc[ai][bj][m][n]));
    }
};
template <bool FIRST> struct EpiGate { static constexpr bool PERM = true, AFTER_DRAIN = false;
    const bf16_t* Y; bf16_t* MG; const float* bias; const float* SS;
    __device__ __forceinline__ void operator()(const f32x4 (&acc)[2][2][4][2], const Unit& u, int wr, int wc, int fr, int fq) const {
        float rs[2][4]; load_rstd(rs, SS, u, wr, fr, fq);
        const int row0 = u.pm * BM + wr * 64 + fr, col0 = u.pn * BM + wc * 32 + 8 * fq;
        f32x4 bv[2][2];
#pragma unroll
        for (int bj = 0; bj < 2; ++bj)
#pragma unroll
            for (int n = 0; n < 2; ++n) bv[bj][n] = *(const f32x4*)(bias + col0 + bj * HALF + 4 * n);
#pragma unroll
        for (int ai = 0; ai < 2; ++ai)
#pragma unroll
            for (int m = 0; m < 4; ++m) { const size_t off = (size_t)(row0 + ai * HALF + m * 16) * 1024 + col0; const float r = rs[ai][m];
#pragma unroll
                for (int bj = 0; bj < 2; ++bj) { const f32x4 z0 = acc[ai][bj][m][0] * r + bv[bj][0], z1 = acc[ai][bj][m][1] * r + bv[bj][1];
                    const u32x4 y = *(const u32x4*)(Y + off + bj * HALF);
                    float o0 = fast_sigmoid(z0[0]) * bf_lo(y.x), o1 = fast_sigmoid(z0[1]) * bf_hi(y.x), o2 = fast_sigmoid(z0[2]) * bf_lo(y.y), o3 = fast_sigmoid(z0[3]) * bf_hi(y.y);
                    float o4 = fast_sigmoid(z1[0]) * bf_lo(y.z), o5 = fast_sigmoid(z1[1]) * bf_hi(y.z), o6 = fast_sigmoid(z1[2]) * bf_lo(y.w), o7 = fast_sigmoid(z1[3]) * bf_hi(y.w);
                    if (!FIRST) { const u32x4 p = *(const u32x4*)(MG + off + bj * HALF);
                        o0 += bf_lo(p.x); o1 += bf_hi(p.x); o2 += bf_lo(p.y); o3 += bf_hi(p.y); o4 += bf_lo(p.z); o5 += bf_hi(p.z); o6 += bf_lo(p.w); o7 += bf_hi(p.w); }
                    u32x4 w; w.x = cvt_pk_bf16(o0, o1); w.y = cvt_pk_bf16(o2, o3); w.z = cvt_pk_bf16(o4, o5); w.w = cvt_pk_bf16(o6, o7);
                    *(u32x4*)(MG + off + bj * HALF) = w; }
                if (m & 1) asm volatile("" ::: "memory"); }
    }
};
struct EpiRes { static constexpr bool PERM = true, AFTER_DRAIN = false;
    bf16_t* xb; float* outf; float* SS;
    __device__ __forceinline__ void operator()(const f32x4 (&acc)[2][2][4][2], const Unit& u, int wr, int wc, int fr, int fq) const {
        const int row0 = u.pm * BM + wr * 64 + fr, col0 = u.pn * BM + wc * 32 + 8 * fq;
#pragma unroll
        for (int ai = 0; ai < 2; ++ai)
#pragma unroll
            for (int m = 0; m < 4; ++m) { const int row = row0 + ai * HALF + m * 16; const size_t off = (size_t)row * 1024 + col0; float ss = 0.f;
#pragma unroll
                for (int bj = 0; bj < 2; ++bj) { const u32x4 y = *(const u32x4*)(xb + off + bj * HALF);
                    const f32x4 v0 = acc[ai][bj][m][0] + (f32x4){bf_lo(y.x), bf_hi(y.x), bf_lo(y.y), bf_hi(y.y)}, v1 = acc[ai][bj][m][1] + (f32x4){bf_lo(y.z), bf_hi(y.z), bf_lo(y.w), bf_hi(y.w)};
                    ss += ((v0[0] * v0[0] + v0[1] * v0[1]) + (v0[2] * v0[2] + v0[3] * v0[3])) + ((v1[0] * v1[0] + v1[1] * v1[1]) + (v1[2] * v1[2] + v1[3] * v1[3]));
                    if (outf) { *(f32x4*)(outf + off + bj * HALF) = v0; *(f32x4*)(outf + off + bj * HALF + 4) = v1; }
                    else { u32x4 w; w.x = cvt_pk_bf16(v0[0], v0[1]); w.y = cvt_pk_bf16(v0[2], v0[3]); w.z = cvt_pk_bf16(v1[0], v1[1]); w.w = cvt_pk_bf16(v1[2], v1[3]); *(u32x4*)(xb + off + bj * HALF) = w; } }
                ss = comb16<false>(ss); ss = comb32<false>(ss);
                if (fq == 0) SS[(size_t)row * 16 + u.pn * 4 + wc] = ss;
                if (m & 1) asm volatile("" ::: "memory"); }
    }
};
struct EpiSoftmax { static constexpr bool PERM = true, AFTER_DRAIN = true;
    bf16_t* P;
    __device__ __forceinline__ void fused(f32x4 (&acc)[2][2][4][2], const Unit& u, int wr, int wc, int fr, int fq, PG8_LAS unsigned char* lds, int wid, int lane) const {
        PG8_LAS float* Pm = (PG8_LAS float*)lds; PG8_LAS float* Ps = Pm + 1024;
#pragma unroll
        for (int ai = 0; ai < 2; ++ai)
#pragma unroll
            for (int m = 0; m < 4; ++m) { float t = -INFINITY;
#pragma unroll
                for (int bj = 0; bj < 2; ++bj)
#pragma unroll
                    for (int n = 0; n < 2; ++n) { const f32x4 x = acc[ai][bj][m][n]; t = __builtin_fmaxf(t, __builtin_fmaxf(__builtin_fmaxf(x[0], x[1]), __builtin_fmaxf(x[2], x[3]))); }
                t = comb16<true>(t); t = comb32<true>(t);
                if (fq == 0) Pm[(ai * HALF + wr * 64 + m * 16 + fr) * 4 + wc] = t; }
        asm volatile("s_waitcnt lgkmcnt(0)" ::: "memory"); __builtin_amdgcn_s_barrier(); asm volatile("" ::: "memory");
#pragma unroll
        for (int ai = 0; ai < 2; ++ai)
#pragma unroll
            for (int m = 0; m < 4; ++m) { const int r = ai * HALF + wr * 64 + m * 16 + fr; const f32x4 mm = *(const PG8_LAS f32x4*)(Pm + r * 4);
                const float mx = __builtin_fmaxf(__builtin_fmaxf(mm[0], mm[1]), __builtin_fmaxf(mm[2], mm[3])); float s = 0.f;
#pragma unroll
                for (int bj = 0; bj < 2; ++bj)
#pragma unroll
                    for (int n = 0; n < 2; ++n) { f32x4 x = acc[ai][bj][m][n];
#pragma unroll
                        for (int i = 0; i < 4; ++i) x[i] = __builtin_amdgcn_exp2f(x[i] - mx);
                        acc[ai][bj][m][n] = x; s += (x[0] + x[1]) + (x[2] + x[3]); }
                s = comb16<false>(s); s = comb32<false>(s);
                if (fq == 0) Ps[r * 4 + wc] = s; }
        asm volatile("s_waitcnt lgkmcnt(0)" ::: "memory"); __builtin_amdgcn_s_barrier(); asm volatile("" ::: "memory");
        bf16_t* base = P + ((size_t)u.pn * TOK + (size_t)u.pm * BM) * 256; const int col0 = wc * 32 + 8 * fq;
#pragma unroll
        for (int ai = 0; ai < 2; ++ai)
#pragma unroll
            for (int m = 0; m < 4; ++m) { const int r = ai * HALF + wr * 64 + m * 16 + fr; const f32x4 sm = *(const PG8_LAS f32x4*)(Ps + r * 4);
                const float inv = 1.0f / ((sm[0] + sm[1]) + (sm[2] + sm[3])); bf16_t* rowp = base + (size_t)r * 256 + col0;
#pragma unroll
                for (int bj = 0; bj < 2; ++bj) { const f32x4 v0 = acc[ai][bj][m][0] * inv, v1 = acc[ai][bj][m][1] * inv;
                    u32x4 w; w.x = cvt_pk_bf16(v0[0], v0[1]); w.y = cvt_pk_bf16(v0[2], v0[3]); w.z = cvt_pk_bf16(v1[0], v1[1]); w.w = cvt_pk_bf16(v1[2], v1[3]);
                    *(u32x4*)(rowp + bj * HALF) = w; } }
        asm volatile("s_waitcnt lgkmcnt(0)" ::: "memory"); __builtin_amdgcn_s_barrier(); asm volatile("" ::: "memory");
    }
};

}

#include <hip/hip_bf16.h>
#include <cmath>
namespace attn_body {
using bf16=__hip_bfloat16;
using bf16x8=__attribute__((ext_vector_type(8)))short;
using s16x4=__attribute__((ext_vector_type(4)))short;
using f32x16=__attribute__((ext_vector_type(16)))float;
using u32x4=__attribute__((ext_vector_type(4)))unsigned;
constexpr int BATCH=8,NHEAD=8,SEQ=2048,D=64,DM=NHEAD*D;
constexpr int NW=8,QBLK=32,QB=QBLK*NW,KVBLK=64,NQB=SEQ/QB;
constexpr int ATTN_PITCH=DM, ATTN_UNIT_ROWS=QB;
__device__ __forceinline__ int crow(int r,int hi){return (r&3)+8*(r>>2)+4*hi;}
#define SBAR() __builtin_amdgcn_sched_barrier(0)
__device__ __forceinline__ void cmask(f32x16&p0,f32x16&p1,int jb,int qrel,int hi){
  const float NEG=-INFINITY; int kb=64*jb+4*hi;
  #pragma unroll
  for(int r=0;r<16;++r){int kv=kb+(r&3)+8*(r>>2); if(kv>qrel)p0[r]=NEG; if(kv+32>qrel)p1[r]=NEG;}
}

constexpr int NSLOT=3, SLOTB=8192;
constexpr int LDS_K=0, LDS_V=NSLOT*SLOTB, LDS_WS=2*NSLOT*SLOTB, LDS_OST=LDS_WS+NW*64*4, LDS_BYTES=LDS_OST+NW*4096, LDS_NB=LDS_BYTES;
constexpr float C2=0.125f*1.4426950408889634f;
__device__ __forceinline__ void glds16(const void*gsrc,unsigned lds_dst){unsigned keep;
  asm volatile("s_mov_b32 %0, m0\n\ts_mov_b32 m0, %2\n\ts_nop 0\n\tglobal_load_lds_dwordx4 %1, off\n\ts_mov_b32 m0, %0":"=&s"(keep):"v"(gsrc),"s"(lds_dst):"memory");}
__device__ __forceinline__ float max3f(float a,float b,float c){float r;asm("v_max3_f32 %0, %1, %2, %3":"=v"(r):"v"(a),"v"(b),"v"(c));return r;}
__device__ __forceinline__ float max2f(float a,float b){float r;asm("v_max_f32_e32 %0, %1, %2":"=v"(r):"v"(a),"v"(b));return r;}
__device__ __forceinline__ float fadd_s(float a,float b){float r;asm("v_add_f32_e32 %0, %1, %2":"=v"(r):"v"(a),"v"(b));return r;}
__device__ __forceinline__ float fsub_s(float a,float b){float r;asm("v_sub_f32_e32 %0, %1, %2":"=v"(r):"v"(a),"v"(b));return r;}
typedef float f32x2_t __attribute__((ext_vector_type(2))); typedef __bf16 bf16x2_t __attribute__((ext_vector_type(2)));
__device__ __forceinline__ unsigned cvtpk_s(float lo,float hi){f32x2_t v={lo,hi};bf16x2_t b=__builtin_convertvector(v,bf16x2_t);return __builtin_bit_cast(unsigned,b);}
#define WAIT_BAR(N) asm volatile("s_waitcnt vmcnt(" #N ") lgkmcnt(0)\n\ts_barrier":::"memory")

__device__ __forceinline__ void qkt(f32x16&p0,f32x16&p1,const char*Kslot,const bf16x8*qr,int r32,int hi){
  const char*kb=Kslot+hi*1024+r32*16;
  #pragma unroll
  for(int d0=0;d0<4;++d0){
    const bf16x8 b0=*reinterpret_cast<const bf16x8*>(kb+d0*2048);
    const bf16x8 b1=*reinterpret_cast<const bf16x8*>(kb+d0*2048+512);
    p0=__builtin_amdgcn_mfma_f32_32x32x16_bf16(b0,qr[d0],p0,0,0,0);p1=__builtin_amdgcn_mfma_f32_32x32x16_bf16(b1,qr[d0],p1,0,0,0);}
}
typedef __attribute__((address_space(3))) const char* lds_cptr;
typedef short v4i16_t __attribute__((ext_vector_type(4)));
__device__ __forceinline__ void kload8(bf16x8*kf,lds_cptr kp){
  kf[0]=*(const __attribute__((address_space(3))) bf16x8*)(kp);      kf[1]=*(const __attribute__((address_space(3))) bf16x8*)(kp+512);
  kf[2]=*(const __attribute__((address_space(3))) bf16x8*)(kp+2048); kf[3]=*(const __attribute__((address_space(3))) bf16x8*)(kp+2560);
  kf[4]=*(const __attribute__((address_space(3))) bf16x8*)(kp+4096); kf[5]=*(const __attribute__((address_space(3))) bf16x8*)(kp+4608);
  kf[6]=*(const __attribute__((address_space(3))) bf16x8*)(kp+6144); kf[7]=*(const __attribute__((address_space(3))) bf16x8*)(kp+6656);
}
__device__ __forceinline__ void kload2(bf16x8*kf,lds_cptr kp,int j){ kf[2*j]=*(const __attribute__((address_space(3))) bf16x8*)(kp+j*2048); kf[2*j+1]=*(const __attribute__((address_space(3))) bf16x8*)(kp+j*2048+512); }
__device__ __forceinline__ s16x4 vtr(lds_cptr p){ return __builtin_bit_cast(s16x4,__builtin_amdgcn_ds_read_tr16_b64_v4i16((__attribute__((address_space(3))) v4i16_t*)p)); }
__device__ __forceinline__ float rowmax(const f32x16&p0,const f32x16&p1){
  float a=max3f(p0[0],p0[1],p1[0]),b=max3f(p0[2],p0[3],p1[1]);a=max3f(a,p1[2],p1[3]);
  #pragma unroll
  for(int r=4;r<16;r+=4){a=max3f(a,p0[r],p0[r+1]);b=max3f(b,p0[r+2],p0[r+3]);a=max3f(a,p1[r],p1[r+1]);b=max3f(b,p1[r+2],p1[r+3]);}
  const float m=max2f(a,b);
  auto rr=__builtin_amdgcn_permlane32_swap(__float_as_uint(m),__float_as_uint(m),false,false);
  return max2f(__uint_as_float(rr[0]),__uint_as_float(rr[1]));
}
__device__ __forceinline__ void pv(f32x16*o,int vb,bf16x8 pa0,bf16x8 pa1,bf16x8 pa2,bf16x8 pa3){
  #pragma unroll
  for(int d0=0;d0<2;++d0){s16x4 lo[4],hi[4];
    #pragma unroll
    for(int ks=0;ks<4;++ks){
      asm volatile("ds_read_b64_tr_b16 %0,%1 offset:%c2":"=&v"(lo[ks]):"v"(vb),"i"(d0*4096+ks*1024):"memory");
      asm volatile("ds_read_b64_tr_b16 %0,%1 offset:%c2":"=&v"(hi[ks]):"v"(vb),"i"(d0*4096+ks*1024+512):"memory");}
    asm volatile("s_waitcnt lgkmcnt(0)":::"memory");SBAR();
    #define PK(k) (bf16x8){lo[k][0],lo[k][1],lo[k][2],lo[k][3],hi[k][0],hi[k][1],hi[k][2],hi[k][3]}
    o[d0]=__builtin_amdgcn_mfma_f32_32x32x16_bf16(pa0,PK(0),o[d0],0,0,0);
    o[d0]=__builtin_amdgcn_mfma_f32_32x32x16_bf16(pa1,PK(1),o[d0],0,0,0);
    o[d0]=__builtin_amdgcn_mfma_f32_32x32x16_bf16(pa2,PK(2),o[d0],0,0,0);
    o[d0]=__builtin_amdgcn_mfma_f32_32x32x16_bf16(pa3,PK(3),o[d0],0,0,0);
    #undef PK
  }
}

#ifndef ATTN_STORE16
#define ATTN_STORE16(p,v) (*(u32x4*)(p)=(v))
#endif
template<int THRL> __device__ __forceinline__ void attn_unit(int b,int h,int qb,const bf16*Q,const bf16*__restrict__ K,const bf16*__restrict__ V,bf16*O,char*shm){
  int tid_=threadIdx.x; asm volatile("":"+v"(tid_)); const int tid=tid_,lane=tid&63,r32=lane&31,hi=lane>>5; const int wid=__builtin_amdgcn_readfirstlane(tid>>6);
  const long rowbase=(long)b*SEQ; const int q0=qb*QB;
  const bf16*Qw=Q+(rowbase+q0+wid*QBLK)*DM+h*D;
  const bf16*Kh=K+rowbase*DM+h*D,*Vh=V+rowbase*DM+h*D;
  const unsigned lds0=(unsigned)(uintptr_t)shm;
  float*wsf=(float*)(shm+LDS_WS)+wid*64;
  const bf16*ksrc=Kh+(long)lane*DM+wid*8;
  const bf16*vsrc=Vh+(long)(16*(wid&3)+(lane>>2))*DM+(wid>>2)*32+(lane&3)*8;
  const unsigned kdst=lds0+LDS_K+wid*1024, vdst=lds0+LDS_V+wid*1024;
  #define DMA_K(t,slot) glds16(ksrc+(long)(t)*KVBLK*DM,(unsigned)__builtin_amdgcn_readfirstlane(kdst+(slot)))
  #define DMA_V(t,slot) glds16(vsrc+(long)(t)*KVBLK*DM,(unsigned)__builtin_amdgcn_readfirstlane(vdst+(slot)))
  const int vb0=(int)(lds0+LDS_V)+((lane>>4)&1)*32+(lane&3)*8+(4*hi+((lane&15)>>2))*64;
  const char*Kbase=shm+LDS_K; bf16x8 kf[8];
  const lds_cptr shm3=(lds_cptr)shm; const lds_cptr kp0=shm3+LDS_K+hi*1024+r32*16; const lds_cptr vp0=shm3+LDS_V+((lane>>4)&1)*32+(lane&3)*8+(4*hi+((lane&15)>>2))*64;
  const int NT=(q0+QB)/KVBLK;
  DMA_K(0,0);DMA_V(0,0);DMA_K(1,SLOTB);
  bf16x8 qr[4];
  #pragma unroll
  for(int d0=0;d0<4;++d0)qr[d0]=*reinterpret_cast<const bf16x8*>(&Qw[(long)r32*DM+d0*16+hi*8]);
  float mhat=0.f,l_reg=0.f;f32x16 o[2];o[0]=f32x16{};o[1]=f32x16{};
  typedef float f32x4_t __attribute__((ext_vector_type(4)));
  const __attribute__((address_space(3))) f32x4_t* nb3=(const __attribute__((address_space(3))) f32x4_t*)((lds_cptr)shm+LDS_NB+hi*16);
  #define LDBIAS(C0,C1,t) do{ const __attribute__((address_space(3))) f32x4_t* nb_=nb3+16*(t); \
    _Pragma("unroll") for(int g_=0;g_<4;++g_){ const f32x4_t a_=nb_[2*g_], b_=nb_[8+2*g_]; \
      C0[4*g_]=a_[0];C0[4*g_+1]=a_[1];C0[4*g_+2]=a_[2];C0[4*g_+3]=a_[3]; C1[4*g_]=b_[0];C1[4*g_+1]=b_[1];C1[4*g_+2]=b_[2];C1[4*g_+3]=b_[3]; } }while(0)
  const int qrel=wid*QBLK+r32;
  #define CMASK(P0,P1,t) do{int jb_=(t)-(NT-4); if(jb_>=0)cmask(P0,P1,jb_,qrel,hi);}while(0)
  bool resc=false;
  #define START(P0,P1) do{ const float rm=rowmax(P0,P1); resc=false; mhat=rm; \
    _Pragma("unroll") for(int r=0;r<16;++r)P0[r]=__builtin_amdgcn_exp2f(P0[r]-mhat); }while(0)
  #define RESC() do{ if(resc){ asm volatile("s_waitcnt lgkmcnt(0)":::"memory"); \
      _Pragma("unroll") for(int d_=0;d_<2;++d_) _Pragma("unroll") for(int r=0;r<16;++r)o[d_][r]*=wsf[crow(r,hi)]; } }while(0)
  f32x16 pA0,pA1,pB0,pB1;
  int sl_prev=0,sl_cur=0,sl_next=SLOTB;
  #define ROT() do{sl_prev=sl_cur;sl_cur=sl_next;sl_next=(sl_next==(NSLOT-1)*SLOTB)?0:sl_next+SLOTB;}while(0)
  DMA_K(2,2*SLOTB);
  WAIT_BAR(3);
  LDBIAS(pA0,pA1,0); qkt(pA0,pA1,Kbase,qr,r32,hi);asm volatile("s_nop 15\n\ts_nop 7":"+v"(pA0),"+v"(pA1));CMASK(pA0,pA1,0);
  START(pA0,pA1);
  _Pragma("unroll") for(int r=0;r<16;++r)pA1[r]=__builtin_amdgcn_exp2f(pA1[r]-mhat);
  WAIT_BAR(0);
  DMA_K(3,0);DMA_V(1,SLOTB);
  ROT();
  kload8(kf,kp0+sl_cur);
  WAIT_BAR(2);
  s16x4 vlo[8],vhi[8]; u32x4 pw0,pw1,pw2,pw3;
  #define PKW(P,B) cvtpk_s(P[B],P[B+1])
  #define PAF(k) __builtin_bit_cast(bf16x8,pw##k)
  #define VFR(i) (bf16x8){vlo[i][0],vlo[i][1],vlo[i][2],vlo[i][3],vhi[i][0],vhi[i][1],vhi[i][2],vhi[i][3]}
  #define PIN(x) asm volatile("":"+v"(x))
  #define MX3(a,b,c) __builtin_fmaxf(__builtin_fmaxf((a),(b)),(c))
  #define GAPA(MF,A0,A1,A2,A3,W0,W1,PW) do{ MF; sacc+=A0; sacc+=A1; sacc+=A2; sacc+=A3; PIN(sacc); W0; W1; PIN(PW); SBAR(); }while(0)
  #define EX(v) __builtin_amdgcn_exp2f((v)-mhat)
  #define GAPB(MF,X,B) do{ MF; X[B]=EX(X[B]); X[B+1]=EX(X[B+1]); X[B+2]=EX(X[B+2]); X[B+3]=EX(X[B+3]); PIN(X); SBAR(); }while(0)
  #define VRD(i) do{ vlo[i]=vtr(vp_+(((i)>>2)*4096+((i)&3)*1024)); vhi[i]=vtr(vp_+(((i)>>2)*4096+((i)&3)*1024+512)); }while(0)
  #define KRD(G,j) do{ if(G){ kload2(kf,kp0+sl_next,j); SBAR(); } }while(0)
  #define STEP(C0,C1,P0,P1,t,GK,GV,GL) do{ SBAR(); LDBIAS(C0,C1,t); \
    const lds_cptr vp_=vp0+sl_prev; \
    VRD(0); SBAR(); float sacc=(P0[0]+P0[1]); \
    GAPA(C0=__builtin_amdgcn_mfma_f32_32x32x16_bf16(kf[0],qr[0],C0,0,0,0), P0[2],P0[3],P0[4],P0[5],     pw0[0]=PKW(P0,0), pw0[1]=PKW(P0,2), pw0); \
    VRD(4); SBAR(); GAPA(C1=__builtin_amdgcn_mfma_f32_32x32x16_bf16(kf[1],qr[0],C1,0,0,0), P0[6],P0[7],P0[8],P0[9],     pw0[2]=PKW(P0,4), pw0[3]=PKW(P0,6), pw0); \
    VRD(1); SBAR(); GAPA(C0=__builtin_amdgcn_mfma_f32_32x32x16_bf16(kf[2],qr[1],C0,0,0,0),   P0[10],P0[11],P0[12],P0[13], pw1[0]=PKW(P0,8), pw1[1]=PKW(P0,10), pw1); \
    VRD(5); SBAR(); GAPA(C1=__builtin_amdgcn_mfma_f32_32x32x16_bf16(kf[3],qr[1],C1,0,0,0),   P0[14],P0[15],P1[0],P1[1],   pw1[2]=PKW(P0,12),pw1[3]=PKW(P0,14), pw1); \
    VRD(2); SBAR(); GAPA(C0=__builtin_amdgcn_mfma_f32_32x32x16_bf16(kf[4],qr[2],C0,0,0,0),   P1[2],P1[3],P1[4],P1[5],     pw2[0]=PKW(P1,0), pw2[1]=PKW(P1,2), pw2); \
    VRD(6); SBAR(); GAPA(C1=__builtin_amdgcn_mfma_f32_32x32x16_bf16(kf[5],qr[2],C1,0,0,0),   P1[6],P1[7],P1[8],P1[9],     pw2[2]=PKW(P1,4), pw2[3]=PKW(P1,6), pw2); \
    VRD(3); SBAR(); GAPA(C0=__builtin_amdgcn_mfma_f32_32x32x16_bf16(kf[6],qr[3],C0,0,0,0),   P1[10],P1[11],P1[12],P1[13], pw3[0]=PKW(P1,8), pw3[1]=PKW(P1,10), pw3); \
    VRD(7); SBAR(); GAPA(C1=__builtin_amdgcn_mfma_f32_32x32x16_bf16(kf[7],qr[3],C1,0,0,0),   P1[14],P1[15],0.f,0.f,       pw3[2]=PKW(P1,12),pw3[3]=PKW(P1,14), pw3); \
    l_reg+=sacc; \
    if(GK){DMA_K((t)+3,sl_cur);} if(GV){DMA_V((t)+1,sl_next);} \
    CMASK(C0,C1,t); \
    { float a=MX3(C0[0],C0[1],C1[0]),b=MX3(C0[2],C0[3],C1[1]); a=MX3(a,C1[2],C1[3]); \
      _Pragma("unroll") for(int r=4;r<16;r+=4){a=MX3(a,C0[r],C0[r+1]);b=MX3(b,C0[r+2],C0[r+3]);a=MX3(a,C1[r],C1[r+1]);b=MX3(b,C1[r+2],C1[r+3]);} \
      float rm=__builtin_fmaxf(a,b); { auto rr=__builtin_amdgcn_permlane32_swap(__float_as_uint(rm),__float_as_uint(rm),false,false); rm=__builtin_fmaxf(__uint_as_float(rr[0]),__uint_as_float(rr[1])); } \
      resc=false; rm-=mhat; \
      if(__builtin_expect(__any(rm>(float)THRL),0)){ const float dl=__builtin_fmaxf(rm,0.f); mhat+=dl; \
        const float f=__builtin_amdgcn_exp2f(-dl); l_reg*=f; if(hi==0)wsf[r32]=f; resc=true; } } \
    SBAR(); \
    GAPB(o[0]=__builtin_amdgcn_mfma_f32_32x32x16_bf16(PAF(0),VFR(0),o[0],0,0,0), C0,0); \
    GAPB(o[1]=__builtin_amdgcn_mfma_f32_32x32x16_bf16(PAF(0),VFR(4),o[1],0,0,0), C0,4); \
    KRD(GL,0); GAPB(o[0]=__builtin_amdgcn_mfma_f32_32x32x16_bf16(PAF(1),VFR(1),o[0],0,0,0), C0,8); \
    KRD(GL,1); GAPB(o[1]=__builtin_amdgcn_mfma_f32_32x32x16_bf16(PAF(1),VFR(5),o[1],0,0,0), C0,12); \
    KRD(GL,2); GAPB(o[0]=__builtin_amdgcn_mfma_f32_32x32x16_bf16(PAF(2),VFR(2),o[0],0,0,0), C1,0); \
    KRD(GL,3); GAPB(o[1]=__builtin_amdgcn_mfma_f32_32x32x16_bf16(PAF(2),VFR(6),o[1],0,0,0), C1,4); \
    GAPB(o[0]=__builtin_amdgcn_mfma_f32_32x32x16_bf16(PAF(3),VFR(3),o[0],0,0,0), C1,8); \
    GAPB(o[1]=__builtin_amdgcn_mfma_f32_32x32x16_bf16(PAF(3),VFR(7),o[1],0,0,0), C1,12); \
    }while(0)
  int t=1;
  #undef CMASK
  #define CMASK(P0,P1,t) do{}while(0)
  for(;t+5<NT;t+=2){
    STEP(pB0,pB1,pA0,pA1,t,true,true,true);     WAIT_BAR(2); RESC(); ROT();
    STEP(pA0,pA1,pB0,pB1,t+1,true,true,true);   WAIT_BAR(2); RESC(); ROT();
  }
  #undef CMASK
  #define CMASK(P0,P1,t) do{int jb_=(t)-(NT-4); if(jb_>=0)cmask(P0,P1,jb_,qrel,hi);}while(0)
  #define ENDW(tt) do{ if((tt)+3<NT){WAIT_BAR(2);} else if((tt)+2<NT){WAIT_BAR(1);} else {WAIT_BAR(0);} }while(0)
  for(;t+1<NT;t+=2){
    STEP(pB0,pB1,pA0,pA1,t,(t+3<NT),(t+1<NT),(t+1<NT));       ENDW(t);   RESC(); ROT();
    STEP(pA0,pA1,pB0,pB1,t+1,(t+4<NT),(t+2<NT),(t+2<NT));     ENDW(t+1); RESC(); ROT();
  }
  STEP(pB0,pB1,pA0,pA1,NT-1,false,false,false); RESC();
  { float sacc=pB0[0]+pB0[1]; _Pragma("unroll") for(int r=2;r<16;++r)sacc+=pB0[r]; _Pragma("unroll") for(int r=0;r<16;++r)sacc+=pB1[r]; l_reg+=sacc;
    pw0=(u32x4){PKW(pB0,0),PKW(pB0,2),PKW(pB0,4),PKW(pB0,6)};pw1=(u32x4){PKW(pB0,8),PKW(pB0,10),PKW(pB0,12),PKW(pB0,14)};pw2=(u32x4){PKW(pB1,0),PKW(pB1,2),PKW(pB1,4),PKW(pB1,6)};pw3=(u32x4){PKW(pB1,8),PKW(pB1,10),PKW(pB1,12),PKW(pB1,14)};
    SBAR(); pv(o,vb0+sl_cur,PAF(0),PAF(1),PAF(2),PAF(3)); }
  #undef PKW
  #undef PAF
  #undef VFR
  #undef PIN
  #undef MX3
  #undef GAPA
  #undef GAPB
  #undef EX
  #undef VRD
  #undef KRD
  #undef STEP
  #undef ENDW
  {auto rr=__builtin_amdgcn_permlane32_swap(__float_as_uint(l_reg),__float_as_uint(l_reg),false,false);l_reg=__uint_as_float(rr[0])+__uint_as_float(rr[1]);}
  if(hi==0)wsf[32+r32]=l_reg;asm volatile("s_waitcnt lgkmcnt(0)":::"memory");
  float rli[16];
  #pragma unroll
  for(int r=0;r<16;++r)rli[r]=__builtin_amdgcn_rcpf(wsf[32+crow(r,hi)]);
  bf16*Ow=O+(rowbase+q0+wid*QBLK)*DM+h*D;
  { bf16*stg=(bf16*)(shm+LDS_OST)+wid*2048;
    #pragma unroll
    for(int r=0;r<16;++r){const int orow=crow(r,hi);
      #pragma unroll
      for(int d0=0;d0<2;++d0)stg[orow*64+d0*32+r32]=__float2bfloat16(o[d0][r]*rli[r]);}
    asm volatile("s_waitcnt lgkmcnt(0)":::"memory");
    #pragma unroll
    for(int i=0;i<4;++i){const int row=i*8+(lane>>3),ch=lane&7; const u32x4 v=*(const u32x4*)(stg+row*64+ch*8); ATTN_STORE16(Ow+(long)row*DM+ch*8,v);} }
  asm volatile("s_waitcnt lgkmcnt(0)\n\ts_barrier":::"memory");
  #undef DMA_K
  #undef DMA_V
  #undef CMASK
  #undef START
  #undef RESC
  #undef ROT
  #undef LDBIAS
}
constexpr int ATTN_LDS_BYTES=LDS_BYTES;
#undef SBAR
#undef WAIT_BAR
}

#define GAS __attribute__((address_space(1)))
#define LAS __attribute__((address_space(3)))
typedef unsigned short bf16;
typedef unsigned v4u __attribute__((ext_vector_type(4)));
typedef float f32x4 __attribute__((ext_vector_type(4)));
typedef short bf16x8 __attribute__((ext_vector_type(8)));
typedef GAS unsigned gu32;
typedef GAS unsigned long long gu64;
#define RLX_AGENT __ATOMIC_RELAXED, __HIP_MEMORY_SCOPE_AGENT
#define LDS_WAIT() asm volatile("s_waitcnt lgkmcnt(0)" ::: "memory")
#define VM_WAIT() asm volatile("s_waitcnt vmcnt(0)" ::: "memory")
__device__ __forceinline__ unsigned long long rt() { return __builtin_amdgcn_s_memrealtime(); }
__device__ __forceinline__ unsigned f2bf(float f) { unsigned u = __builtin_bit_cast(unsigned, f); return (u + 0x7fffu + ((u >> 16) & 1u)) >> 16; }
__device__ __forceinline__ unsigned pk2(float lo, float hi) { return f2bf(lo) | (f2bf(hi) << 16); }

#define XB_TMO      128
#define XB_XCNT(j)  (256  + 64 * (j))
#define XB_XSUB(j)  (1280 + 64 * (j))
#define XB_XGEN(j)  (2304 + 64 * (j))
#define XB_TOP      3328
#define XB_TOPGEN   3392
#define XCD_BAR_WORDS 3456
#define XB_SPIN_CAP (1u << 18)

__device__ __forceinline__ unsigned xb_ld(unsigned* p)              { return __hip_atomic_load(p, __ATOMIC_RELAXED, __HIP_MEMORY_SCOPE_AGENT); }
__device__ __forceinline__ unsigned xb_add(unsigned* p, unsigned v) { return __hip_atomic_fetch_add(p, v, __ATOMIC_RELAXED, __HIP_MEMORY_SCOPE_AGENT); }
__device__ __forceinline__ unsigned xb_xcc_id() { return (unsigned)__builtin_amdgcn_s_getreg((3 << 11) | 20) & 0xFu; }
#define XB_SPIN(cond, bar) do { unsigned _sp = 0; while (cond) { __builtin_amdgcn_s_sleep(1); \
    if ((++_sp & 255u) == 0u) { if (xb_ld(&(bar)[XB_TMO])) break; if (_sp > XB_SPIN_CAP) { atomicAdd(&(bar)[XB_TMO], 1u); break; } } } } while (0)

struct XcdBarrier {
    unsigned* bar; unsigned x;
    volatile LAS unsigned* st;
};

__device__ __forceinline__ XcdBarrier xcd_barrier_post(unsigned* bar, volatile LAS unsigned* st) {
    XcdBarrier b; b.bar = bar; b.x = xb_xcc_id(); b.st = st;
    if (threadIdx.x == 0) (void)xb_add(&bar[XB_XCNT(b.x)], 1u);
    return b;
}
__device__ __forceinline__ void xcd_barrier_complete(unsigned* bar, unsigned x, unsigned& nloc, unsigned& nx) {
    const unsigned G = gridDim.x * gridDim.y * gridDim.z;
    unsigned sum, cnt, mine, sp = 0u;
    for (;;) {
        sum = 0u; cnt = 0u; mine = 0u;
#pragma unroll
        for (unsigned j = 0; j < 16; ++j) { const unsigned c = xb_ld(&bar[XB_XCNT(j)]); sum += c; cnt += (c > 0u) ? 1u : 0u; mine = (j == x) ? c : mine; }
        if (sum == G) break;
        __builtin_amdgcn_s_sleep(1);
        if ((++sp & 255u) == 0u) { if (xb_ld(&bar[XB_TMO])) break; if (sp > XB_SPIN_CAP) { atomicAdd(&bar[XB_TMO], 1u); break; } }
    }
    nloc = mine > 0u ? mine : 1u; nx = cnt > 0u ? cnt : 1u;
}

__device__ __forceinline__ void xcd_barrier(const XcdBarrier& b) {
    asm volatile("s_waitcnt vmcnt(0)" ::: "memory");
    __syncthreads();
    int tb_ = threadIdx.x; asm volatile("" : "+v"(tb_));
    if (tb_ == 0) {
        unsigned* bar = b.bar;
        __builtin_amdgcn_s_waitcnt(0);
        unsigned nloc = b.st[0], nx = b.st[1];
        if (nloc == 0u) { xcd_barrier_complete(bar, b.x, nloc, nx); b.st[0] = nloc; b.st[1] = nx; }
        const unsigned old = xb_add(&bar[XB_XSUB(b.x)], 1u);
        const unsigned gen = old / nloc;
        if (old + 1u == (gen + 1u) * nloc) {
            __builtin_amdgcn_fence(__ATOMIC_RELEASE, "agent");
            asm volatile("s_waitcnt vmcnt(0)" ::: "memory");
            const unsigned og = xb_add(&bar[XB_TOP], 1u);
            const unsigned tg = og / nx;
            if (og + 1u == (tg + 1u) * nx) xb_add(&bar[XB_TOPGEN], 1u);
            else XB_SPIN(xb_ld(&bar[XB_TOPGEN]) == tg, bar);
            __builtin_amdgcn_fence(__ATOMIC_ACQUIRE, "agent");
            xb_add(&bar[XB_XGEN(b.x)], 1u);
            asm volatile("s_waitcnt vmcnt(0)" ::: "memory");
        } else {
            XB_SPIN(xb_ld(&bar[XB_XGEN(b.x)]) == gen, bar);
            __builtin_amdgcn_fence(__ATOMIC_ACQUIRE, "agent");
            asm volatile("s_waitcnt vmcnt(0)" ::: "memory");
        }
    }
    __syncthreads();
}

constexpr int NWAVES = 8, NCU = 256;
constexpr int BATCH = 8, SEQ = 2048, D = 1024, TOK = BATCH * SEQ, DEPTH = 2, MEMLEN = 256, FF = 4096;
constexpr int N_IN = 5384, OFF_F = 1792, OFF_C = 1800, OFF_G = 2312;
constexpr float EPSF = 1e-6f, LOG2E = 1.4426950408889634f;
constexpr size_t MiB = 1u << 20;
constexpr size_t WS_CTL = 0, CTL_ZERO_BYTES = 32768;
constexpr size_t WS_SS = 1 * MiB;
constexpr size_t WS_LOGF = 2 * MiB;
constexpr size_t WS_W = 3 * MiB;
constexpr size_t OW_IN = 0, OW_G = OW_IN + (size_t)2304 * 1024 * 2, OW_A = OW_G + (size_t)3072 * 1024 * 2, OW_B = OW_A + (size_t)1024 * 256 * 2, OW_C = OW_B + (size_t)1024 * 512 * 2,
                 OW_OUT = OW_C + (size_t)1024 * 256 * 2, OW_XQ = OW_OUT + (size_t)1024 * 1024 * 2, OW_XKV = OW_XQ + (size_t)1024 * 1024 * 2, OW_XO = OW_XKV + (size_t)2048 * 1024 * 2,
                 OW_FF1 = OW_XO + (size_t)1024 * 1024 * 2, OW_FF2 = OW_FF1 + (size_t)4096 * 1024 * 2, LW = OW_FF2 + (size_t)1024 * 4096 * 2;
static_assert(LW == 40370176 && WS_W + 2 * LW <= 80 * MiB, "weight map");
constexpr size_t WS_XKV1 = 80 * MiB;
constexpr size_t WS_XB = 88 * MiB;
constexpr size_t WS_DYN = 120 * MiB;
constexpr size_t WS_Q = WS_DYN, WS_K = WS_DYN + 16 * MiB, WS_V = WS_DYN + 32 * MiB, WS_PA = WS_DYN + 48 * MiB, WS_DD = WS_DYN + 56 * MiB, WS_ZC = WS_DYN + 64 * MiB,
                 WS_SG = WS_DYN + 80 * MiB, WS_T2 = WS_DYN + 88 * MiB, WS_HM = WS_DYN + 120 * MiB, WS_XKV0 = WS_DYN + 128 * MiB;
constexpr size_t WS_MG = WS_DYN + 16 * MiB;
constexpr size_t WS_XQH = WS_DYN, WS_PP = WS_DYN + 32 * MiB, WS_XO = WS_DYN + 64 * MiB;
constexpr size_t WS_FFH = WS_DYN;
constexpr size_t WS_END = 256 * MiB;
static_assert(WS_XKV0 + 8 * MiB <= WS_END, "d_ws map");
constexpr int CW_TMO = 0, CW_CODE = 1, CW_BAR = 4096;
constexpr int RING_OFF = 0, RING_BYTES = 131072, LDSCTL_OFF = RING_BYTES, MISC_OFF = LDSCTL_OFF + 320, LDS_BYTES = 147456;

template <int CTRL> __device__ __forceinline__ float dppf(float v) { return __uint_as_float(__builtin_amdgcn_update_dpp(0u, __float_as_uint(v), CTRL, 0xf, 0xf, false)); }
__device__ __forceinline__ float wave_sum(float v) {
    v += dppf<0xB1>(v); v += dppf<0x4E>(v); v += dppf<0x141>(v); v += dppf<0x140>(v);
    v = pg8::comb16<false>(v); v = pg8::comb32<false>(v);
    return v;
}
__device__ __forceinline__ float wave_scan(float v) {
    v += dppf<0x111>(v); v += dppf<0x112>(v); v += dppf<0x114>(v); v += dppf<0x118>(v);
    v += __uint_as_float(__builtin_amdgcn_update_dpp(0u, __float_as_uint(v), 0x142, 0xa, 0xf, false));
    v += __uint_as_float(__builtin_amdgcn_update_dpp(0u, __float_as_uint(v), 0x143, 0xc, 0xf, false));
    return v;
}

struct Frame {
    LAS unsigned char* lds;
    volatile LAS unsigned* MISC;
    gu32* ctl;
    int tid, lane, wave, vcu, G;
    float* out; unsigned char* ws;
};
constexpr int PTRS_OFF = LDSCTL_OFF + 512;
__device__ __forceinline__ const float* inp(const Frame& F, int i) {
    const unsigned long long v = *(volatile LAS unsigned long long*)(F.lds + PTRS_OFF + 8 * i);
    const unsigned lo = __builtin_amdgcn_readfirstlane((unsigned)v), hi = __builtin_amdgcn_readfirstlane((unsigned)(v >> 32));
    return (const float*)(const GAS float*)(((unsigned long long)hi << 32) | lo); }
__device__ __forceinline__ bf16* wsb(const Frame& F, size_t off) { return (bf16*)(F.ws + off); }
__device__ __forceinline__ bf16* wlay(const Frame& F, int l, size_t off) { return (bf16*)(F.ws + WS_W + (size_t)l * LW + off); }

__device__ __forceinline__ void tr_item(const float* W, int ldw, int K, int scol0, bf16* WT, int drow0, const float* gain, LAS float* scr, int kb, int nb, int lane) {
    const int k0 = 64 * kb, n0 = 32 * nb;
    float vv[32];
#pragma unroll
    for (int i = 0; i < 32; ++i) vv[i] = W[(size_t)(k0 + 2 * i + (lane >> 5)) * ldw + scol0 + n0 + (lane & 31)];
    if (gain) {
#pragma unroll
        for (int i = 0; i < 32; ++i) vv[i] *= gain[k0 + 2 * i + (lane >> 5)];
    }
#pragma unroll
    for (int i = 0; i < 32; ++i) scr[(2 * i + (lane >> 5)) * 33 + (lane & 31)] = vv[i];
    LDS_WAIT(); asm volatile("" ::: "memory");
    const int c = lane & 7;
#pragma unroll
    for (int j = 0; j < 4; ++j) { const int n = (lane >> 3) + 8 * j; const LAS float* s = scr + (8 * c) * 33 + n;
        v4u o; o.x = pk2(s[0 * 33], s[1 * 33]); o.y = pk2(s[2 * 33], s[3 * 33]); o.z = pk2(s[4 * 33], s[5 * 33]); o.w = pk2(s[6 * 33], s[7 * 33]);
        *(GAS v4u*)(WT + (size_t)(drow0 + n0 + n) * K + k0 + 8 * c) = o; }
    LDS_WAIT(); asm volatile("" ::: "memory");
}
constexpr int I_IN1 = 16 * 56, I_IN2 = 16 * 16, I_G = 16 * 96, I_B = 8 * 32, I_C = 4 * 32, I_OUT = 16 * 32, I_XQ = 16 * 32, I_XKV = 16 * 64, I_XO = 16 * 32, I_FF1 = 16 * 128, I_FF2 = 64 * 32;
constexpr int I_LAYER = I_IN1 + I_IN2 + I_G + I_B + I_C + I_OUT + I_XQ + I_XKV + I_XO + I_FF1 + I_FF2;

__device__ __forceinline__ void p0_prologue(Frame& F) {
    LAS float* scr = (LAS float*)(F.lds + RING_OFF + F.wave * 16384);
    const int gw = F.vcu * NWAVES + F.wave, NGW = F.G * NWAVES, lane = F.lane;
    for (int it = gw; it < DEPTH * I_LAYER; it += NGW) {
        const int l = it / I_LAYER; int r = it % I_LAYER;
        const float* w_in = inp(F, 3) + (size_t)l * D * N_IN;
        if (r < I_IN1) { tr_item(w_in, N_IN, D, 0, wlay(F, l, OW_IN), 0, inp(F, 2) + l * D, scr, r / 56, r % 56, lane); continue; } r -= I_IN1;
        if (r < I_IN2) { tr_item(w_in, N_IN, D, OFF_C, wlay(F, l, OW_IN), 1792, inp(F, 2) + l * D, scr, r / 16, r % 16, lane); continue; } r -= I_IN2;
        if (r < I_G) { tr_item(w_in, N_IN, D, OFF_G, wlay(F, l, OW_G), 0, inp(F, 2) + l * D, scr, r / 96, r % 96, lane); continue; } r -= I_G;
        if (r < I_B) { tr_item(inp(F, 11) + (size_t)l * 512 * D, D, 512, 0, wlay(F, l, OW_B), 0, nullptr, scr, r / 32, r % 32, lane); continue; } r -= I_B;
        if (r < I_C) { tr_item(inp(F, 12) + (size_t)l * 256 * D, D, 256, 0, wlay(F, l, OW_C), 0, nullptr, scr, r / 32, r % 32, lane); continue; } r -= I_C;
        if (r < I_OUT) { tr_item(inp(F, 14) + (size_t)l * D * D, D, D, 0, wlay(F, l, OW_OUT), 0, nullptr, scr, r / 32, r % 32, lane); continue; } r -= I_OUT;
        if (r < I_XQ) { tr_item(inp(F, 17) + (size_t)l * D * D, D, D, 0, wlay(F, l, OW_XQ), 0, inp(F, 15) + l * D, scr, r / 32, r % 32, lane); continue; } r -= I_XQ;
        if (r < I_XKV) { tr_item(inp(F, 18) + (size_t)l * D * 2 * D, 2 * D, D, 0, wlay(F, l, OW_XKV), 0, nullptr, scr, r / 64, r % 64, lane); continue; } r -= I_XKV;
        if (r < I_XO) { tr_item(inp(F, 19) + (size_t)l * D * D, D, D, 0, wlay(F, l, OW_XO), 0, nullptr, scr, r / 32, r % 32, lane); continue; } r -= I_XO;
        if (r < I_FF1) { tr_item(inp(F, 21) + (size_t)l * D * FF, FF, D, 0, wlay(F, l, OW_FF1), 0, inp(F, 20) + l * D, scr, r / 128, r % 128, lane); continue; } r -= I_FF1;
        tr_item(inp(F, 22) + (size_t)l * FF * D, D, FF, 0, wlay(F, l, OW_FF2), 0, nullptr, scr, r / 32, r % 32, lane);
    }
    for (int it = gw; it < DEPTH * 256 * 16; it += NGW) {
        const int l = it / 4096, r = it % 4096, cp = r / 16, n = (r % 16) * 64 + lane, g = cp >> 6;
        const float* pw = inp(F, 5) + ((size_t)l * 256 + cp) * 64; const float* ps = inp(F, 6) + l * 256 + g * 64; const float* wa = inp(F, 10) + ((size_t)l * 256 + g * 64) * D + n;
        float a = 0.f;
#pragma unroll 8
        for (int d = 0; d < 64; ++d) a += pw[d] * ps[d] * wa[(size_t)d * D];
        wlay(F, l, OW_A)[(size_t)n * 256 + cp] = (bf16)f2bf(a);
    }
    for (int it = gw; it < DEPTH * BATCH * MEMLEN; it += NGW) {
        const int l = it / (BATCH * MEMLEN), m = it % (BATCH * MEMLEN);
        const GAS f32x4* xr = (const GAS f32x4*)(inp(F, 1) + (size_t)m * D) + lane; const GAS f32x4* gr = (const GAS f32x4*)(inp(F, 16) + l * D) + lane;
        f32x4 v[4]; float s = 0.f;
#pragma unroll
        for (int j = 0; j < 4; ++j) { v[j] = xr[64 * j]; s += (v[j].x * v[j].x + v[j].y * v[j].y) + (v[j].z * v[j].z + v[j].w * v[j].w); }
        const float rstd = 1.0f / sqrtf(wave_sum(s) * (1.f / D) + EPSF);
        GAS unsigned long long* o8 = (GAS unsigned long long*)(wsb(F, WS_HM) + ((size_t)l * BATCH * MEMLEN + m) * D) + lane;
#pragma unroll
        for (int j = 0; j < 4; ++j) { const f32x4 g = gr[64 * j]; o8[64 * j] = (unsigned long long)pk2(v[j].x * rstd * g.x, v[j].y * rstd * g.y) | ((unsigned long long)pk2(v[j].z * rstd * g.z, v[j].w * rstd * g.w) << 32); }
    }
    for (int m = gw; m < TOK; m += NGW) {
        const GAS f32x4* xr = (const GAS f32x4*)(inp(F, 0) + (size_t)m * D) + lane;
        f32x4 v[4]; float s = 0.f;
#pragma unroll
        for (int j = 0; j < 4; ++j) { v[j] = xr[64 * j]; s += (v[j].x * v[j].x + v[j].y * v[j].y) + (v[j].z * v[j].z + v[j].w * v[j].w); }
        s = wave_sum(s);
        GAS unsigned long long* o8 = (GAS unsigned long long*)(wsb(F, WS_XB) + (size_t)m * D) + lane;
#pragma unroll
        for (int j = 0; j < 4; ++j) o8[64 * j] = (unsigned long long)pk2(v[j].x, v[j].y) | ((unsigned long long)pk2(v[j].z, v[j].w) << 32);
        if (lane < 16) ((float*)(F.ws + WS_SS))[(size_t)m * 16 + lane] = lane == 0 ? s : 0.f;
    }
}

__device__ __forceinline__ float row_rstd(const Frame& F, int row) {
    const f32x4* p = (const f32x4*)((const float*)(F.ws + WS_SS) + (size_t)row * 16);
    const f32x4 a = p[0], b = p[1], c = p[2], d = p[3];
    const float s = ((a[0] + a[1]) + (a[2] + a[3])) + ((b[0] + b[1]) + (b[2] + b[3])) + ((c[0] + c[1]) + (c[2] + c[3])) + ((d[0] + d[1]) + (d[2] + d[3]));
    return 1.0f / sqrtf(s * (1.f / D) + EPSF);
}

__device__ __forceinline__ void logf_pass(Frame& F, int l) {
    const int gw = F.vcu * NWAVES + F.wave, NGW = F.G * NWAVES, lane = F.lane;
    LAS float* WF = (LAS float*)(F.lds + RING_OFF);
    {
        const float* w_in = inp(F, 3) + (size_t)l * D * N_IN; const float* g = inp(F, 2) + l * D;
#pragma unroll
        for (int i = 0; i < 2; ++i) { const int k = F.tid + 512 * i; const float gk = g[k]; const float* p = w_in + (size_t)k * N_IN + OFF_F;
            const f32x4 a = *(const f32x4*)p * gk, b = *(const f32x4*)(p + 4) * gk;
            LAS f32x4* dst = (LAS f32x4*)(WF + (k >> 4) * 132 + (k & 15) * 8); dst[0] = a; dst[1] = b; }
    }
    LDS_WAIT(); __syncthreads();
    const float bfl = (lane < 8) ? (inp(F, 4) + l * 8)[lane] : 0.f;
    float* LOGF = (float*)(F.ws + WS_LOGF);
    const LAS f32x4* wl = (const LAS f32x4*)(WF + lane * 132);
    for (int m = gw; m < TOK; m += NGW) {
        const v4u* xp = (const v4u*)(wsb(F, WS_XB) + (size_t)m * D + 16 * lane);
        const v4u x0 = xp[0], x1 = xp[1];
        float xv[16];
        xv[0] = __uint_as_float(x0.x << 16); xv[1] = __uint_as_float(x0.x & 0xffff0000u); xv[2] = __uint_as_float(x0.y << 16); xv[3] = __uint_as_float(x0.y & 0xffff0000u);
        xv[4] = __uint_as_float(x0.z << 16); xv[5] = __uint_as_float(x0.z & 0xffff0000u); xv[6] = __uint_as_float(x0.w << 16); xv[7] = __uint_as_float(x0.w & 0xffff0000u);
        xv[8] = __uint_as_float(x1.x << 16); xv[9] = __uint_as_float(x1.x & 0xffff0000u); xv[10] = __uint_as_float(x1.y << 16); xv[11] = __uint_as_float(x1.y & 0xffff0000u);
        xv[12] = __uint_as_float(x1.z << 16); xv[13] = __uint_as_float(x1.z & 0xffff0000u); xv[14] = __uint_as_float(x1.w << 16); xv[15] = __uint_as_float(x1.w & 0xffff0000u);
        f32x4 a0 = (f32x4){0.f, 0.f, 0.f, 0.f}, a1 = a0;
#pragma unroll
        for (int j = 0; j < 16; ++j) { a0 += wl[2 * j] * xv[j]; a1 += wl[2 * j + 1] * xv[j]; }
        float d[8] = {a0[0], a0[1], a0[2], a0[3], a1[0], a1[1], a1[2], a1[3]};
#pragma unroll
        for (int h = 0; h < 8; ++h) d[h] = wave_sum(d[h]);
        const float rstd = row_rstd(F, m);
        if (lane < 8) {
            float dv = d[0];
#pragma unroll
            for (int h = 1; h < 8; ++h) dv = (lane == h) ? d[h] : dv;
            const float z = dv * rstd + bfl;
            const float ls = fminf(z, 0.f) - 0.6931471805599453f * __builtin_amdgcn_logf(1.0f + __builtin_amdgcn_exp2f(-LOG2E * fabsf(z)));
            LOGF[((size_t)(m / SEQ) * 8 + lane) * SEQ + (m % SEQ)] = ls;
        }
    }
    LDS_WAIT(); __syncthreads();
}

__device__ __forceinline__ void cumsum_bias(Frame& F, int bh, LAS float* nb, LAS float* scr) {
    const f32x4 v = *((const f32x4*)((const float*)(F.ws + WS_LOGF) + (size_t)bh * SEQ) + F.tid);
    const float p0 = v[0], p1 = p0 + v[1], p2 = p1 + v[2], p3 = p2 + v[3];
    const float incl = wave_scan(p3);
    if (F.lane == 63) scr[F.wave] = incl;
    LDS_WAIT(); __syncthreads();
    float woff = 0.f;
#pragma unroll
    for (int w = 0; w < 8; ++w) woff += (w < F.wave) ? scr[w] : 0.f;
    const float base = woff + (incl - p3);
    *((LAS f32x4*)nb + F.tid) = (f32x4){-(base + p0) * LOG2E, -(base + p1) * LOG2E, -(base + p2) * LOG2E, -(base + p3) * LOG2E};
    LDS_WAIT(); __syncthreads();
}

__device__ __forceinline__ void pool_diff(Frame& F) {
    const bf16* PA = wsb(F, WS_PA); bf16* DD = wsb(F, WS_DD);
    const int ch = F.tid & 31, seg = F.tid >> 5, g = ch >> 3, win = 2 << g, r0 = 64 * F.vcu + 4 * seg, tl0 = r0 & (SEQ - 1);
    v4u a[19];
#pragma unroll
    for (int i = 0; i < 19; ++i) { const int dt = i - 15;
        a[i] = (tl0 + dt >= 0) ? *(const v4u*)(PA + (size_t)(r0 + dt) * 256 + 8 * ch) : (v4u){0u, 0u, 0u, 0u}; }
    float s[8] = {0.f, 0.f, 0.f, 0.f, 0.f, 0.f, 0.f, 0.f};
#define PD_ACC(W, SG) do { s[0] += SG __uint_as_float((W).x << 16); s[1] += SG __uint_as_float((W).x & 0xffff0000u); s[2] += SG __uint_as_float((W).y << 16); s[3] += SG __uint_as_float((W).y & 0xffff0000u); \
        s[4] += SG __uint_as_float((W).z << 16); s[5] += SG __uint_as_float((W).z & 0xffff0000u); s[6] += SG __uint_as_float((W).w << 16); s[7] += SG __uint_as_float((W).w & 0xffff0000u); } while (0)
#pragma unroll
    for (int k = 0; k < 16; ++k) if (k < win) PD_ACC(a[15 - k], +);
#pragma unroll
    for (int o = 0; o < 4; ++o) {
        if (o > 0) { PD_ACC(a[15 + o], +);
            const v4u old = (g == 0) ? a[13 + o] : (g == 1) ? a[11 + o] : (g == 2) ? a[7 + o] : a[o - 1]; PD_ACC(old, -); }
        const int tl = tl0 + o; const float inv = 1.0f / (float)((tl + 1 < win) ? tl + 1 : win);
        const v4u cur = a[15 + o]; v4u w;
        w.x = pk2(s[0] * inv - __uint_as_float(cur.x << 16), s[1] * inv - __uint_as_float(cur.x & 0xffff0000u));
        w.y = pk2(s[2] * inv - __uint_as_float(cur.y << 16), s[3] * inv - __uint_as_float(cur.y & 0xffff0000u));
        w.z = pk2(s[4] * inv - __uint_as_float(cur.z << 16), s[5] * inv - __uint_as_float(cur.z & 0xffff0000u));
        w.w = pk2(s[6] * inv - __uint_as_float(cur.w << 16), s[7] * inv - __uint_as_float(cur.w & 0xffff0000u));
        *(v4u*)(DD + (size_t)(r0 + o) * 256 + 8 * ch) = w;
    }
#undef PD_ACC
}

__device__ __forceinline__ void sgu_unit(Frame& F, int l, int unit) {
    const int chunk = unit >> 2, g = unit & 3, row0 = chunk * 128, lane = F.lane, w = F.wave;
    const bf16* ZC = wsb(F, WS_ZC); bf16* SG = wsb(F, WS_SG);
    LAS bf16* vnT = (LAS bf16*)(F.lds + RING_OFF);
    const float* gain = inp(F, 7) + l * 256;
    const float g0 = gain[4 * lane], g1 = gain[4 * lane + 1], g2 = gain[4 * lane + 2], g3 = gain[4 * lane + 3];
    unsigned long long qv[16];
#pragma unroll
    for (int i = 0; i < 16; ++i) qv[i] = *(const unsigned long long*)(ZC + (size_t)(row0 + 16 * w + i) * 512 + 256 + 4 * lane);
#pragma unroll
    for (int i = 0; i < 16; ++i) {
        const int s = 16 * w + i;
        const unsigned long long q = qv[i];
        const unsigned lo = (unsigned)q, hi = (unsigned)(q >> 32);
        const float v0 = __uint_as_float(lo << 16), v1 = __uint_as_float(lo & 0xffff0000u), v2 = __uint_as_float(hi << 16), v3 = __uint_as_float(hi & 0xffff0000u);
        const float ss = wave_sum((v0 * v0 + v1 * v1) + (v2 * v2 + v3 * v3));
        const float r = 1.0f / sqrtf(ss * (1.f / 256.f) + EPSF);
        if ((lane >> 4) == g) { const int d = 4 * (lane & 15);
            vnT[(d + 0) * 136 + s] = (bf16)f2bf(v0 * r * g0); vnT[(d + 1) * 136 + s] = (bf16)f2bf(v1 * r * g1); vnT[(d + 2) * 136 + s] = (bf16)f2bf(v2 * r * g2); vnT[(d + 3) * 136 + s] = (bf16)f2bf(v3 * r * g3); }
    }
    LDS_WAIT(); __syncthreads();
    const float* Wg = inp(F, 8) + ((size_t)(l * 4 + g) * 128) * 128;
    const int t = 16 * w + (lane & 15), kq = lane >> 4;
    f32x4 acc[4];
#pragma unroll
    for (int n = 0; n < 4; ++n) acc[n] = (f32x4){0.f, 0.f, 0.f, 0.f};
#pragma unroll
    for (int kk = 0; kk < 4; ++kk) {
        if (32 * kk <= 16 * w + 15) {
            const int s0 = 32 * kk + 8 * kq;
            const f32x4 wa = *(const f32x4*)(Wg + (size_t)t * 128 + s0), wb = *(const f32x4*)(Wg + (size_t)t * 128 + s0 + 4);
            float wv[8] = {wa[0], wa[1], wa[2], wa[3], wb[0], wb[1], wb[2], wb[3]};
#pragma unroll
            for (int j = 0; j < 8; ++j) wv[j] = (s0 + j <= t) ? wv[j] : 0.f;
            v4u bw; bw.x = pk2(wv[0], wv[1]); bw.y = pk2(wv[2], wv[3]); bw.z = pk2(wv[4], wv[5]); bw.w = pk2(wv[6], wv[7]);
            const bf16x8 bfrag = __builtin_bit_cast(bf16x8, bw);
#pragma unroll
            for (int n = 0; n < 4; ++n) { const bf16x8 afrag = *(const LAS bf16x8*)(vnT + (16 * n + (lane & 15)) * 136 + s0);
                acc[n] = __builtin_amdgcn_mfma_f32_16x16x32_bf16(afrag, bfrag, acc[n], 0, 0, 0); }
        }
    }
    const float bt = inp(F, 9)[(l * 4 + g) * 128 + t];
#pragma unroll
    for (int n = 0; n < 4; ++n) { const int d = 64 * g + 16 * n + 4 * kq;
        const unsigned long long q = *(const unsigned long long*)(ZC + (size_t)(row0 + t) * 512 + d);
        const unsigned lo = (unsigned)q, hi = (unsigned)(q >> 32);
        const float o0 = __uint_as_float(lo << 16) * (acc[n][0] + bt), o1 = __uint_as_float(lo & 0xffff0000u) * (acc[n][1] + bt), o2 = __uint_as_float(hi << 16) * (acc[n][2] + bt), o3 = __uint_as_float(hi & 0xffff0000u) * (acc[n][3] + bt);
        *(unsigned long long*)(SG + (size_t)(row0 + t) * 256 + d) = (unsigned long long)pk2(o0, o1) | ((unsigned long long)pk2(o2, o3) << 32); }
    LDS_WAIT(); __syncthreads();
}

__device__ __forceinline__ void final_norm(Frame& F) {
    const int gw = F.vcu * NWAVES + F.wave, NGW = F.G * NWAVES, lane = F.lane;
    const GAS f32x4* gr = (const GAS f32x4*)inp(F, 23) + lane;
    for (int m = gw; m < TOK; m += NGW) {
        const float rstd = row_rstd(F, m);
        GAS f32x4* xr = (GAS f32x4*)(F.out + (size_t)m * D) + lane;
#pragma unroll
        for (int j = 0; j < 4; ++j) { const f32x4 v = xr[64 * j]; xr[64 * j] = v * rstd * gr[64 * j]; }
    }
}

struct Args { const float* in[24]; float* out; unsigned char* ws; };
__global__ void __launch_bounds__(NWAVES * 64, 2) mega_fwd(Args args) {
    extern __shared__ __attribute__((aligned(16))) unsigned char lds[];
    Frame F;
    F.lds = (LAS unsigned char*)lds;
    F.MISC = (volatile LAS unsigned*)(F.lds + MISC_OFF);
    int c = 0;
#define REFRESH() do { int t_ = threadIdx.x, b_ = blockIdx.x; asm volatile("" : "+v"(t_)); asm volatile("" : "+s"(b_)); F.tid = t_; F.lane = t_ & 63; F.wave = __builtin_amdgcn_readfirstlane(t_ >> 6); \
        F.G = NCU; F.vcu = (b_ % 8) * (NCU / 8) + b_ / 8; c = b_; \
        unsigned lb_ = (unsigned)(uintptr_t)(LAS unsigned char*)lds; asm volatile("" : "+s"(lb_)); F.lds = (LAS unsigned char*)(uintptr_t)lb_; F.MISC = (volatile LAS unsigned*)(F.lds + MISC_OFF); } while (0)
    REFRESH();
    F.ws = args.ws; F.out = args.out; F.ctl = (gu32*)(args.ws + WS_CTL);
    for (int u = F.tid; u < (LDS_BYTES - LDSCTL_OFF) / 4; u += NWAVES * 64) ((LAS unsigned*)(F.lds + LDSCTL_OFF))[u] = 0u;
    __syncthreads();
    if (F.tid < 24) *(LAS unsigned long long*)(F.lds + PTRS_OFF + 8 * F.tid) = (unsigned long long)args.in[F.tid];
    LDS_WAIT(); __syncthreads();
    (void)xcd_barrier_post((unsigned*)(F.ctl + CW_BAR), F.MISC + 8);
#define GRID_BAR() do { XcdBarrier b_; b_.bar = (unsigned*)(F.ws + WS_CTL) + CW_BAR; b_.x = xb_xcc_id(); asm volatile("" : "+s"(b_.x)); b_.st = F.MISC + 8; REP(9) xcd_barrier(b_); } while (0)
    float* SS = (float*)(F.ws + WS_SS);

#ifndef PROBE
#define PROBE 0
#endif
#define REP(n) for (int rep_ = 0; rep_ < ((PROBE == (n)) ? 2 : 1); ++rep_)
    REP(1) p0_prologue(F);
    GRID_BAR();
    for (int l = 0; l < DEPTH; ++l) {
        REFRESH();
        REP(2) logf_pass(F, l);
        REP(3)
        { pg8::GemmProj g{wsb(F, WS_XB), wlay(F, l, OW_IN), wsb(F, WS_HM), wlay(F, 0, OW_XKV), LW / 2, D, D, D};
          pg8::StaticOrder S; S.init(TOK, l == 0 ? 11 * 256 : 9 * 256, F.G, c);
          pg8::EpiProj E{wsb(F, WS_PA), wsb(F, WS_Q), wsb(F, WS_K), wsb(F, WS_V), wsb(F, WS_ZC), SS, attn_body::C2, wsb(F, WS_XKV0), wsb(F, WS_XKV1)};
          pg8::gemm_phase<pg8::EpiProj, pg8::StaticOrder, pg8::GemmProj, true, true>(F.lds + RING_OFF, g, S, E); }
        GRID_BAR();
        REFRESH();
        {
            const int bh = F.vcu >> 2, s4 = F.vcu & 3;
            LAS float* nb = (LAS float*)(F.lds + RING_OFF + attn_body::LDS_NB);
            cumsum_bias(F, bh, nb, (LAS float*)(F.lds + RING_OFF + attn_body::LDS_NB + 8192));
#if PROBE == 4
            attn_body::attn_unit<8>(bh >> 3, bh & 7, 7 - s4, (const attn_body::bf16*)wsb(F, WS_Q), (const attn_body::bf16*)wsb(F, WS_K), (const attn_body::bf16*)wsb(F, WS_V), (attn_body::bf16*)wsb(F, WS_T2), (char*)F.lds + RING_OFF);
            attn_body::attn_unit<8>(bh >> 3, bh & 7, s4, (const attn_body::bf16*)wsb(F, WS_Q), (const attn_body::bf16*)wsb(F, WS_K), (const attn_body::bf16*)wsb(F, WS_V), (attn_body::bf16*)wsb(F, WS_T2), (char*)F.lds + RING_OFF);
#endif
            attn_body::attn_unit<8>(bh >> 3, bh & 7, 7 - s4, (const attn_body::bf16*)wsb(F, WS_Q), (const attn_body::bf16*)wsb(F, WS_K), (const attn_body::bf16*)wsb(F, WS_V), (attn_body::bf16*)wsb(F, WS_Q), (char*)F.lds + RING_OFF);
            attn_body::attn_unit<8>(bh >> 3, bh & 7, s4, (const attn_body::bf16*)wsb(F, WS_Q), (const attn_body::bf16*)wsb(F, WS_K), (const attn_body::bf16*)wsb(F, WS_V), (attn_body::bf16*)wsb(F, WS_Q), (char*)F.lds + RING_OFF);
            REP(5) { pool_diff(F); sgu_unit(F, l, 2 * F.vcu); sgu_unit(F, l, 2 * F.vcu + 1); }
        }
        GRID_BAR();
        REFRESH();
        REP(6) {
            pg8::StaticOrder S; S.init(TOK, D, F.G, c);
            const float* bg = inp(F, 13) + (size_t)l * 3 * D;
            { pg8::GemmP g{wsb(F, WS_DD), wlay(F, l, OW_A), 256, 256, 256}; pg8::EpiStore<0, false, false> E{wsb(F, WS_T2), D, nullptr, 1.f};
              pg8::gemm_phase<pg8::EpiStore<0, false, false>, pg8::StaticOrder, pg8::GemmP, true, true>(F.lds + RING_OFF, g, S, E); }
            { pg8::GemmP g{wsb(F, WS_XB), wlay(F, l, OW_G), D, D, D}; pg8::EpiGate<true> E{wsb(F, WS_T2), wsb(F, WS_MG), bg, SS};
              pg8::gemm_phase<pg8::EpiGate<true>, pg8::StaticOrder, pg8::GemmP, true, true>(F.lds + RING_OFF, g, S, E); }
            { pg8::GemmP g{wsb(F, WS_Q), wlay(F, l, OW_B), 512, 512, 512}; pg8::EpiStore<0, false, false> E{wsb(F, WS_T2), D, nullptr, 1.f};
              pg8::gemm_phase<pg8::EpiStore<0, false, false>, pg8::StaticOrder, pg8::GemmP, true, true>(F.lds + RING_OFF, g, S, E); }
            { pg8::GemmP g{wsb(F, WS_XB), wlay(F, l, OW_G) + (size_t)D * D, D, D, D}; pg8::EpiGate<false> E{wsb(F, WS_T2), wsb(F, WS_MG), bg + D, SS};
              pg8::gemm_phase<pg8::EpiGate<false>, pg8::StaticOrder, pg8::GemmP, true, true>(F.lds + RING_OFF, g, S, E); }
            { pg8::GemmP g{wsb(F, WS_SG), wlay(F, l, OW_C), 256, 256, 256}; pg8::EpiStore<0, false, false> E{wsb(F, WS_T2), D, nullptr, 1.f};
              pg8::gemm_phase<pg8::EpiStore<0, false, false>, pg8::StaticOrder, pg8::GemmP, true, true>(F.lds + RING_OFF, g, S, E); }
            { pg8::GemmP g{wsb(F, WS_XB), wlay(F, l, OW_G) + (size_t)2 * D * D, D, D, D}; pg8::EpiGate<false> E{wsb(F, WS_T2), wsb(F, WS_MG), bg + 2 * D, SS};
              pg8::gemm_phase<pg8::EpiGate<false>, pg8::StaticOrder, pg8::GemmP, true, true>(F.lds + RING_OFF, g, S, E); }
        }
        GRID_BAR();
        REFRESH();
        { pg8::GemmP g{wsb(F, WS_MG), wlay(F, l, OW_OUT), D, D, D}; pg8::StaticOrder S; S.init(TOK, D, F.G, c); pg8::EpiRes E{wsb(F, WS_XB), nullptr, SS};
          pg8::gemm_phase<pg8::EpiRes, pg8::StaticOrder, pg8::GemmP, true, true>(F.lds + RING_OFF, g, S, E); }
        GRID_BAR();
        REFRESH();
        REP(7) {
            pg8::StaticOrder S; S.init(TOK, D, F.G, c);
            const bf16* xk = wsb(F, l == 0 ? WS_XKV0 : WS_XKV1); const bf16* xvt = xk + (size_t)BATCH * 4 * 65536;
            { pg8::GemmP g{wsb(F, WS_XB), wlay(F, l, OW_XQ), D, D, D}; pg8::EpiStore<0, true, true> E{wsb(F, WS_XQH), 256, SS, 0.0625f * LOG2E};
              pg8::gemm_phase<pg8::EpiStore<0, true, true>, pg8::StaticOrder, pg8::GemmP, true, true>(F.lds + RING_OFF, g, S, E); }
            { pg8::GemmX g{wsb(F, WS_XQH), xk, 256, 256, 256}; pg8::EpiSoftmax E{wsb(F, WS_PP)};
              pg8::gemm_phase<pg8::EpiSoftmax, pg8::StaticOrder, pg8::GemmX, false, true>(F.lds + RING_OFF, g, S, E); }
            { pg8::GemmX g{wsb(F, WS_PP), xvt, 256, 256, 256}; pg8::EpiStore<0, false, false> E{wsb(F, WS_XO), D, nullptr, 1.f};
              pg8::gemm_phase<pg8::EpiStore<0, false, false>, pg8::StaticOrder, pg8::GemmX, true, true>(F.lds + RING_OFF, g, S, E); }
        }
        GRID_BAR();
        REFRESH();
        { pg8::GemmP g{wsb(F, WS_XO), wlay(F, l, OW_XO), D, D, D}; pg8::StaticOrder S; S.init(TOK, D, F.G, c); pg8::EpiRes E{wsb(F, WS_XB), nullptr, SS};
          pg8::gemm_phase<pg8::EpiRes, pg8::StaticOrder, pg8::GemmP, true, true>(F.lds + RING_OFF, g, S, E); }
        GRID_BAR();
        REFRESH();
#if PROBE == 10
        { pg8::GemmP g{wsb(F, WS_XB), wlay(F, l, OW_FF1), D, D, D}; pg8::StaticOrder S; S.init(TOK, FF, F.G, c); pg8::EpiNop E{};
          pg8::gemm_phase<pg8::EpiNop, pg8::StaticOrder, pg8::GemmP, true, true>(F.lds + RING_OFF, g, S, E); }
#endif
        REP(8) { pg8::GemmP g{wsb(F, WS_XB), wlay(F, l, OW_FF1), D, D, D}; pg8::StaticOrder S; S.init(TOK, FF, F.G, c); pg8::EpiStore<1, true, false> E{wsb(F, WS_FFH), FF, SS, 1.f};
          pg8::gemm_phase<pg8::EpiStore<1, true, false>, pg8::StaticOrder, pg8::GemmP, true, true>(F.lds + RING_OFF, g, S, E); }
        GRID_BAR();
        REFRESH();
        { pg8::GemmP g{wsb(F, WS_FFH), wlay(F, l, OW_FF2), FF, FF, FF}; pg8::StaticOrder S; S.init(TOK, D, F.G, c); pg8::EpiRes E{wsb(F, WS_XB), (l == DEPTH - 1) ? F.out : nullptr, SS};
          pg8::gemm_phase<pg8::EpiRes, pg8::StaticOrder, pg8::GemmP, true, true>(F.lds + RING_OFF, g, S, E); }
        GRID_BAR();
    }
    REFRESH();
    final_norm(F);
    if (__hip_atomic_load((gu32*)((unsigned*)(F.ctl + CW_BAR) + XB_TMO), RLX_AGENT) != 0u && blockIdx.x == 0 && F.tid < 64) F.out[F.tid] = __builtin_nanf("");
}

extern "C" void kernel_launch(void* const* d_in, const int* in_sizes, int n_in, void* d_out, int out_size, void* d_ws, size_t ws_size, hipStream_t stream) {
    static int grid = 0;
    if (grid == 0) {
        if (n_in != 24 || out_size != TOK * D || ws_size < WS_END) { fprintf(stderr, "kernel_launch: unexpected problem shape (n_in %d, out %d, ws %zu); nothing launched\n", n_in, out_size, ws_size); grid = -1; return; }
        int dev = 0, cus = 0;
        if (hipGetDevice(&dev) != hipSuccess || hipDeviceGetAttribute(&cus, hipDeviceAttributeMultiprocessorCount, dev) != hipSuccess) { grid = -1; return; }
        if (hipFuncSetAttribute((const void*)mega_fwd, hipFuncAttributeMaxDynamicSharedMemorySize, LDS_BYTES) != hipSuccess) { fprintf(stderr, "kernel_launch: hipFuncSetAttribute failed\n"); grid = -1; return; }
        int per_cu = 0;
        if (hipOccupancyMaxActiveBlocksPerMultiprocessor(&per_cu, (const void*)mega_fwd, NWAVES * 64, LDS_BYTES) != hipSuccess || per_cu < 1) fprintf(stderr, "kernel_launch: occupancy query reports %d workgroups per CU\n", per_cu);
        (void)hipGetLastError();
        if (cus != 256) fprintf(stderr, "kernel_launch: built for a 256-CU device, found %d CUs\n", cus);
        grid = NCU;
    }
    if (grid < 0) return;
    (void)in_sizes;
    if (hipMemsetAsync((char*)d_ws + WS_CTL, 0, CTL_ZERO_BYTES, stream) != hipSuccess) return;
    Args a{};
    for (int i = 0; i < 24; ++i) a.in[i] = (const float*)d_in[i];
    a.out = (float*)d_out; a.ws = (unsigned char*)d_ws;
    hipLaunchKernelGGL(mega_fwd, dim3(grid), dim3(NWAVES * 64), LDS_BYTES, stream, a);
}
```

```cpp
#include <hip/hip_runtime.h>
#include <cstdio>
#include <cstdint>
namespace pg8 {
#define PG8_LAS __attribute__((address_space(3)))
typedef unsigned short bf16_t;
typedef short bf16x8 __attribute__((ext_vector_type(8)));
typedef float f32x4 __attribute__((ext_vector_type(4)));
typedef unsigned u32x4 __attribute__((ext_vector_type(4)));
constexpr int BM = 256, BK = 64, HALF = 128, HTB = HALF * BK * 2  , STAGE_BYTES = 8 * HTB, NXCD = 8, WGM = 8;

__host__ __device__ __forceinline__ int lds_byte(int r, int c) { const int st = (r >> 4) * 2 + (c >> 5), rr = r & 15, cc = c & 31, ob = rr * 64 + cc * 2; return st * 1024 + (ob ^ (((ob >> 9) & 1) << 5)); }
__host__ __device__ __forceinline__ void stage_rc(int b, int& R, int& C) { const int st = b / 1024, sb = b % 1024, swz = sb ^ (((sb >> 9) & 1) << 5); R = (st >> 1) * 16 + swz / 64; C = (st & 1) * 32 + (swz % 64) / 2; }
__host__ __device__ __forceinline__ int perm32(int rho) { const int n = rho >> 4, i = rho & 15; return 8 * (i >> 2) + 4 * n + (i & 3); }

struct Unit { int pm, pn; };

struct StaticOrder {
    int nM, nN, nwg, G, c;
    __host__ __device__ __forceinline__ void init(int M, int N, int G_, int c_) { nM = M / BM; nN = N / BM; nwg = nM * nN; G = G_; c = c_; }
    __host__ __device__ __forceinline__ bool next(int i, Unit& u) const {
        const long L = (long)i * G + c; if (L >= nwg) return false;
        int wgid = (int)L; { const int q = nwg / NXCD, r = nwg % NXCD, xcd = wgid % NXCD, off = wgid / NXCD; wgid = (xcd < r ? xcd * (q + 1) : r * (q + 1) + (xcd - r) * q) + off; }
        const int nig = WGM * nN, gid = wgid / nig, fm = gid * WGM, gsz = (nM - fm) < WGM ? (nM - fm) : WGM;
        u.pm = fm + ((wgid % nig) % gsz); u.pn = (wgid % nig) / gsz; return true;
    }
    __device__ __forceinline__ void a_ready(const Unit&) const {}
    __device__ __forceinline__ void done(const Unit&) const {}
};
__device__ __forceinline__ unsigned cvt_pk_bf16(float lo, float hi) { unsigned r; asm volatile("v_cvt_pk_bf16_f32 %0, %1, %2" : "=v"(r) : "v"(lo), "v"(hi)); return r; }
template <class Epi, class Sched, class G, bool ALIGN_EPI = false, bool SP2 = false>
__device__ __forceinline__ void gemm_phase(PG8_LAS unsigned char* lds, const G g, const Sched& S, const Epi& E) {
    int tid_ = threadIdx.x; asm volatile("" : "+v"(tid_));
    const int tid = tid_, wid = __builtin_amdgcn_readfirstlane(tid >> 6), lane = tid & 63, wr = wid >> 2, wc = wid & 3, fr = lane & 15, fq = lane >> 4;
    Unit cur, nxt; int ui = 0;
    if (!S.next(0, cur)) return;
    const int lda_ = g.lda_of(cur), ldb_ = g.ldb_of(cur);
    const int K = g.K, nt = K / BK;
    unsigned voffA[2], voffB[2];
#pragma unroll
    for (int i = 0; i < 2; ++i) { int R, C; stage_rc(tid * 16 + i * 8192, R, C); const int Rb = Epi::PERM ? ((R & ~31) + perm32(R & 31)) : R;
        voffA[i] = (unsigned)(R * lda_ + C) * 2u; voffB[i] = (unsigned)(Rb * ldb_ + C) * 2u; }
    const size_t kstep = (size_t)(BK * 2);
    const size_t hstepA = (size_t)HALF * lda_ * 2, hstepB = (size_t)HALF * ldb_ * 2;
    const unsigned ldsw = (unsigned)wid * 1024u;
    const int aoff = lds_byte(wr * 64 + fr, fq * 8), boff = lds_byte(wc * 32 + fr, fq * 8);
#define PG8_SA(b, h) (((b) * 2 + (h)) * HTB)
#define PG8_SB(b, h) ((4 + (b) * 2 + (h)) * HTB)
#define PG8_STAGE(bufoff, gbase, voff) do { _Pragma("unroll") for (int _i = 0; _i < 2; ++_i) \
        __builtin_amdgcn_global_load_lds((const unsigned*)((const char*)(gbase) + (voff)[_i]), (PG8_LAS unsigned*)(lds + (bufoff) + ldsw + _i * 8192), 16, 0, 0); } while (0)
#define PG8_LDA(dst, b, h) do { _Pragma("unroll") for (int m = 0; m < 4; ++m) _Pragma("unroll") for (int k = 0; k < 2; ++k) dst[m][k] = *(const PG8_LAS bf16x8*)(lds + PG8_SA(b, h) + aoff + m * 2048 + k * 1024); } while (0)
#define PG8_LDB(dst, b, h) do { _Pragma("unroll") for (int n = 0; n < 2; ++n) _Pragma("unroll") for (int k = 0; k < 2; ++k) dst[n][k] = *(const PG8_LAS bf16x8*)(lds + PG8_SB(b, h) + boff + n * 2048 + k * 1024); } while (0)
#define PG8_MMA(ai, bj, At, Bt) do { __builtin_amdgcn_s_setprio(1); _Pragma("unroll") for (int m = 0; m < 4; ++m) _Pragma("unroll") for (int n = 0; n < 2; ++n) _Pragma("unroll") for (int k = 0; k < 2; ++k) \
        acc[ai][bj][m][n] = __builtin_amdgcn_mfma_f32_16x16x32_bf16(Bt[n][k], At[m][k], acc[ai][bj][m][n], 0, 0, 0); __builtin_amdgcn_s_setprio(0); } while (0)
#define PG8_WAIT_V(n) asm volatile("s_waitcnt vmcnt(" #n ")" ::: "memory")
#define PG8_WAIT_L(n) asm volatile("s_waitcnt lgkmcnt(" #n ")" ::: "memory")
#define PG8_BAR __builtin_amdgcn_s_barrier()
#define PG8_SCHED __builtin_amdgcn_sched_barrier(0)
    f32x4 acc[2][2][4][2];
#pragma unroll
    for (int a = 0; a < 2; ++a)
#pragma unroll
        for (int b = 0; b < 2; ++b)
#pragma unroll
            for (int m = 0; m < 4; ++m)
#pragma unroll
                for (int n = 0; n < 2; ++n) acc[a][b][m][n] = (f32x4){0.f, 0.f, 0.f, 0.f};
    bf16x8 At[4][2], B0[2][2], B1[2][2];
    const char* cA = g.a_ptr(cur); const char* cB = g.b_ptr(cur);
    S.a_ready(cur);
    if constexpr (SP2) {
        PG8_STAGE(PG8_SB(0, 0), cB, voffB); PG8_STAGE(PG8_SB(0, 1), cB + hstepB, voffB); PG8_STAGE(PG8_SA(0, 0), cA, voffA); PG8_STAGE(PG8_SA(0, 1), cA + hstepA, voffA);
        if (wr == 1) PG8_BAR;
        PG8_WAIT_V(2); PG8_BAR;
        PG8_STAGE(PG8_SB(1, 0), cB + kstep, voffB); PG8_STAGE(PG8_SA(1, 0), cA + kstep, voffA); PG8_STAGE(PG8_SB(1, 1), cB + hstepB + kstep, voffB);
        PG8_WAIT_V(6); PG8_BAR;
    } else {
        PG8_STAGE(PG8_SB(0, 0), cB, voffB); PG8_STAGE(PG8_SA(0, 0), cA, voffA); PG8_STAGE(PG8_SB(0, 1), cB + hstepB, voffB); PG8_STAGE(PG8_SA(0, 1), cA + hstepA, voffA);
        if (wr == 1) PG8_BAR;
        PG8_WAIT_V(4); PG8_BAR;
        PG8_STAGE(PG8_SB(1, 0), cB + kstep, voffB); PG8_STAGE(PG8_SA(1, 0), cA + kstep, voffA); PG8_STAGE(PG8_SB(1, 1), cB + hstepB + kstep, voffB);
        PG8_WAIT_V(6); PG8_BAR;
    }
    for (;;) {
        const bool has_next = S.next(ui + 1, nxt);
        const char* nA = has_next ? g.a_ptr(nxt) : cA; const char* nB = has_next ? g.b_ptr(nxt) : cB;
        for (int t = 0; t < nt; t += 2) {
            const bool last = (t == nt - 2);
            const char* a1 = cA + (size_t)(t + 1) * kstep;
            const char* a2 = last ? nA : cA + (size_t)(t + 2) * kstep; const char* b2 = last ? nB : cB + (size_t)(t + 2) * kstep;
            const char* a3 = a2 + kstep; const char* b3 = b2 + kstep;
            if (last && has_next) S.a_ready(nxt);
            if constexpr (SP2) {
            PG8_LDB(B0, 0, 0); PG8_LDB(B1, 0, 1); PG8_SCHED; PG8_LDA(At, 0, 0); PG8_STAGE(PG8_SA(1, 1), a1 + hstepA, voffA);
            PG8_WAIT_V(8); PG8_WAIT_L(0); PG8_BAR; PG8_MMA(0, 0, At, B0); PG8_MMA(0, 1, At, B1); PG8_BAR; PG8_SCHED;
            PG8_LDA(At, 0, 1); PG8_STAGE(PG8_SB(0, 0), b2, voffB); PG8_STAGE(PG8_SB(0, 1), b2 + hstepB, voffB); PG8_STAGE(PG8_SA(0, 0), a2, voffA);
            PG8_WAIT_V(8); PG8_WAIT_L(0); PG8_BAR; PG8_MMA(1, 0, At, B0); PG8_MMA(1, 1, At, B1); PG8_BAR; PG8_SCHED;
            PG8_LDB(B0, 1, 0); PG8_LDB(B1, 1, 1); PG8_SCHED; PG8_LDA(At, 1, 0); PG8_STAGE(PG8_SA(0, 1), a2 + hstepA, voffA);
            PG8_WAIT_V(8); PG8_WAIT_L(0); PG8_BAR; PG8_MMA(0, 0, At, B0); PG8_MMA(0, 1, At, B1); PG8_BAR; PG8_SCHED;
            PG8_LDA(At, 1, 1); PG8_STAGE(PG8_SB(1, 0), b3, voffB); PG8_STAGE(PG8_SB(1, 1), b3 + hstepB, voffB); PG8_STAGE(PG8_SA(1, 0), a3, voffA);
            PG8_WAIT_V(8); PG8_WAIT_L(0); PG8_BAR; PG8_MMA(1, 0, At, B0); PG8_MMA(1, 1, At, B1); PG8_BAR; PG8_SCHED;
            } else {
            PG8_LDB(B0, 0, 0); PG8_SCHED; PG8_LDA(At, 0, 0); PG8_STAGE(PG8_SA(1, 1), a1 + hstepA, voffA);
            PG8_WAIT_L(8); PG8_BAR; PG8_WAIT_L(0); PG8_MMA(0, 0, At, B0); PG8_BAR; PG8_SCHED;
            PG8_LDB(B1, 0, 1); PG8_STAGE(PG8_SB(0, 0), b2, voffB);
            PG8_BAR; PG8_WAIT_L(0); PG8_MMA(0, 1, At, B1); PG8_BAR;
            PG8_LDA(At, 0, 1); PG8_STAGE(PG8_SA(0, 0), a2, voffA);
            PG8_BAR; PG8_WAIT_L(0); PG8_MMA(1, 0, At, B0); PG8_BAR; PG8_SCHED;
            PG8_STAGE(PG8_SB(0, 1), b2 + hstepB, voffB);
            PG8_WAIT_V(6); PG8_BAR; PG8_MMA(1, 1, At, B1); PG8_BAR;
            PG8_LDB(B0, 1, 0); PG8_SCHED; PG8_LDA(At, 1, 0); PG8_STAGE(PG8_SA(0, 1), a2 + hstepA, voffA);
            PG8_WAIT_L(8); PG8_BAR; PG8_WAIT_L(0); PG8_MMA(0, 0, At, B0); PG8_BAR; PG8_SCHED;
            PG8_LDB(B1, 1, 1); PG8_STAGE(PG8_SB(1, 0), b3, voffB);
            PG8_BAR; PG8_WAIT_L(0); PG8_MMA(0, 1, At, B1); PG8_BAR;
            PG8_LDA(At, 1, 1); PG8_STAGE(PG8_SA(1, 0), a3, voffA);
            PG8_BAR; PG8_WAIT_L(0); PG8_MMA(1, 0, At, B0); PG8_BAR; PG8_SCHED;
            PG8_STAGE(PG8_SB(1, 1), b3 + hstepB, voffB);
            PG8_WAIT_V(6); PG8_BAR; PG8_MMA(1, 1, At, B1); PG8_BAR;
            }
        }
        if constexpr (ALIGN_EPI) { if (wr == 0) PG8_BAR; }
        if constexpr (!Epi::AFTER_DRAIN) { int te_ = threadIdx.x; asm volatile("" : "+v"(te_)); E(acc, cur, wr, wc, te_ & 15, (te_ & 63) >> 4); S.done(cur); }
        if (!has_next) break;
#pragma unroll
        for (int a = 0; a < 2; ++a)
#pragma unroll
            for (int b = 0; b < 2; ++b)
#pragma unroll
                for (int m = 0; m < 4; ++m)
#pragma unroll
                    for (int n = 0; n < 2; ++n) acc[a][b][m][n] = (f32x4){0.f, 0.f, 0.f, 0.f};
        cur = nxt; cA = nA; cB = nB; ++ui;
        if constexpr (ALIGN_EPI) { if (wr == 1) PG8_BAR; }
    }
    PG8_WAIT_V(0);
    if constexpr (!ALIGN_EPI) { if (wr == 0) PG8_BAR; }
    PG8_BAR;
    if constexpr (Epi::AFTER_DRAIN) { int te_ = threadIdx.x; asm volatile("" : "+v"(te_)); E.fused(acc, cur, wr, wc, te_ & 15, (te_ & 63) >> 4, lds, wid, te_ & 63); S.done(cur); }
#undef PG8_SA
#undef PG8_SB
#undef PG8_STAGE
#undef PG8_LDA
#undef PG8_LDB
#undef PG8_MMA
#undef PG8_WAIT_V
#undef PG8_WAIT_L
#undef PG8_BAR
#undef PG8_SCHED
}
constexpr int TOK = 16384;
constexpr float RMS_EPS = 1e-6f;
struct GemmP { const bf16_t* A; const bf16_t* Bt; int lda, ldb, K;
    __device__ __forceinline__ const char* a_ptr(const Unit& u) const { return (const char*)(A + (size_t)u.pm * BM * lda); }
    __device__ __forceinline__ const char* b_ptr(const Unit& u) const { return (const char*)(Bt + (size_t)u.pn * BM * ldb); }
    __device__ __forceinline__ int lda_of(const Unit&) const { return lda; } __device__ __forceinline__ int ldb_of(const Unit&) const { return ldb; } };
struct GemmBB { const bf16_t* A; const bf16_t* Bt; int lda, ldb, K;
    __device__ __forceinline__ const char* a_ptr(const Unit& u) const { return (const char*)(A + (size_t)u.pm * BM * lda); }
    __device__ __forceinline__ const char* b_ptr(const Unit& u) const { return (const char*)(Bt + (size_t)(u.pm >> 3) * 1048576 + (size_t)u.pn * BM * ldb); }
    __device__ __forceinline__ int lda_of(const Unit&) const { return lda; } __device__ __forceinline__ int ldb_of(const Unit&) const { return ldb; } };
struct GemmFold { const bf16_t *XKV, *WQO, *WXO; int K;
    __device__ __forceinline__ const char* a_ptr(const Unit& u) const { const int idx = 4 * u.pm + u.pn, bh = (idx & 127) >> 2, q = idx & 3, h = bh & 3;
        return (idx >> 7) == 0 ? (const char*)(XKV + (size_t)bh * 65536) : (const char*)(WXO + (size_t)(q * 256) * 1024 + h * 256); }
    __device__ __forceinline__ const char* b_ptr(const Unit& u) const { const int idx = 4 * u.pm + u.pn, bh = (idx & 127) >> 2, q = idx & 3, h = bh & 3;
        return (idx >> 7) == 0 ? (const char*)(WQO + (size_t)(q * 256) * 1024 + h * 256) : (const char*)(XKV + (size_t)(32 + bh) * 65536); }
    __device__ __forceinline__ int lda_of(const Unit& u) const { return ((4 * u.pm + u.pn) >> 7) == 0 ? 256 : 1024; }
    __device__ __forceinline__ int ldb_of(const Unit& u) const { return ((4 * u.pm + u.pn) >> 7) == 0 ? 1024 : 256; } };
struct GemmX { const bf16_t* A; const bf16_t* Bt; int lda, ldb, K;
    __device__ __forceinline__ const char* a_ptr(const Unit& u) const { return (const char*)(A + ((size_t)u.pn * TOK + (size_t)u.pm * BM) * 256); }
    __device__ __forceinline__ const char* b_ptr(const Unit& u) const { return (const char*)(Bt + (size_t)((u.pm >> 3) * 4 + u.pn) * 65536); }
    __device__ __forceinline__ int lda_of(const Unit&) const { return lda; } __device__ __forceinline__ int ldb_of(const Unit&) const { return ldb; } };

struct GemmProj { const bf16_t* XB; const bf16_t* WIN; const bf16_t* HM; const bf16_t* WKV0; size_t wkv_lstride; int lda, ldb, K;
    __device__ __forceinline__ const char* a_ptr(const Unit& u) const {
        if (u.pn < 9) return (const char*)(XB + (size_t)u.pm * BM * 1024);
        const int idx = 2 * u.pm + (u.pn - 9), l = idx >> 6, b = (idx >> 2) & 7;
        return (const char*)(HM + ((size_t)l * 2048 + b * 256) * 1024); }
    __device__ __forceinline__ const char* b_ptr(const Unit& u) const {
        if (u.pn < 9) return (const char*)(WIN + (size_t)u.pn * BM * 1024);
        const int idx = 2 * u.pm + (u.pn - 9), l = idx >> 6, part = (idx >> 5) & 1, h = idx & 3;
        return (const char*)(WKV0 + (size_t)l * wkv_lstride + (size_t)(part * 1024 + h * 256) * 1024); }
    __device__ __forceinline__ int lda_of(const Unit&) const { return lda; } __device__ __forceinline__ int ldb_of(const Unit&) const { return ldb; } };
typedef unsigned u32x2 __attribute__((ext_vector_type(2)));
__device__ __forceinline__ void store16_wt(void* p, u32x4 v) { asm volatile("global_store_dwordx4 %0, %1, off sc1\n\ts_nop 1" :: "v"(p), "v"(v) : "memory"); }
template <bool MAX> __device__ __forceinline__ float comb16(float s) { const auto r = __builtin_amdgcn_permlane16_swap(__float_as_uint(s), __float_as_uint(s), false, false);
    const float a = __uint_as_float(r[0]), b = __uint_as_float(r[1]); return MAX ? __builtin_fmaxf(a, b) : a + b; }
template <bool MAX> __device__ __forceinline__ float comb32(float s) { const auto r = __builtin_amdgcn_permlane32_swap(__float_as_uint(s), __float_as_uint(s), false, false);
    const float a = __uint_as_float(r[0]), b = __uint_as_float(r[1]); return MAX ? __builtin_fmaxf(a, b) : a + b; }
__device__ __forceinline__ float bf_lo(unsigned w) { return __uint_as_float(w << 16); }
__device__ __forceinline__ float bf_hi(unsigned w) { return __uint_as_float(w & 0xffff0000u); }
__device__ __forceinline__ float fast_sigmoid(float z) { return __builtin_amdgcn_rcpf(1.0f + __builtin_amdgcn_exp2f(-1.4426950408889634f * z)); }
__device__ __forceinline__ float gelu_tanh(float x) {
    const float u = x * (0.7978845608028654f + 0.035677408136300125f * x * x);
    return x * __builtin_amdgcn_rcpf(1.0f + __builtin_amdgcn_exp2f(-2.8853900817779268f * u)); }
__device__ __forceinline__ void load_rstd(float (&rs)[2][4], const float* SS, const Unit& u, int wr, int fr, int fq) {
#pragma unroll
    for (int ai = 0; ai < 2; ++ai)
#pragma unroll
        for (int m = 0; m < 4; ++m) { const f32x4 a = *((const f32x4*)(SS + (size_t)(u.pm * BM + ai * HALF + wr * 64 + m * 16 + fr) * 16) + fq);
            float s = (a[0] + a[1]) + (a[2] + a[3]); s = comb16<false>(s); s = comb32<false>(s);
            rs[ai][m] = __builtin_amdgcn_rsqf(s * (1.0f / 1024.0f) + RMS_EPS); }
}
struct EpiProj { static constexpr bool PERM = true, AFTER_DRAIN = false;
    bf16_t *PA, *Q, *K, *V, *ZC; const float* SS; float qscale; bf16_t *XKV0, *XKV1;
    __device__ __forceinline__ void operator()(const f32x4 (&acc)[2][2][4][2], const Unit& u, int wr, int wc, int fr, int fq) const {
        const int pn = u.pn; bf16_t* base; int ldc, colt, mode;
        if (pn >= 9) {
            const int idx = 2 * u.pm + (pn - 9), l = idx >> 6, part = (idx >> 5) & 1, b = (idx >> 2) & 7, h = idx & 3;
            bf16_t* tb = (l == 0 ? XKV0 : XKV1) + (size_t)(part * 32 + b * 4 + h) * 65536; const int r0 = wr * 64 + fr, c0 = wc * 32 + 8 * fq;
#pragma unroll
            for (int ai = 0; ai < 2; ++ai)
#pragma unroll
                for (int m = 0; m < 4; ++m) { bf16_t* rowp = tb + (size_t)(r0 + ai * HALF + m * 16) * 256 + c0;
#pragma unroll
                    for (int bj = 0; bj < 2; ++bj) { const f32x4 v0 = acc[ai][bj][m][0], v1 = acc[ai][bj][m][1];
                        u32x4 w; w.x = cvt_pk_bf16(v0[0], v0[1]); w.y = cvt_pk_bf16(v0[2], v0[3]); w.z = cvt_pk_bf16(v1[0], v1[1]); w.w = cvt_pk_bf16(v1[2], v1[3]);
                        store16_wt(rowp + bj * HALF, w); } }
            return; }
        if (pn == 0) { base = PA; ldc = 256; colt = 0; mode = 0; }
        else if (pn <= 2) { base = Q; ldc = 512; colt = (pn - 1) * 256; mode = 1; }
        else if (pn <= 4) { base = K; ldc = 512; colt = (pn - 3) * 256; mode = 0; }
        else if (pn <= 6) { base = V; ldc = 512; colt = (pn - 5) * 256; mode = 0; }
        else { base = ZC; ldc = 512; colt = (pn - 7) * 256; mode = 2; }
        float rs[2][4]; load_rstd(rs, SS, u, wr, fr, fq);
        const float sc = (mode == 1) ? qscale : 1.0f;
        const int row0 = u.pm * BM + wr * 64 + fr, col0 = colt + wc * 32 + 8 * fq;
#pragma unroll
        for (int ai = 0; ai < 2; ++ai)
#pragma unroll
            for (int m = 0; m < 4; ++m) { bf16_t* rowp = base + (size_t)(row0 + ai * HALF + m * 16) * ldc + col0; const float r = rs[ai][m] * sc;
#pragma unroll
                for (int bj = 0; bj < 2; ++bj) { f32x4 v0 = acc[ai][bj][m][0] * r, v1 = acc[ai][bj][m][1] * r;
                    if (mode == 2) { v0 = (f32x4){gelu_tanh(v0[0]), gelu_tanh(v0[1]), gelu_tanh(v0[2]), gelu_tanh(v0[3])}; v1 = (f32x4){gelu_tanh(v1[0]), gelu_tanh(v1[1]), gelu_tanh(v1[2]), gelu_tanh(v1[3])}; }
                    u32x4 w; w.x = cvt_pk_bf16(v0[0], v0[1]); w.y = cvt_pk_bf16(v0[2], v0[3]); w.z = cvt_pk_bf16(v1[0], v1[1]); w.w = cvt_pk_bf16(v1[2], v1[3]);
                    store16_wt(rowp + bj * HALF, w); } }
    }
};
struct EpiTile { static constexpr bool PERM = true, AFTER_DRAIN = false;
    bf16_t* O; int mm, mn;
    __device__ __forceinline__ void operator()(const f32x4 (&acc)[2][2][4][2], const Unit& u, int wr, int wc, int fr, int fq) const {
        bf16_t* base = O + (size_t)(mm * u.pm + mn * u.pn) * 65536; const int row0 = wr * 64 + fr, col0 = wc * 32 + 8 * fq;
#pragma unroll
        for (int ai = 0; ai < 2; ++ai)
#pragma unroll
            for (int m = 0; m < 4; ++m) { bf16_t* rowp = base + (size_t)(row0 + ai * HALF + m * 16) * 256 + col0;
#pragma unroll
                for (int bj = 0; bj < 2; ++bj) { const f32x4 v0 = acc[ai][bj][m][0], v1 = acc[ai][bj][m][1];
                    u32x4 w; w.x = cvt_pk_bf16(v0[0], v0[1]); w.y = cvt_pk_bf16(v0[2], v0[3]); w.z = cvt_pk_bf16(v1[0], v1[1]); w.w = cvt_pk_bf16(v1[2], v1[3]);
                    *(u32x4*)(rowp + bj * HALF) = w; } }
    }
};
template <int ACT  , bool ROWSCALE, bool HEADMAJOR> struct EpiStore { static constexpr bool PERM = true, AFTER_DRAIN = false;
    bf16_t* O; int ldc; const float* SS; float scale;
    __device__ __forceinline__ void operator()(const f32x4 (&acc)[2][2][4][2], const Unit& u, int wr, int wc, int fr, int fq) const {
        float rs[2][4];
        if (ROWSCALE) load_rstd(rs, SS, u, wr, fr, fq);
        bf16_t* base = O; int colt = u.pn * BM;
        if (HEADMAJOR) { base += (size_t)u.pn * TOK * 256; colt = 0; }
        const int row0 = u.pm * BM + wr * 64 + fr, col0 = colt + wc * 32 + 8 * fq;
#pragma unroll
        for (int ai = 0; ai < 2; ++ai)
#pragma unroll
            for (int m = 0; m < 4; ++m) { bf16_t* rowp = base + (size_t)(row0 + ai * HALF + m * 16) * ldc + col0; const float r = ROWSCALE ? rs[ai][m] * scale : scale;
#pragma unroll
                for (int bj = 0; bj < 2; ++bj) { f32x4 v0 = acc[ai][bj][m][0] * r, v1 = acc[ai][bj][m][1] * r;
                    if (ACT == 1) {
#pragma unroll
                        for (int i = 0; i < 4; ++i) { const float a = __builtin_fmaxf(v0[i], 0.f), b = __builtin_fmaxf(v1[i], 0.f); v0[i] = a * a; v1[i] = b * b; } }
                    u32x4 w; w.x = cvt_pk_bf16(v0[0], v0[1]); w.y = cvt_pk_bf16(v0[2], v0[3]); w.z = cvt_pk_bf16(v1[0], v1[1]); w.w = cvt_pk_bf16(v1[2], v1[3]);
                    store16_wt(rowp + bj * HALF, w); } }
    }
};
struct EpiFold { static constexpr bool PERM = true, AFTER_DRAIN = false;
    bf16_t *WK, *VW;
    __device__ __forceinline__ void operator()(const f32x4 (&acc)[2][2][4][2], const Unit& u, int wr, int wc, int fr, int fq) const {
        const int idx = 4 * u.pm + u.pn, kind = idx >> 7, bh = (idx & 127) >> 2, q = idx & 3, b = bh >> 2, h = bh & 3;
        bf16_t* base = (kind == 0 ? WK + (size_t)(h * 256) * 1024 + q * 256 : VW + (size_t)(q * 256) * 1024 + h * 256) + (size_t)b * 1048576;
        const int row0 = wr * 64 + fr, col0 = wc * 32 + 8 * fq;
#pragma unroll
        for (int ai = 0; ai < 2; ++ai)
#pragma unroll
            for (int m = 0; m < 4; ++m) { bf16_t* rowp = base + (size_t)(row0 + ai * HALF + m * 16) * 1024 + col0;
#pragma unroll
                for (int bj = 0; bj < 2; ++bj) { const f32x4 v0 = acc[ai][bj][m][0], v1 = acc[ai][bj][m][1];
                    u32x4 w; w.x = cvt_pk_bf16(v0[0], v0[1]); w.y = cvt_pk_bf16(v0[2], v0[3]); w.z = cvt_pk_bf16(v1[0], v1[1]); w.w = cvt_pk_bf16(v1[2], v1[3]);
                    *(u32x4*)(rowp + bj * HALF) = w; } }
    }
};
struct EpiNop { static constexpr bool PERM = true, AFTER_DRAIN = false;
    __device__ __forceinline__ void operator()(const f32x4 (&acc)[2][2][4][2], const Unit&, int, int, int, int) const {
#pragma unroll
        for (int ai = 0; ai < 2; ++ai)
#pragma unroll
            for (int bj = 0; bj < 2; ++bj)
#pragma unroll
                for (int m = 0; m < 4; ++m)
#pragma unroll
                    for (int n = 0; n < 2; ++n) asm volatile("" :: "v"(acc[ai][bj][m][n]));
    }
};
template <bool FIRST> struct EpiGate { static constexpr bool PERM = true, AFTER_DRAIN = false;
    const bf16_t* Y; bf16_t* MG; const float* bias; const float* SS;
    __device__ __forceinline__ void operator()(const f32x4 (&acc)[2][2][4][2], const Unit& u, int wr, int wc, int fr, int fq) const {
        float rs[2][4]; load_rstd(rs, SS, u, wr, fr, fq);
        const int row0 = u.pm * BM + wr * 64 + fr, col0 = u.pn * BM + wc * 32 + 8 * fq;
        f32x4 bv[2][2];
#pragma unroll
        for (int bj = 0; bj < 2; ++bj)
#pragma unroll
            for (int n = 0; n < 2; ++n) bv[bj][n] = *(const f32x4*)(bias + col0 + bj * HALF + 4 * n);
#pragma unroll
        for (int ai = 0; ai < 2; ++ai)
#pragma unroll
            for (int m = 0; m < 4; ++m) { const size_t off = (size_t)(row0 + ai * HALF + m * 16) * 1024 + col0; const float r = rs[ai][m];
#pragma unroll
                for (int bj = 0; bj < 2; ++bj) { const f32x4 z0 = acc[ai][bj][m][0] * r + bv[bj][0], z1 = acc[ai][bj][m][1] * r + bv[bj][1];
                    const u32x4 y = *(const u32x4*)(Y + off + bj * HALF);
                    float o0 = fast_sigmoid(z0[0]) * bf_lo(y.x), o1 = fast_sigmoid(z0[1]) * bf_hi(y.x), o2 = fast_sigmoid(z0[2]) * bf_lo(y.y), o3 = fast_sigmoid(z0[3]) * bf_hi(y.y);
                    float o4 = fast_sigmoid(z1[0]) * bf_lo(y.z), o5 = fast_sigmoid(z1[1]) * bf_hi(y.z), o6 = fast_sigmoid(z1[2]) * bf_lo(y.w), o7 = fast_sigmoid(z1[3]) * bf_hi(y.w);
                    if (!FIRST) { const u32x4 p = *(const u32x4*)(MG + off + bj * HALF);
                        o0 += bf_lo(p.x); o1 += bf_hi(p.x); o2 += bf_lo(p.y); o3 += bf_hi(p.y); o4 += bf_lo(p.z); o5 += bf_hi(p.z); o6 += bf_lo(p.w); o7 += bf_hi(p.w); }
                    u32x4 w; w.x = cvt_pk_bf16(o0, o1); w.y = cvt_pk_bf16(o2, o3); w.z = cvt_pk_bf16(o4, o5); w.w = cvt_pk_bf16(o6, o7);
                    *(u32x4*)(MG + off + bj * HALF) = w; }
                if (m & 1) asm volatile("" ::: "memory"); }
    }
};
struct EpiRes { static constexpr bool PERM = true, AFTER_DRAIN = false;
    bf16_t* xb; float* outf; float* SS;
    __device__ __forceinline__ void operator()(const f32x4 (&acc)[2][2][4][2], const Unit& u, int wr, int wc, int fr, int fq) const {
        const int row0 = u.pm * BM + wr * 64 + fr, col0 = u.pn * BM + wc * 32 + 8 * fq;
#pragma unroll
        for (int ai = 0; ai < 2; ++ai)
#pragma unroll
            for (int m = 0; m < 4; ++m) { const int row = row0 + ai * HALF + m * 16; const size_t off = (size_t)row * 1024 + col0; float ss = 0.f;
#pragma unroll
                for (int bj = 0; bj < 2; ++bj) { const u32x4 y = *(const u32x4*)(xb + off + bj * HALF);
                    const f32x4 v0 = acc[ai][bj][m][0] + (f32x4){bf_lo(y.x), bf_hi(y.x), bf_lo(y.y), bf_hi(y.y)}, v1 = acc[ai][bj][m][1] + (f32x4){bf_lo(y.z), bf_hi(y.z), bf_lo(y.w), bf_hi(y.w)};
                    ss += ((v0[0] * v0[0] + v0[1] * v0[1]) + (v0[2] * v0[2] + v0[3] * v0[3])) + ((v1[0] * v1[0] + v1[1] * v1[1]) + (v1[2] * v1[2] + v1[3] * v1[3]));
                    if (outf) { *(f32x4*)(outf + off + bj * HALF) = v0; *(f32x4*)(outf + off + bj * HALF + 4) = v1; }
                    else { u32x4 w; w.x = cvt_pk_bf16(v0[0], v0[1]); w.y = cvt_pk_bf16(v0[2], v0[3]); w.z = cvt_pk_bf16(v1[0], v1[1]); w.w = cvt_pk_bf16(v1[2], v1[3]); *(u32x4*)(xb + off + bj * HALF) = w; } }
                ss = comb16<false>(ss); ss = comb32<false>(ss);
                if (fq == 0) SS[(size_t)row * 16 + u.pn * 4 + wc] = ss;
                if (m & 1) asm volatile("" ::: "memory"); }
    }
};
struct EpiSoftmax { static constexpr bool PERM = true, AFTER_DRAIN = true;
    bf16_t* P;
    __device__ __forceinline__ void fused(f32x4 (&acc)[2][2][4][2], const Unit& u, int wr, int wc, int fr, int fq, PG8_LAS unsigned char* lds, int wid, int lane) const {
        PG8_LAS float* Pm = (PG8_LAS float*)lds; PG8_LAS float* Ps = Pm + 1024;
#pragma unroll
        for (int ai = 0; ai < 2; ++ai)
#pragma unroll
            for (int m = 0; m < 4; ++m) { float t = -INFINITY;
#pragma unroll
                for (int bj = 0; bj < 2; ++bj)
#pragma unroll
                    for (int n = 0; n < 2; ++n) { const f32x4 x = acc[ai][bj][m][n]; t = __builtin_fmaxf(t, __builtin_fmaxf(__builtin_fmaxf(x[0], x[1]), __builtin_fmaxf(x[2], x[3]))); }
                t = comb16<true>(t); t = comb32<true>(t);
                if (fq == 0) Pm[(ai * HALF + wr * 64 + m * 16 + fr) * 4 + wc] = t; }
        asm volatile("s_waitcnt lgkmcnt(0)" ::: "memory"); __builtin_amdgcn_s_barrier(); asm volatile("" ::: "memory");
#pragma unroll
        for (int ai = 0; ai < 2; ++ai)
#pragma unroll
            for (int m = 0; m < 4; ++m) { const int r = ai * HALF + wr * 64 + m * 16 + fr; const f32x4 mm = *(const PG8_LAS f32x4*)(Pm + r * 4);
                const float mx = __builtin_fmaxf(__builtin_fmaxf(mm[0], mm[1]), __builtin_fmaxf(mm[2], mm[3])); float s = 0.f;
#pragma unroll
                for (int bj = 0; bj < 2; ++bj)
#pragma unroll
                    for (int n = 0; n < 2; ++n) { f32x4 x = acc[ai][bj][m][n];
#pragma unroll
                        for (int i = 0; i < 4; ++i) x[i] = __builtin_amdgcn_exp2f(x[i] - mx);
                        acc[ai][bj][m][n] = x; s += (x[0] + x[1]) + (x[2] + x[3]); }
                s = comb16<false>(s); s = comb32<false>(s);
                if (fq == 0) Ps[r * 4 + wc] = s; }
        asm volatile("s_waitcnt lgkmcnt(0)" ::: "memory"); __builtin_amdgcn_s_barrier(); asm volatile("" ::: "memory");
        bf16_t* base = P + ((size_t)u.pn * TOK + (size_t)u.pm * BM) * 256; const int col0 = wc * 32 + 8 * fq;
#pragma unroll
        for (int ai = 0; ai < 2; ++ai)
#pragma unroll
            for (int m = 0; m < 4; ++m) { const int r = ai * HALF + wr * 64 + m * 16 + fr; const f32x4 sm = *(const PG8_LAS f32x4*)(Ps + r * 4);
                const float inv = 1.0f / ((sm[0] + sm[1]) + (sm[2] + sm[3])); bf16_t* rowp = base + (size_t)r * 256 + col0;
#pragma unroll
                for (int bj = 0; bj < 2; ++bj) { const f32x4 v0 = acc[ai][bj][m][0] * inv, v1 = acc[ai][bj][m][1] * inv;
                    u32x4 w; w.x = cvt_pk_bf16(v0[0], v0[1]); w.y = cvt_pk_bf16(v0[2], v0[3]); w.z = cvt_pk_bf16(v1[0], v1[1]); w.w = cvt_pk_bf16(v1[2], v1[3]);
                    *(u32x4*)(rowp + bj * HALF) = w; } }
        asm volatile("s_waitcnt lgkmcnt(0)" ::: "memory"); __builtin_amdgcn_s_barrier(); asm volatile("" ::: "memory");
    }
};


struct EpiSoftmaxR { static constexpr bool PERM = true, AFTER_DRAIN = true;
    bf16_t* P; const float* SS;
    __device__ __forceinline__ void fused(f32x4 (&acc)[2][2][4][2], const Unit& u, int wr, int wc, int fr, int fq, PG8_LAS unsigned char* lds, int wid, int lane) const {
        PG8_LAS float* Pm = (PG8_LAS float*)lds; PG8_LAS float* Ps = Pm + 1024;
        float rs[2][4]; load_rstd(rs, SS, u, wr, fr, fq);
#pragma unroll
        for (int ai = 0; ai < 2; ++ai)
#pragma unroll
            for (int m = 0; m < 4; ++m) { float t = -INFINITY;
#pragma unroll
                for (int bj = 0; bj < 2; ++bj)
#pragma unroll
                    for (int n = 0; n < 2; ++n) { const f32x4 x = acc[ai][bj][m][n] * rs[ai][m]; acc[ai][bj][m][n] = x; t = __builtin_fmaxf(t, __builtin_fmaxf(__builtin_fmaxf(x[0], x[1]), __builtin_fmaxf(x[2], x[3]))); }
                t = comb16<true>(t); t = comb32<true>(t);
                if (fq == 0) Pm[(ai * HALF + wr * 64 + m * 16 + fr) * 4 + wc] = t; }
        asm volatile("s_waitcnt lgkmcnt(0)" ::: "memory"); __builtin_amdgcn_s_barrier(); asm volatile("" ::: "memory");
#pragma unroll
        for (int ai = 0; ai < 2; ++ai)
#pragma unroll
            for (int m = 0; m < 4; ++m) { const int r = ai * HALF + wr * 64 + m * 16 + fr; const f32x4 mm = *(const PG8_LAS f32x4*)(Pm + r * 4);
                const float mx = __builtin_fmaxf(__builtin_fmaxf(mm[0], mm[1]), __builtin_fmaxf(mm[2], mm[3])); float s = 0.f;
#pragma unroll
                for (int bj = 0; bj < 2; ++bj)
#pragma unroll
                    for (int n = 0; n < 2; ++n) { f32x4 x = acc[ai][bj][m][n];
#pragma unroll
                        for (int i = 0; i < 4; ++i) x[i] = __builtin_amdgcn_exp2f(x[i] - mx);
                        acc[ai][bj][m][n] = x; s += (x[0] + x[1]) + (x[2] + x[3]); }
                s = comb16<false>(s); s = comb32<false>(s);
                if (fq == 0) Ps[r * 4 + wc] = s; }
        asm volatile("s_waitcnt lgkmcnt(0)" ::: "memory"); __builtin_amdgcn_s_barrier(); asm volatile("" ::: "memory");
        bf16_t* base = P + (size_t)u.pm * BM * 1024 + u.pn * BM; const int col0 = wc * 32 + 8 * fq;
#pragma unroll
        for (int ai = 0; ai < 2; ++ai)
#pragma unroll
            for (int m = 0; m < 4; ++m) { const int r = ai * HALF + wr * 64 + m * 16 + fr; const f32x4 sm = *(const PG8_LAS f32x4*)(Ps + r * 4);
                const float inv = 1.0f / ((sm[0] + sm[1]) + (sm[2] + sm[3])); bf16_t* rowp = base + (size_t)r * 1024 + col0;
#pragma unroll
                for (int bj = 0; bj < 2; ++bj) { const f32x4 v0 = acc[ai][bj][m][0] * inv, v1 = acc[ai][bj][m][1] * inv;
                    u32x4 w; w.x = cvt_pk_bf16(v0[0], v0[1]); w.y = cvt_pk_bf16(v0[2], v0[3]); w.z = cvt_pk_bf16(v1[0], v1[1]); w.w = cvt_pk_bf16(v1[2], v1[3]);
                    store16_wt(rowp + bj * HALF, w); } }
        asm volatile("s_waitcnt lgkmcnt(0)" ::: "memory"); __builtin_amdgcn_s_barrier(); asm volatile("" ::: "memory");
    }
};
}

#include <hip/hip_bf16.h>
#include <cmath>
namespace attn_body {
using bf16=__hip_bfloat16;
using bf16x8=__attribute__((ext_vector_type(8)))short;
using s16x4=__attribute__((ext_vector_type(4)))short;
using f32x16=__attribute__((ext_vector_type(16)))float;
using u32x4=__attribute__((ext_vector_type(4)))unsigned;
constexpr int BATCH=8,NHEAD=8,SEQ=2048,D=64,DM=NHEAD*D;
constexpr int NW=8,QBLK=32,QB=QBLK*NW,KVBLK=64,NQB=SEQ/QB;
constexpr int ATTN_PITCH=DM, ATTN_UNIT_ROWS=QB;
__device__ __forceinline__ int crow(int r,int hi){return (r&3)+8*(r>>2)+4*hi;}
#define SBAR() __builtin_amdgcn_sched_barrier(0)
__device__ __forceinline__ void cmask(f32x16&p0,f32x16&p1,int jb,int qrel,int hi){
  const float NEG=-INFINITY; int kb=64*jb+4*hi;
  #pragma unroll
  for(int r=0;r<16;++r){int kv=kb+(r&3)+8*(r>>2); if(kv>qrel)p0[r]=NEG; if(kv+32>qrel)p1[r]=NEG;}
}

constexpr int NSLOT=3, SLOTB=8192;
constexpr int LDS_K=0, LDS_V=NSLOT*SLOTB, LDS_WS=2*NSLOT*SLOTB, LDS_OST=LDS_WS+NW*64*4, LDS_BYTES=LDS_OST+NW*4096, LDS_NB=LDS_BYTES;
constexpr float C2=0.125f*1.4426950408889634f;
__device__ __forceinline__ void glds16(const void*gsrc,unsigned lds_dst){unsigned keep;
  asm volatile("s_mov_b32 %0, m0\n\ts_mov_b32 m0, %2\n\ts_nop 0\n\tglobal_load_lds_dwordx4 %1, off\n\ts_mov_b32 m0, %0":"=&s"(keep):"v"(gsrc),"s"(lds_dst):"memory");}
__device__ __forceinline__ float max3f(float a,float b,float c){float r;asm("v_max3_f32 %0, %1, %2, %3":"=v"(r):"v"(a),"v"(b),"v"(c));return r;}
__device__ __forceinline__ float max2f(float a,float b){float r;asm("v_max_f32_e32 %0, %1, %2":"=v"(r):"v"(a),"v"(b));return r;}
__device__ __forceinline__ float fadd_s(float a,float b){float r;asm("v_add_f32_e32 %0, %1, %2":"=v"(r):"v"(a),"v"(b));return r;}
__device__ __forceinline__ float fsub_s(float a,float b){float r;asm("v_sub_f32_e32 %0, %1, %2":"=v"(r):"v"(a),"v"(b));return r;}
typedef float f32x2_t __attribute__((ext_vector_type(2))); typedef __bf16 bf16x2_t __attribute__((ext_vector_type(2)));
__device__ __forceinline__ unsigned cvtpk_s(float lo,float hi){f32x2_t v={lo,hi};bf16x2_t b=__builtin_convertvector(v,bf16x2_t);return __builtin_bit_cast(unsigned,b);}
#define WAIT_BAR(N) asm volatile("s_waitcnt vmcnt(" #N ") lgkmcnt(0)\n\ts_barrier":::"memory")

__device__ __forceinline__ void qkt(f32x16&p0,f32x16&p1,const char*Kslot,const bf16x8*qr,int r32,int hi){
  const char*kb=Kslot+hi*1024+r32*16;
  #pragma unroll
  for(int d0=0;d0<4;++d0){
    const bf16x8 b0=*reinterpret_cast<const bf16x8*>(kb+d0*2048);
    const bf16x8 b1=*reinterpret_cast<const bf16x8*>(kb+d0*2048+512);
    p0=__builtin_amdgcn_mfma_f32_32x32x16_bf16(b0,qr[d0],p0,0,0,0);p1=__builtin_amdgcn_mfma_f32_32x32x16_bf16(b1,qr[d0],p1,0,0,0);}
}
typedef __attribute__((address_space(3))) const char* lds_cptr;
typedef short v4i16_t __attribute__((ext_vector_type(4)));
__device__ __forceinline__ void kload8(bf16x8*kf,lds_cptr kp){
  kf[0]=*(const __attribute__((address_space(3))) bf16x8*)(kp);      kf[1]=*(const __attribute__((address_space(3))) bf16x8*)(kp+512);
  kf[2]=*(const __attribute__((address_space(3))) bf16x8*)(kp+2048); kf[3]=*(const __attribute__((address_space(3))) bf16x8*)(kp+2560);
  kf[4]=*(const __attribute__((address_space(3))) bf16x8*)(kp+4096); kf[5]=*(const __attribute__((address_space(3))) bf16x8*)(kp+4608);
  kf[6]=*(const __attribute__((address_space(3))) bf16x8*)(kp+6144); kf[7]=*(const __attribute__((address_space(3))) bf16x8*)(kp+6656);
}
__device__ __forceinline__ void kload2(bf16x8*kf,lds_cptr kp,int j){ kf[2*j]=*(const __attribute__((address_space(3))) bf16x8*)(kp+j*2048); kf[2*j+1]=*(const __attribute__((address_space(3))) bf16x8*)(kp+j*2048+512); }
__device__ __forceinline__ s16x4 vtr(lds_cptr p){ return __builtin_bit_cast(s16x4,__builtin_amdgcn_ds_read_tr16_b64_v4i16((__attribute__((address_space(3))) v4i16_t*)p)); }
__device__ __forceinline__ float rowmax(const f32x16&p0,const f32x16&p1){
  float a=max3f(p0[0],p0[1],p1[0]),b=max3f(p0[2],p0[3],p1[1]);a=max3f(a,p1[2],p1[3]);
  #pragma unroll
  for(int r=4;r<16;r+=4){a=max3f(a,p0[r],p0[r+1]);b=max3f(b,p0[r+2],p0[r+3]);a=max3f(a,p1[r],p1[r+1]);b=max3f(b,p1[r+2],p1[r+3]);}
  const float m=max2f(a,b);
  auto rr=__builtin_amdgcn_permlane32_swap(__float_as_uint(m),__float_as_uint(m),false,false);
  return max2f(__uint_as_float(rr[0]),__uint_as_float(rr[1]));
}
__device__ __forceinline__ void pv(f32x16*o,int vb,bf16x8 pa0,bf16x8 pa1,bf16x8 pa2,bf16x8 pa3){
  #pragma unroll
  for(int d0=0;d0<2;++d0){s16x4 lo[4],hi[4];
    #pragma unroll
    for(int ks=0;ks<4;++ks){
      asm volatile("ds_read_b64_tr_b16 %0,%1 offset:%c2":"=&v"(lo[ks]):"v"(vb),"i"(d0*4096+ks*1024):"memory");
      asm volatile("ds_read_b64_tr_b16 %0,%1 offset:%c2":"=&v"(hi[ks]):"v"(vb),"i"(d0*4096+ks*1024+512):"memory");}
    asm volatile("s_waitcnt lgkmcnt(0)":::"memory");SBAR();
    #define PK(k) (bf16x8){lo[k][0],lo[k][1],lo[k][2],lo[k][3],hi[k][0],hi[k][1],hi[k][2],hi[k][3]}
    o[d0]=__builtin_amdgcn_mfma_f32_32x32x16_bf16(pa0,PK(0),o[d0],0,0,0);
    o[d0]=__builtin_amdgcn_mfma_f32_32x32x16_bf16(pa1,PK(1),o[d0],0,0,0);
    o[d0]=__builtin_amdgcn_mfma_f32_32x32x16_bf16(pa2,PK(2),o[d0],0,0,0);
    o[d0]=__builtin_amdgcn_mfma_f32_32x32x16_bf16(pa3,PK(3),o[d0],0,0,0);
    #undef PK
  }
}

#ifndef ATTN_STORE16
#define ATTN_STORE16(p,v) (*(u32x4*)(p)=(v))
#endif
template<int THRL> __device__ __forceinline__ void attn_unit(int b,int h,int qb,const bf16*Q,const bf16*__restrict__ K,const bf16*__restrict__ V,bf16*O,char*shm){
  int tid_=threadIdx.x; asm volatile("":"+v"(tid_)); const int tid=tid_,lane=tid&63,r32=lane&31,hi=lane>>5; const int wid=__builtin_amdgcn_readfirstlane(tid>>6);
  const long rowbase=(long)b*SEQ; const int q0=qb*QB;
  const bf16*Qw=Q+(rowbase+q0+wid*QBLK)*DM+h*D;
  const bf16*Kh=K+rowbase*DM+h*D,*Vh=V+rowbase*DM+h*D;
  const unsigned lds0=(unsigned)(uintptr_t)shm;
  float*wsf=(float*)(shm+LDS_WS)+wid*64;
  const bf16*ksrc=Kh+(long)lane*DM+wid*8;
  const bf16*vsrc=Vh+(long)(16*(wid&3)+(lane>>2))*DM+(wid>>2)*32+(lane&3)*8;
  const unsigned kdst=lds0+LDS_K+wid*1024, vdst=lds0+LDS_V+wid*1024;
  #define DMA_K(t,slot) glds16(ksrc+(long)(t)*KVBLK*DM,(unsigned)__builtin_amdgcn_readfirstlane(kdst+(slot)))
  #define DMA_V(t,slot) glds16(vsrc+(long)(t)*KVBLK*DM,(unsigned)__builtin_amdgcn_readfirstlane(vdst+(slot)))
  const int vb0=(int)(lds0+LDS_V)+((lane>>4)&1)*32+(lane&3)*8+(4*hi+((lane&15)>>2))*64;
  const char*Kbase=shm+LDS_K; bf16x8 kf[8];
  const lds_cptr shm3=(lds_cptr)shm; const lds_cptr kp0=shm3+LDS_K+hi*1024+r32*16; const lds_cptr vp0=shm3+LDS_V+((lane>>4)&1)*32+(lane&3)*8+(4*hi+((lane&15)>>2))*64;
  const int NT=(q0+QB)/KVBLK;
  DMA_K(0,0);DMA_V(0,0);DMA_K(1,SLOTB);
  bf16x8 qr[4];
  #pragma unroll
  for(int d0=0;d0<4;++d0)qr[d0]=*reinterpret_cast<const bf16x8*>(&Qw[(long)r32*DM+d0*16+hi*8]);
  float mhat=0.f,l_reg=0.f;f32x16 o[2];o[0]=f32x16{};o[1]=f32x16{};
  typedef float f32x4_t __attribute__((ext_vector_type(4)));
  const __attribute__((address_space(3))) f32x4_t* nb3=(const __attribute__((address_space(3))) f32x4_t*)((lds_cptr)shm+LDS_NB+hi*16);
  #define LDBIAS(C0,C1,t) do{ const __attribute__((address_space(3))) f32x4_t* nb_=nb3+16*(t); \
    _Pragma("unroll") for(int g_=0;g_<4;++g_){ const f32x4_t a_=nb_[2*g_], b_=nb_[8+2*g_]; \
      C0[4*g_]=a_[0];C0[4*g_+1]=a_[1];C0[4*g_+2]=a_[2];C0[4*g_+3]=a_[3]; C1[4*g_]=b_[0];C1[4*g_+1]=b_[1];C1[4*g_+2]=b_[2];C1[4*g_+3]=b_[3]; } }while(0)
  const int qrel=wid*QBLK+r32;
  #define CMASK(P0,P1,t) do{int jb_=(t)-(NT-4); if(jb_>=0)cmask(P0,P1,jb_,qrel,hi);}while(0)
  bool resc=false;
  #define START(P0,P1) do{ const float rm=rowmax(P0,P1); resc=false; mhat=rm; \
    _Pragma("unroll") for(int r=0;r<16;++r)P0[r]=__builtin_amdgcn_exp2f(P0[r]-mhat); }while(0)
  #define RESC() do{ if(resc){ asm volatile("s_waitcnt lgkmcnt(0)":::"memory"); \
      _Pragma("unroll") for(int d_=0;d_<2;++d_) _Pragma("unroll") for(int r=0;r<16;++r)o[d_][r]*=wsf[crow(r,hi)]; } }while(0)
  f32x16 pA0,pA1,pB0,pB1;
  int sl_prev=0,sl_cur=0,sl_next=SLOTB;
  #define ROT() do{sl_prev=sl_cur;sl_cur=sl_next;sl_next=(sl_next==(NSLOT-1)*SLOTB)?0:sl_next+SLOTB;}while(0)
  DMA_K(2,2*SLOTB);
  WAIT_BAR(3);
  LDBIAS(pA0,pA1,0); qkt(pA0,pA1,Kbase,qr,r32,hi);asm volatile("s_nop 15\n\ts_nop 7":"+v"(pA0),"+v"(pA1));CMASK(pA0,pA1,0);
  START(pA0,pA1);
  _Pragma("unroll") for(int r=0;r<16;++r)pA1[r]=__builtin_amdgcn_exp2f(pA1[r]-mhat);
  WAIT_BAR(0);
  DMA_K(3,0);DMA_V(1,SLOTB);
  ROT();
  kload8(kf,kp0+sl_cur);
  WAIT_BAR(2);
  s16x4 vlo[8],vhi[8]; u32x4 pw0,pw1,pw2,pw3;
  #define PKW(P,B) cvtpk_s(P[B],P[B+1])
  #define PAF(k) __builtin_bit_cast(bf16x8,pw##k)
  #define VFR(i) (bf16x8){vlo[i][0],vlo[i][1],vlo[i][2],vlo[i][3],vhi[i][0],vhi[i][1],vhi[i][2],vhi[i][3]}
  #define PIN(x) asm volatile("":"+v"(x))
  #define MX3(a,b,c) __builtin_fmaxf(__builtin_fmaxf((a),(b)),(c))
  #define GAPA(MF,A0,A1,A2,A3,W0,W1,PW) do{ MF; sacc+=A0; sacc+=A1; sacc+=A2; sacc+=A3; PIN(sacc); W0; W1; PIN(PW); SBAR(); }while(0)
  #define EX(v) __builtin_amdgcn_exp2f((v)-mhat)
  #define GAPB(MF,X,B) do{ MF; X[B]=EX(X[B]); X[B+1]=EX(X[B+1]); X[B+2]=EX(X[B+2]); X[B+3]=EX(X[B+3]); PIN(X); SBAR(); }while(0)
  #define VRD(i) do{ vlo[i]=vtr(vp_+(((i)>>2)*4096+((i)&3)*1024)); vhi[i]=vtr(vp_+(((i)>>2)*4096+((i)&3)*1024+512)); }while(0)
  #define KRD(G,j) do{ if(G){ kload2(kf,kp0+sl_next,j); SBAR(); } }while(0)
  #define STEP(C0,C1,P0,P1,t,GK,GV,GL) do{ SBAR(); LDBIAS(C0,C1,t); \
    const lds_cptr vp_=vp0+sl_prev; \
    VRD(0); SBAR(); float sacc=(P0[0]+P0[1]); \
    GAPA(C0=__builtin_amdgcn_mfma_f32_32x32x16_bf16(kf[0],qr[0],C0,0,0,0), P0[2],P0[3],P0[4],P0[5],     pw0[0]=PKW(P0,0), pw0[1]=PKW(P0,2), pw0); \
    VRD(4); SBAR(); GAPA(C1=__builtin_amdgcn_mfma_f32_32x32x16_bf16(kf[1],qr[0],C1,0,0,0), P0[6],P0[7],P0[8],P0[9],     pw0[2]=PKW(P0,4), pw0[3]=PKW(P0,6), pw0); \
    VRD(1); SBAR(); GAPA(C0=__builtin_amdgcn_mfma_f32_32x32x16_bf16(kf[2],qr[1],C0,0,0,0),   P0[10],P0[11],P0[12],P0[13], pw1[0]=PKW(P0,8), pw1[1]=PKW(P0,10), pw1); \
    VRD(5); SBAR(); GAPA(C1=__builtin_amdgcn_mfma_f32_32x32x16_bf16(kf[3],qr[1],C1,0,0,0),   P0[14],P0[15],P1[0],P1[1],   pw1[2]=PKW(P0,12),pw1[3]=PKW(P0,14), pw1); \
    VRD(2); SBAR(); GAPA(C0=__builtin_amdgcn_mfma_f32_32x32x16_bf16(kf[4],qr[2],C0,0,0,0),   P1[2],P1[3],P1[4],P1[5],     pw2[0]=PKW(P1,0), pw2[1]=PKW(P1,2), pw2); \
    VRD(6); SBAR(); GAPA(C1=__builtin_amdgcn_mfma_f32_32x32x16_bf16(kf[5],qr[2],C1,0,0,0),   P1[6],P1[7],P1[8],P1[9],     pw2[2]=PKW(P1,4), pw2[3]=PKW(P1,6), pw2); \
    VRD(3); SBAR(); GAPA(C0=__builtin_amdgcn_mfma_f32_32x32x16_bf16(kf[6],qr[3],C0,0,0,0),   P1[10],P1[11],P1[12],P1[13], pw3[0]=PKW(P1,8), pw3[1]=PKW(P1,10), pw3); \
    VRD(7); SBAR(); GAPA(C1=__builtin_amdgcn_mfma_f32_32x32x16_bf16(kf[7],qr[3],C1,0,0,0),   P1[14],P1[15],0.f,0.f,       pw3[2]=PKW(P1,12),pw3[3]=PKW(P1,14), pw3); \
    l_reg+=sacc; \
    if(GK){DMA_K((t)+3,sl_cur);} if(GV){DMA_V((t)+1,sl_next);} \
    CMASK(C0,C1,t); \
    { float a=MX3(C0[0],C0[1],C1[0]),b=MX3(C0[2],C0[3],C1[1]); a=MX3(a,C1[2],C1[3]); \
      _Pragma("unroll") for(int r=4;r<16;r+=4){a=MX3(a,C0[r],C0[r+1]);b=MX3(b,C0[r+2],C0[r+3]);a=MX3(a,C1[r],C1[r+1]);b=MX3(b,C1[r+2],C1[r+3]);} \
      float rm=__builtin_fmaxf(a,b); { auto rr=__builtin_amdgcn_permlane32_swap(__float_as_uint(rm),__float_as_uint(rm),false,false); rm=__builtin_fmaxf(__uint_as_float(rr[0]),__uint_as_float(rr[1])); } \
      resc=false; rm-=mhat; \
      if(__builtin_expect(__any(rm>(float)THRL),0)){ const float dl=__builtin_fmaxf(rm,0.f); mhat+=dl; \
        const float f=__builtin_amdgcn_exp2f(-dl); l_reg*=f; if(hi==0)wsf[r32]=f; resc=true; } } \
    SBAR(); \
    GAPB(o[0]=__builtin_amdgcn_mfma_f32_32x32x16_bf16(PAF(0),VFR(0),o[0],0,0,0), C0,0); \
    GAPB(o[1]=__builtin_amdgcn_mfma_f32_32x32x16_bf16(PAF(0),VFR(4),o[1],0,0,0), C0,4); \
    KRD(GL,0); GAPB(o[0]=__builtin_amdgcn_mfma_f32_32x32x16_bf16(PAF(1),VFR(1),o[0],0,0,0), C0,8); \
    KRD(GL,1); GAPB(o[1]=__builtin_amdgcn_mfma_f32_32x32x16_bf16(PAF(1),VFR(5),o[1],0,0,0), C0,12); \
    KRD(GL,2); GAPB(o[0]=__builtin_amdgcn_mfma_f32_32x32x16_bf16(PAF(2),VFR(2),o[0],0,0,0), C1,0); \
    KRD(GL,3); GAPB(o[1]=__builtin_amdgcn_mfma_f32_32x32x16_bf16(PAF(2),VFR(6),o[1],0,0,0), C1,4); \
    GAPB(o[0]=__builtin_amdgcn_mfma_f32_32x32x16_bf16(PAF(3),VFR(3),o[0],0,0,0), C1,8); \
    GAPB(o[1]=__builtin_amdgcn_mfma_f32_32x32x16_bf16(PAF(3),VFR(7),o[1],0,0,0), C1,12); \
    }while(0)
  int t=1;
  #undef CMASK
  #define CMASK(P0,P1,t) do{}while(0)
  for(;t+5<NT;t+=2){
    STEP(pB0,pB1,pA0,pA1,t,true,true,true);     WAIT_BAR(2); RESC(); ROT();
    STEP(pA0,pA1,pB0,pB1,t+1,true,true,true);   WAIT_BAR(2); RESC(); ROT();
  }
  #undef CMASK
  #define CMASK(P0,P1,t) do{int jb_=(t)-(NT-4); if(jb_>=0)cmask(P0,P1,jb_,qrel,hi);}while(0)
  #define ENDW(tt) do{ if((tt)+3<NT){WAIT_BAR(2);} else if((tt)+2<NT){WAIT_BAR(1);} else {WAIT_BAR(0);} }while(0)
  for(;t+1<NT;t+=2){
    STEP(pB0,pB1,pA0,pA1,t,(t+3<NT),(t+1<NT),(t+1<NT));       ENDW(t);   RESC(); ROT();
    STEP(pA0,pA1,pB0,pB1,t+1,(t+4<NT),(t+2<NT),(t+2<NT));     ENDW(t+1); RESC(); ROT();
  }
  STEP(pB0,pB1,pA0,pA1,NT-1,false,false,false); RESC();
  { float sacc=pB0[0]+pB0[1]; _Pragma("unroll") for(int r=2;r<16;++r)sacc+=pB0[r]; _Pragma("unroll") for(int r=0;r<16;++r)sacc+=pB1[r]; l_reg+=sacc;
    pw0=(u32x4){PKW(pB0,0),PKW(pB0,2),PKW(pB0,4),PKW(pB0,6)};pw1=(u32x4){PKW(pB0,8),PKW(pB0,10),PKW(pB0,12),PKW(pB0,14)};pw2=(u32x4){PKW(pB1,0),PKW(pB1,2),PKW(pB1,4),PKW(pB1,6)};pw3=(u32x4){PKW(pB1,8),PKW(pB1,10),PKW(pB1,12),PKW(pB1,14)};
    SBAR(); pv(o,vb0+sl_cur,PAF(0),PAF(1),PAF(2),PAF(3)); }
  #undef PKW
  #undef PAF
  #undef VFR
  #undef PIN
  #undef MX3
  #undef GAPA
  #undef GAPB
  #undef EX
  #undef VRD
  #undef KRD
  #undef STEP
  #undef ENDW
  {auto rr=__builtin_amdgcn_permlane32_swap(__float_as_uint(l_reg),__float_as_uint(l_reg),false,false);l_reg=__uint_as_float(rr[0])+__uint_as_float(rr[1]);}
  if(hi==0)wsf[32+r32]=l_reg;asm volatile("s_waitcnt lgkmcnt(0)":::"memory");
  float rli[16];
  #pragma unroll
  for(int r=0;r<16;++r)rli[r]=__builtin_amdgcn_rcpf(wsf[32+crow(r,hi)]);
  bf16*Ow=O+(rowbase+q0+wid*QBLK)*DM+h*D;
  { bf16*stg=(bf16*)(shm+LDS_OST)+wid*2048;
    #pragma unroll
    for(int r=0;r<16;++r){const int orow=crow(r,hi);
      #pragma unroll
      for(int d0=0;d0<2;++d0)stg[orow*64+d0*32+r32]=__float2bfloat16(o[d0][r]*rli[r]);}
    asm volatile("s_waitcnt lgkmcnt(0)":::"memory");
    #pragma unroll
    for(int i=0;i<4;++i){const int row=i*8+(lane>>3),ch=lane&7; const u32x4 v=*(const u32x4*)(stg+row*64+ch*8); ATTN_STORE16(Ow+(long)row*DM+ch*8,v);} }
  asm volatile("s_waitcnt lgkmcnt(0)\n\ts_barrier":::"memory");
  #undef DMA_K
  #undef DMA_V
  #undef CMASK
  #undef START
  #undef RESC
  #undef ROT
  #undef LDBIAS
}
constexpr int ATTN_LDS_BYTES=LDS_BYTES;
#undef SBAR
#undef WAIT_BAR
}

#define GAS __attribute__((address_space(1)))
#define LAS __attribute__((address_space(3)))
typedef unsigned short bf16;
typedef unsigned v4u __attribute__((ext_vector_type(4)));
typedef float f32x4 __attribute__((ext_vector_type(4)));
typedef short bf16x8 __attribute__((ext_vector_type(8)));
typedef GAS unsigned gu32;
typedef GAS unsigned long long gu64;
#define RLX_AGENT __ATOMIC_RELAXED, __HIP_MEMORY_SCOPE_AGENT
#define LDS_WAIT() asm volatile("s_waitcnt lgkmcnt(0)" ::: "memory")
#define VM_WAIT() asm volatile("s_waitcnt vmcnt(0)" ::: "memory")
__device__ __forceinline__ unsigned long long rt() { return __builtin_amdgcn_s_memrealtime(); }
__device__ __forceinline__ unsigned f2bf(float f) { unsigned u = __builtin_bit_cast(unsigned, f); return (u + 0x7fffu + ((u >> 16) & 1u)) >> 16; }
__device__ __forceinline__ unsigned pk2(float lo, float hi) { return f2bf(lo) | (f2bf(hi) << 16); }

#define XB_TMO      128
#define XB_XCNT(j)  (256  + 64 * (j))
#define XB_XSUB(j)  (1280 + 64 * (j))
#define XB_XGEN(j)  (2304 + 64 * (j))
#define XB_TOP      3328
#define XB_TOPGEN   3392
#define XCD_BAR_WORDS 3456
#define XB_SPIN_CAP (1u << 18)

__device__ __forceinline__ unsigned xb_ld(unsigned* p)              { return __hip_atomic_load(p, __ATOMIC_RELAXED, __HIP_MEMORY_SCOPE_AGENT); }
__device__ __forceinline__ unsigned xb_add(unsigned* p, unsigned v) { return __hip_atomic_fetch_add(p, v, __ATOMIC_RELAXED, __HIP_MEMORY_SCOPE_AGENT); }
__device__ __forceinline__ unsigned xb_xcc_id() { return (unsigned)__builtin_amdgcn_s_getreg((3 << 11) | 20) & 0xFu; }
#define XB_SPIN(cond, bar) do { unsigned _sp = 0; while (cond) { __builtin_amdgcn_s_sleep(1); \
    if ((++_sp & 255u) == 0u) { if (xb_ld(&(bar)[XB_TMO])) break; if (_sp > XB_SPIN_CAP) { atomicAdd(&(bar)[XB_TMO], 1u); break; } } } } while (0)

struct XcdBarrier {
    unsigned* bar; unsigned x;
    volatile LAS unsigned* st;
};

__device__ __forceinline__ XcdBarrier xcd_barrier_post(unsigned* bar, volatile LAS unsigned* st) {
    XcdBarrier b; b.bar = bar; b.x = xb_xcc_id(); b.st = st;
    if (threadIdx.x == 0) (void)xb_add(&bar[XB_XCNT(b.x)], 1u);
    return b;
}
__device__ __forceinline__ void xcd_barrier_complete(unsigned* bar, unsigned x, unsigned& nloc, unsigned& nx) {
    const unsigned G = gridDim.x * gridDim.y * gridDim.z;
    unsigned sum, cnt, mine, sp = 0u;
    for (;;) {
        sum = 0u; cnt = 0u; mine = 0u;
#pragma unroll
        for (unsigned j = 0; j < 16; ++j) { const unsigned c = xb_ld(&bar[XB_XCNT(j)]); sum += c; cnt += (c > 0u) ? 1u : 0u; mine = (j == x) ? c : mine; }
        if (sum == G) break;
        __builtin_amdgcn_s_sleep(1);
        if ((++sp & 255u) == 0u) { if (xb_ld(&bar[XB_TMO])) break; if (sp > XB_SPIN_CAP) { atomicAdd(&bar[XB_TMO], 1u); break; } }
    }
    nloc = mine > 0u ? mine : 1u; nx = cnt > 0u ? cnt : 1u;
}

__device__ __forceinline__ void xcd_barrier(const XcdBarrier& b) {
    asm volatile("s_waitcnt vmcnt(0)" ::: "memory");
    __syncthreads();
    int tb_ = threadIdx.x; asm volatile("" : "+v"(tb_));
    if (tb_ == 0) {
        unsigned* bar = b.bar;
        __builtin_amdgcn_s_waitcnt(0);
        unsigned nloc = b.st[0], nx = b.st[1];
        if (nloc == 0u) { xcd_barrier_complete(bar, b.x, nloc, nx); b.st[0] = nloc; b.st[1] = nx; }
        const unsigned old = xb_add(&bar[XB_XSUB(b.x)], 1u);
        const unsigned gen = old / nloc;
        if (old + 1u == (gen + 1u) * nloc) {
            __builtin_amdgcn_fence(__ATOMIC_RELEASE, "agent");
            asm volatile("s_waitcnt vmcnt(0)" ::: "memory");
            const unsigned og = xb_add(&bar[XB_TOP], 1u);
            const unsigned tg = og / nx;
            if (og + 1u == (tg + 1u) * nx) xb_add(&bar[XB_TOPGEN], 1u);
            else XB_SPIN(xb_ld(&bar[XB_TOPGEN]) == tg, bar);
            __builtin_amdgcn_fence(__ATOMIC_ACQUIRE, "agent");
            xb_add(&bar[XB_XGEN(b.x)], 1u);
            asm volatile("s_waitcnt vmcnt(0)" ::: "memory");
        } else {
            XB_SPIN(xb_ld(&bar[XB_XGEN(b.x)]) == gen, bar);
            __builtin_amdgcn_fence(__ATOMIC_ACQUIRE, "agent");
            asm volatile("s_waitcnt vmcnt(0)" ::: "memory");
        }
    }
    __syncthreads();
}

constexpr int NWAVES = 8, NCU = 256;
constexpr int BATCH = 8, SEQ = 2048, D = 1024, TOK = BATCH * SEQ, DEPTH = 2, MEMLEN = 256, FF = 4096;
constexpr int N_IN = 5384, OFF_F = 1792, OFF_C = 1800, OFF_G = 2312;
constexpr float EPSF = 1e-6f, LOG2E = 1.4426950408889634f;
constexpr size_t MiB = 1u << 20;
constexpr size_t WS_CTL = 0, CTL_ZERO_BYTES = 32768;
constexpr size_t WS_SS = 1 * MiB;
constexpr size_t WS_LOGF = 2 * MiB;
constexpr size_t WS_W = 3 * MiB;
constexpr size_t OW_IN = 0, OW_G = OW_IN + (size_t)2304 * 1024 * 2, OW_A = OW_G + (size_t)3072 * 1024 * 2, OW_B = OW_A + (size_t)1024 * 256 * 2, OW_C = OW_B + (size_t)1024 * 512 * 2,
                 OW_OUT = OW_C + (size_t)1024 * 256 * 2, OW_XQ = OW_OUT + (size_t)1024 * 1024 * 2, OW_XKV = OW_XQ + (size_t)1024 * 1024 * 2, OW_XO = OW_XKV + (size_t)2048 * 1024 * 2,
                 OW_FF1 = OW_XO + (size_t)1024 * 1024 * 2, OW_FF2 = OW_FF1 + (size_t)4096 * 1024 * 2, LW = OW_FF2 + (size_t)1024 * 4096 * 2;
static_assert(LW == 40370176 && WS_W + 2 * LW <= 80 * MiB, "weight map");
constexpr size_t WS_XKV1 = 80 * MiB;
constexpr size_t WS_XB = 88 * MiB;
constexpr size_t WS_DYN = 120 * MiB;
constexpr size_t WS_Q = WS_DYN, WS_K = WS_DYN + 16 * MiB, WS_V = WS_DYN + 32 * MiB, WS_PA = WS_DYN + 48 * MiB, WS_DD = WS_DYN + 56 * MiB, WS_ZC = WS_DYN + 64 * MiB,
                 WS_SG = WS_DYN + 80 * MiB, WS_T2 = WS_DYN + 88 * MiB, WS_HM = WS_DYN + 120 * MiB, WS_XKV0 = WS_DYN + 128 * MiB;
constexpr size_t WS_MG = WS_DYN + 16 * MiB;
constexpr size_t WS_PP = WS_DYN + 32 * MiB;
constexpr size_t WS_WK = WS_DYN + 88 * MiB, WS_VW = WS_DYN + 104 * MiB;
constexpr size_t WS_FFH = WS_DYN;
constexpr size_t WS_END = 256 * MiB;
static_assert(WS_XKV0 + 8 * MiB <= WS_END, "d_ws map");
constexpr int CW_TMO = 0, CW_CODE = 1, CW_BAR = 4096;
constexpr int RING_OFF = 0, RING_BYTES = 131072, LDSCTL_OFF = RING_BYTES, MISC_OFF = LDSCTL_OFF + 320, LDS_BYTES = 147456;

template <int CTRL> __device__ __forceinline__ float dppf(float v) { return __uint_as_float(__builtin_amdgcn_update_dpp(0u, __float_as_uint(v), CTRL, 0xf, 0xf, false)); }
__device__ __forceinline__ float wave_sum(float v) {
    v += dppf<0xB1>(v); v += dppf<0x4E>(v); v += dppf<0x141>(v); v += dppf<0x140>(v);
    v = pg8::comb16<false>(v); v = pg8::comb32<false>(v);
    return v;
}
__device__ __forceinline__ float wave_scan(float v) {
    v += dppf<0x111>(v); v += dppf<0x112>(v); v += dppf<0x114>(v); v += dppf<0x118>(v);
    v += __uint_as_float(__builtin_amdgcn_update_dpp(0u, __float_as_uint(v), 0x142, 0xa, 0xf, false));
    v += __uint_as_float(__builtin_amdgcn_update_dpp(0u, __float_as_uint(v), 0x143, 0xc, 0xf, false));
    return v;
}

struct Frame {
    LAS unsigned char* lds;
    volatile LAS unsigned* MISC;
    gu32* ctl;
    int tid, lane, wave, vcu, G;
    float* out; unsigned char* ws;
};
constexpr int PTRS_OFF = LDSCTL_OFF + 512;
__device__ __forceinline__ const float* inp(const Frame& F, int i) {
    const unsigned long long v = *(volatile LAS unsigned long long*)(F.lds + PTRS_OFF + 8 * i);
    const unsigned lo = __builtin_amdgcn_readfirstlane((unsigned)v), hi = __builtin_amdgcn_readfirstlane((unsigned)(v >> 32));
    return (const float*)(const GAS float*)(((unsigned long long)hi << 32) | lo); }
__device__ __forceinline__ bf16* wsb(const Frame& F, size_t off) { return (bf16*)(F.ws + off); }
__device__ __forceinline__ bf16* wlay(const Frame& F, int l, size_t off) { return (bf16*)(F.ws + WS_W + (size_t)l * LW + off); }

__device__ __forceinline__ void tr_item(const float* W, int ldw, int K, int scol0, bf16* WT, int drow0, const float* gain, LAS float* scr, int kb, int nb, int lane) {
    const int k0 = 64 * kb, n0 = 32 * nb;
    float vv[32];
#pragma unroll
    for (int i = 0; i < 32; ++i) vv[i] = W[(size_t)(k0 + 2 * i + (lane >> 5)) * ldw + scol0 + n0 + (lane & 31)];
    if (gain) {
#pragma unroll
        for (int i = 0; i < 32; ++i) vv[i] *= gain[k0 + 2 * i + (lane >> 5)];
    }
#pragma unroll
    for (int i = 0; i < 32; ++i) scr[(2 * i + (lane >> 5)) * 33 + (lane & 31)] = vv[i];
    LDS_WAIT(); asm volatile("" ::: "memory");
    const int c = lane & 7;
#pragma unroll
    for (int j = 0; j < 4; ++j) { const int n = (lane >> 3) + 8 * j; const LAS float* s = scr + (8 * c) * 33 + n;
        v4u o; o.x = pk2(s[0 * 33], s[1 * 33]); o.y = pk2(s[2 * 33], s[3 * 33]); o.z = pk2(s[4 * 33], s[5 * 33]); o.w = pk2(s[6 * 33], s[7 * 33]);
        *(GAS v4u*)(WT + (size_t)(drow0 + n0 + n) * K + k0 + 8 * c) = o; }
    LDS_WAIT(); asm volatile("" ::: "memory");
}
constexpr int I_IN1 = 16 * 56, I_IN2 = 16 * 16, I_G = 16 * 96, I_B = 8 * 32, I_C = 4 * 32, I_OUT = 16 * 32, I_XKV = 16 * 64, I_XO = 16 * 32, I_FF1 = 16 * 128, I_FF2 = 64 * 32;
constexpr int I_LAYER = I_IN1 + I_IN2 + I_G + I_B + I_C + I_OUT + I_XKV + I_XO + I_FF1 + I_FF2;

__device__ __forceinline__ void p0_prologue(Frame& F) {
    LAS float* scr = (LAS float*)(F.lds + RING_OFF + F.wave * 16384);
    const int gw = F.vcu * NWAVES + F.wave, NGW = F.G * NWAVES, lane = F.lane;
    for (int it = gw; it < DEPTH * I_LAYER; it += NGW) {
        const int l = it / I_LAYER; int r = it % I_LAYER;
        const float* w_in = inp(F, 3) + (size_t)l * D * N_IN;
        if (r < I_IN1) { tr_item(w_in, N_IN, D, 0, wlay(F, l, OW_IN), 0, inp(F, 2) + l * D, scr, r / 56, r % 56, lane); continue; } r -= I_IN1;
        if (r < I_IN2) { tr_item(w_in, N_IN, D, OFF_C, wlay(F, l, OW_IN), 1792, inp(F, 2) + l * D, scr, r / 16, r % 16, lane); continue; } r -= I_IN2;
        if (r < I_G) { tr_item(w_in, N_IN, D, OFF_G, wlay(F, l, OW_G), 0, inp(F, 2) + l * D, scr, r / 96, r % 96, lane); continue; } r -= I_G;
        if (r < I_B) { tr_item(inp(F, 11) + (size_t)l * 512 * D, D, 512, 0, wlay(F, l, OW_B), 0, nullptr, scr, r / 32, r % 32, lane); continue; } r -= I_B;
        if (r < I_C) { tr_item(inp(F, 12) + (size_t)l * 256 * D, D, 256, 0, wlay(F, l, OW_C), 0, nullptr, scr, r / 32, r % 32, lane); continue; } r -= I_C;
        if (r < I_OUT) { tr_item(inp(F, 14) + (size_t)l * D * D, D, D, 0, wlay(F, l, OW_OUT), 0, nullptr, scr, r / 32, r % 32, lane); continue; } r -= I_OUT;
        if (r < I_XKV) { tr_item(inp(F, 18) + (size_t)l * D * 2 * D, 2 * D, D, 0, wlay(F, l, OW_XKV), 0, nullptr, scr, r / 64, r % 64, lane); continue; } r -= I_XKV;
        if (r < I_XO) { tr_item(inp(F, 19) + (size_t)l * D * D, D, D, 0, wlay(F, l, OW_XO), 0, nullptr, scr, r / 32, r % 32, lane); continue; } r -= I_XO;
        if (r < I_FF1) { tr_item(inp(F, 21) + (size_t)l * D * FF, FF, D, 0, wlay(F, l, OW_FF1), 0, inp(F, 20) + l * D, scr, r / 128, r % 128, lane); continue; } r -= I_FF1;
        tr_item(inp(F, 22) + (size_t)l * FF * D, D, FF, 0, wlay(F, l, OW_FF2), 0, nullptr, scr, r / 32, r % 32, lane);
    }
    for (int it = gw; it < DEPTH * 256 * 16; it += NGW) {
        const int l = it / 4096, r = it % 4096, cp = r / 16, n = (r % 16) * 64 + lane, g = cp >> 6;
        const float* pw = inp(F, 5) + ((size_t)l * 256 + cp) * 64; const float* ps = inp(F, 6) + l * 256 + g * 64; const float* wa = inp(F, 10) + ((size_t)l * 256 + g * 64) * D + n;
        float a = 0.f;
#pragma unroll 8
        for (int d = 0; d < 64; ++d) a += pw[d] * ps[d] * wa[(size_t)d * D];
        wlay(F, l, OW_A)[(size_t)n * 256 + cp] = (bf16)f2bf(a);
    }
    for (int it = gw; it < DEPTH * D; it += NGW) {
        const int l = it / D, k = it % D; const float gk = (inp(F, 15) + l * D)[k] * (0.0625f * LOG2E);
        const GAS f32x4* wr_ = (const GAS f32x4*)(inp(F, 17) + ((size_t)l * D + k) * D) + lane;
        GAS unsigned long long* o8 = (GAS unsigned long long*)(wlay(F, l, OW_XQ) + (size_t)k * D) + lane;
#pragma unroll
        for (int j = 0; j < 4; ++j) { const f32x4 v = wr_[64 * j] * gk; o8[64 * j] = (unsigned long long)pk2(v.x, v.y) | ((unsigned long long)pk2(v.z, v.w) << 32); }
    }
    for (int it = gw; it < DEPTH * BATCH * MEMLEN; it += NGW) {
        const int l = it / (BATCH * MEMLEN), m = it % (BATCH * MEMLEN);
        const GAS f32x4* xr = (const GAS f32x4*)(inp(F, 1) + (size_t)m * D) + lane; const GAS f32x4* gr = (const GAS f32x4*)(inp(F, 16) + l * D) + lane;
        f32x4 v[4]; float s = 0.f;
#pragma unroll
        for (int j = 0; j < 4; ++j) { v[j] = xr[64 * j]; s += (v[j].x * v[j].x + v[j].y * v[j].y) + (v[j].z * v[j].z + v[j].w * v[j].w); }
        const float rstd = 1.0f / sqrtf(wave_sum(s) * (1.f / D) + EPSF);
        GAS unsigned long long* o8 = (GAS unsigned long long*)(wsb(F, WS_HM) + ((size_t)l * BATCH * MEMLEN + m) * D) + lane;
#pragma unroll
        for (int j = 0; j < 4; ++j) { const f32x4 g = gr[64 * j]; o8[64 * j] = (unsigned long long)pk2(v[j].x * rstd * g.x, v[j].y * rstd * g.y) | ((unsigned long long)pk2(v[j].z * rstd * g.z, v[j].w * rstd * g.w) << 32); }
    }
    for (int m = gw; m < TOK; m += NGW) {
        const GAS f32x4* xr = (const GAS f32x4*)(inp(F, 0) + (size_t)m * D) + lane;
        f32x4 v[4]; float s = 0.f;
#pragma unroll
        for (int j = 0; j < 4; ++j) { v[j] = xr[64 * j]; s += (v[j].x * v[j].x + v[j].y * v[j].y) + (v[j].z * v[j].z + v[j].w * v[j].w); }
        s = wave_sum(s);
        GAS unsigned long long* o8 = (GAS unsigned long long*)(wsb(F, WS_XB) + (size_t)m * D) + lane;
#pragma unroll
        for (int j = 0; j < 4; ++j) o8[64 * j] = (unsigned long long)pk2(v[j].x, v[j].y) | ((unsigned long long)pk2(v[j].z, v[j].w) << 32);
        if (lane < 16) ((float*)(F.ws + WS_SS))[(size_t)m * 16 + lane] = lane == 0 ? s : 0.f;
    }
}

__device__ __forceinline__ float row_rstd(const Frame& F, int row) {
    const f32x4* p = (const f32x4*)((const float*)(F.ws + WS_SS) + (size_t)row * 16);
    const f32x4 a = p[0], b = p[1], c = p[2], d = p[3];
    const float s = ((a[0] + a[1]) + (a[2] + a[3])) + ((b[0] + b[1]) + (b[2] + b[3])) + ((c[0] + c[1]) + (c[2] + c[3])) + ((d[0] + d[1]) + (d[2] + d[3]));
    return 1.0f / sqrtf(s * (1.f / D) + EPSF);
}

__device__ __forceinline__ void logf_pass(Frame& F, int l) {
    const int gw = F.vcu * NWAVES + F.wave, NGW = F.G * NWAVES, lane = F.lane;
    LAS float* WF = (LAS float*)(F.lds + RING_OFF);
    {
        const float* w_in = inp(F, 3) + (size_t)l * D * N_IN; const float* g = inp(F, 2) + l * D;
#pragma unroll
        for (int i = 0; i < 2; ++i) { const int k = F.tid + 512 * i; const float gk = g[k]; const float* p = w_in + (size_t)k * N_IN + OFF_F;
            const f32x4 a = *(const f32x4*)p * gk, b = *(const f32x4*)(p + 4) * gk;
            LAS f32x4* dst = (LAS f32x4*)(WF + (k >> 4) * 132 + (k & 15) * 8); dst[0] = a; dst[1] = b; }
    }
    LDS_WAIT(); __syncthreads();
    const float bfl = (lane < 8) ? (inp(F, 4) + l * 8)[lane] : 0.f;
    float* LOGF = (float*)(F.ws + WS_LOGF);
    const LAS f32x4* wl = (const LAS f32x4*)(WF + lane * 132);
    static_assert(TOK == 8 * NCU * NWAVES, "one wave takes exactly 8 rows");
#pragma unroll 1
    for (int i4 = 0; i4 < 8; i4 += 4) {
        v4u xa[4], xb_[4]; f32x4 sq[4];
#pragma unroll
        for (int i = 0; i < 4; ++i) { const int m = gw + NGW * (i4 + i); const v4u* xp = (const v4u*)(wsb(F, WS_XB) + (size_t)m * D + 16 * lane); xa[i] = xp[0]; xb_[i] = xp[1];
            sq[i] = *((const f32x4*)((const float*)(F.ws + WS_SS) + (size_t)m * 16) + (lane & 3)); }
#pragma unroll
        for (int i = 0; i < 4; ++i) { const int m = gw + NGW * (i4 + i); const v4u x0 = xa[i], x1 = xb_[i];
            float xv[16];
            xv[0] = __uint_as_float(x0.x << 16); xv[1] = __uint_as_float(x0.x & 0xffff0000u); xv[2] = __uint_as_float(x0.y << 16); xv[3] = __uint_as_float(x0.y & 0xffff0000u);
            xv[4] = __uint_as_float(x0.z << 16); xv[5] = __uint_as_float(x0.z & 0xffff0000u); xv[6] = __uint_as_float(x0.w << 16); xv[7] = __uint_as_float(x0.w & 0xffff0000u);
            xv[8] = __uint_as_float(x1.x << 16); xv[9] = __uint_as_float(x1.x & 0xffff0000u); xv[10] = __uint_as_float(x1.y << 16); xv[11] = __uint_as_float(x1.y & 0xffff0000u);
            xv[12] = __uint_as_float(x1.z << 16); xv[13] = __uint_as_float(x1.z & 0xffff0000u); xv[14] = __uint_as_float(x1.w << 16); xv[15] = __uint_as_float(x1.w & 0xffff0000u);
            f32x4 a0 = (f32x4){0.f, 0.f, 0.f, 0.f}, a1 = a0;
#pragma unroll
            for (int j = 0; j < 16; ++j) { a0 += wl[2 * j] * xv[j]; a1 += wl[2 * j + 1] * xv[j]; }
            float d[8] = {a0[0], a0[1], a0[2], a0[3], a1[0], a1[1], a1[2], a1[3]};
#pragma unroll
            for (int h = 0; h < 8; ++h) d[h] = wave_sum(d[h]);
            float ssum = (sq[i][0] + sq[i][1]) + (sq[i][2] + sq[i][3]); ssum += dppf<0xB1>(ssum); ssum += dppf<0x4E>(ssum);
            const float rstd = 1.0f / sqrtf(ssum * (1.f / D) + EPSF);
            if (lane < 8) {
                float dv = d[0];
#pragma unroll
                for (int h = 1; h < 8; ++h) dv = (lane == h) ? d[h] : dv;
                const float z = dv * rstd + bfl;
                const float ls = fminf(z, 0.f) - 0.6931471805599453f * __builtin_amdgcn_logf(1.0f + __builtin_amdgcn_exp2f(-LOG2E * fabsf(z)));
                LOGF[((size_t)(m / SEQ) * 8 + lane) * SEQ + (m % SEQ)] = ls;
            }
        }
    }
    LDS_WAIT(); __syncthreads();
}

__device__ __forceinline__ void cumsum_bias(Frame& F, int bh, LAS float* nb, LAS float* scr) {
    const f32x4 v = *((const f32x4*)((const float*)(F.ws + WS_LOGF) + (size_t)bh * SEQ) + F.tid);
    const float p0 = v[0], p1 = p0 + v[1], p2 = p1 + v[2], p3 = p2 + v[3];
    const float incl = wave_scan(p3);
    if (F.lane == 63) scr[F.wave] = incl;
    LDS_WAIT(); __syncthreads();
    float woff = 0.f;
#pragma unroll
    for (int w = 0; w < 8; ++w) woff += (w < F.wave) ? scr[w] : 0.f;
    const float base = woff + (incl - p3);
    *((LAS f32x4*)nb + F.tid) = (f32x4){-(base + p0) * LOG2E, -(base + p1) * LOG2E, -(base + p2) * LOG2E, -(base + p3) * LOG2E};
    LDS_WAIT(); __syncthreads();
}

__device__ __forceinline__ void pool_diff(Frame& F) {
    const bf16* PA = wsb(F, WS_PA); bf16* DD = wsb(F, WS_DD);
    const int ch = F.tid & 31, seg = F.tid >> 5, g = ch >> 3, win = 2 << g, r0 = 64 * F.vcu + 4 * seg, tl0 = r0 & (SEQ - 1);
    v4u a[19];
#pragma unroll
    for (int i = 0; i < 19; ++i) { const int dt = i - 15;
        a[i] = (tl0 + dt >= 0) ? *(const v4u*)(PA + (size_t)(r0 + dt) * 256 + 8 * ch) : (v4u){0u, 0u, 0u, 0u}; }
    float s[8] = {0.f, 0.f, 0.f, 0.f, 0.f, 0.f, 0.f, 0.f};
#define PD_ACC(W, SG) do { s[0] += SG __uint_as_float((W).x << 16); s[1] += SG __uint_as_float((W).x & 0xffff0000u); s[2] += SG __uint_as_float((W).y << 16); s[3] += SG __uint_as_float((W).y & 0xffff0000u); \
        s[4] += SG __uint_as_float((W).z << 16); s[5] += SG __uint_as_float((W).z & 0xffff0000u); s[6] += SG __uint_as_float((W).w << 16); s[7] += SG __uint_as_float((W).w & 0xffff0000u); } while (0)
#pragma unroll
    for (int k = 0; k < 16; ++k) if (k < win) PD_ACC(a[15 - k], +);
#pragma unroll
    for (int o = 0; o < 4; ++o) {
        if (o > 0) { PD_ACC(a[15 + o], +);
            const v4u old = (g == 0) ? a[13 + o] : (g == 1) ? a[11 + o] : (g == 2) ? a[7 + o] : a[o - 1]; PD_ACC(old, -); }
        const int tl = tl0 + o; const float inv = 1.0f / (float)((tl + 1 < win) ? tl + 1 : win);
        const v4u cur = a[15 + o]; v4u w;
        w.x = pk2(s[0] * inv - __uint_as_float(cur.x << 16), s[1] * inv - __uint_as_float(cur.x & 0xffff0000u));
        w.y = pk2(s[2] * inv - __uint_as_float(cur.y << 16), s[3] * inv - __uint_as_float(cur.y & 0xffff0000u));
        w.z = pk2(s[4] * inv - __uint_as_float(cur.z << 16), s[5] * inv - __uint_as_float(cur.z & 0xffff0000u));
        w.w = pk2(s[6] * inv - __uint_as_float(cur.w << 16), s[7] * inv - __uint_as_float(cur.w & 0xffff0000u));
        *(v4u*)(DD + (size_t)(r0 + o) * 256 + 8 * ch) = w;
    }
#undef PD_ACC
}

__device__ __forceinline__ void sgu_unit(Frame& F, int l, int unit) {
    const int chunk = unit >> 2, g = unit & 3, row0 = chunk * 128, lane = F.lane, w = F.wave;
    const bf16* ZC = wsb(F, WS_ZC); bf16* SG = wsb(F, WS_SG);
    LAS bf16* vnT = (LAS bf16*)(F.lds + RING_OFF);
    const float* gain = inp(F, 7) + l * 256;
    const float g0 = gain[4 * lane], g1 = gain[4 * lane + 1], g2 = gain[4 * lane + 2], g3 = gain[4 * lane + 3];
    unsigned long long qv[16];
#pragma unroll
    for (int i = 0; i < 16; ++i) qv[i] = *(const unsigned long long*)(ZC + (size_t)(row0 + 16 * w + i) * 512 + 256 + 4 * lane);
#pragma unroll
    for (int i = 0; i < 16; ++i) {
        const int s = 16 * w + i;
        const unsigned long long q = qv[i];
        const unsigned lo = (unsigned)q, hi = (unsigned)(q >> 32);
        const float v0 = __uint_as_float(lo << 16), v1 = __uint_as_float(lo & 0xffff0000u), v2 = __uint_as_float(hi << 16), v3 = __uint_as_float(hi & 0xffff0000u);
        const float ss = wave_sum((v0 * v0 + v1 * v1) + (v2 * v2 + v3 * v3));
        const float r = 1.0f / sqrtf(ss * (1.f / 256.f) + EPSF);
        if ((lane >> 4) == g) { const int d = 4 * (lane & 15);
            vnT[(d + 0) * 136 + s] = (bf16)f2bf(v0 * r * g0); vnT[(d + 1) * 136 + s] = (bf16)f2bf(v1 * r * g1); vnT[(d + 2) * 136 + s] = (bf16)f2bf(v2 * r * g2); vnT[(d + 3) * 136 + s] = (bf16)f2bf(v3 * r * g3); }
    }
    LDS_WAIT(); __syncthreads();
    const float* Wg = inp(F, 8) + ((size_t)(l * 4 + g) * 128) * 128;
    const int t = 16 * w + (lane & 15), kq = lane >> 4;
    f32x4 acc[4];
#pragma unroll
    for (int n = 0; n < 4; ++n) acc[n] = (f32x4){0.f, 0.f, 0.f, 0.f};
#pragma unroll
    for (int kk = 0; kk < 4; ++kk) {
        if (32 * kk <= 16 * w + 15) {
            const int s0 = 32 * kk + 8 * kq;
            const f32x4 wa = *(const f32x4*)(Wg + (size_t)t * 128 + s0), wb = *(const f32x4*)(Wg + (size_t)t * 128 + s0 + 4);
            float wv[8] = {wa[0], wa[1], wa[2], wa[3], wb[0], wb[1], wb[2], wb[3]};
#pragma unroll
            for (int j = 0; j < 8; ++j) wv[j] = (s0 + j <= t) ? wv[j] : 0.f;
            v4u bw; bw.x = pk2(wv[0], wv[1]); bw.y = pk2(wv[2], wv[3]); bw.z = pk2(wv[4], wv[5]); bw.w = pk2(wv[6], wv[7]);
            const bf16x8 bfrag = __builtin_bit_cast(bf16x8, bw);
#pragma unroll
            for (int n = 0; n < 4; ++n) { const bf16x8 afrag = *(const LAS bf16x8*)(vnT + (16 * n + (lane & 15)) * 136 + s0);
                acc[n] = __builtin_amdgcn_mfma_f32_16x16x32_bf16(afrag, bfrag, acc[n], 0, 0, 0); }
        }
    }
    const float bt = inp(F, 9)[(l * 4 + g) * 128 + t];
#pragma unroll
    for (int n = 0; n < 4; ++n) { const int d = 64 * g + 16 * n + 4 * kq;
        const unsigned long long q = *(const unsigned long long*)(ZC + (size_t)(row0 + t) * 512 + d);
        const unsigned lo = (unsigned)q, hi = (unsigned)(q >> 32);
        const float o0 = __uint_as_float(lo << 16) * (acc[n][0] + bt), o1 = __uint_as_float(lo & 0xffff0000u) * (acc[n][1] + bt), o2 = __uint_as_float(hi << 16) * (acc[n][2] + bt), o3 = __uint_as_float(hi & 0xffff0000u) * (acc[n][3] + bt);
        *(unsigned long long*)(SG + (size_t)(row0 + t) * 256 + d) = (unsigned long long)pk2(o0, o1) | ((unsigned long long)pk2(o2, o3) << 32); }
    LDS_WAIT(); __syncthreads();
}

__device__ __forceinline__ void final_norm(Frame& F) {
    const int gw = F.vcu * NWAVES + F.wave, NGW = F.G * NWAVES, lane = F.lane;
    const GAS f32x4* gr = (const GAS f32x4*)inp(F, 23) + lane;
    for (int m = gw; m < TOK; m += NGW) {
        const float rstd = row_rstd(F, m);
        GAS f32x4* xr = (GAS f32x4*)(F.out + (size_t)m * D) + lane;
#pragma unroll
        for (int j = 0; j < 4; ++j) { const f32x4 v = xr[64 * j]; xr[64 * j] = v * rstd * gr[64 * j]; }
    }
}

struct Args { const float* in[24]; float* out; unsigned char* ws; };
__global__ void __launch_bounds__(NWAVES * 64, 2) mega_fwd(Args args) {
    extern __shared__ __attribute__((aligned(16))) unsigned char lds[];
    Frame F;
    F.lds = (LAS unsigned char*)lds;
    F.MISC = (volatile LAS unsigned*)(F.lds + MISC_OFF);
    int c = 0;
#define REFRESH() do { int t_ = threadIdx.x, b_ = blockIdx.x; asm volatile("" : "+v"(t_)); asm volatile("" : "+s"(b_)); F.tid = t_; F.lane = t_ & 63; F.wave = __builtin_amdgcn_readfirstlane(t_ >> 6); \
        F.G = NCU; F.vcu = (b_ % 8) * (NCU / 8) + b_ / 8; c = b_; \
        unsigned lb_ = (unsigned)(uintptr_t)(LAS unsigned char*)lds; asm volatile("" : "+s"(lb_)); F.lds = (LAS unsigned char*)(uintptr_t)lb_; F.MISC = (volatile LAS unsigned*)(F.lds + MISC_OFF); } while (0)
    REFRESH();
    F.ws = args.ws; F.out = args.out; F.ctl = (gu32*)(args.ws + WS_CTL);
    for (int u = F.tid; u < (LDS_BYTES - LDSCTL_OFF) / 4; u += NWAVES * 64) ((LAS unsigned*)(F.lds + LDSCTL_OFF))[u] = 0u;
    __syncthreads();
    if (F.tid < 24) *(LAS unsigned long long*)(F.lds + PTRS_OFF + 8 * F.tid) = (unsigned long long)args.in[F.tid];
    LDS_WAIT(); __syncthreads();
    (void)xcd_barrier_post((unsigned*)(F.ctl + CW_BAR), F.MISC + 8);
#define GRID_BAR() do { XcdBarrier b_; b_.bar = (unsigned*)(F.ws + WS_CTL) + CW_BAR; b_.x = xb_xcc_id(); asm volatile("" : "+s"(b_.x)); b_.st = F.MISC + 8; REP(9) xcd_barrier(b_); } while (0)
    float* SS = (float*)(F.ws + WS_SS);

#ifndef PROBE
#define PROBE 0
#endif
#define REP(n) for (int rep_ = 0; rep_ < ((PROBE == (n)) ? 2 : 1); ++rep_)
    REP(1) p0_prologue(F);
    GRID_BAR();
    for (int l = 0; l < DEPTH; ++l) {
        REFRESH();
        REP(2) logf_pass(F, l);
        REP(3)
        { pg8::GemmProj g{wsb(F, WS_XB), wlay(F, l, OW_IN), wsb(F, WS_HM), wlay(F, 0, OW_XKV), LW / 2, D, D, D};
          pg8::StaticOrder S; S.init(TOK, l == 0 ? 11 * 256 : 9 * 256, F.G, c);
          pg8::EpiProj E{wsb(F, WS_PA), wsb(F, WS_Q), wsb(F, WS_K), wsb(F, WS_V), wsb(F, WS_ZC), SS, attn_body::C2, wsb(F, WS_XKV0), wsb(F, WS_XKV1)};
          pg8::gemm_phase<pg8::EpiProj, pg8::StaticOrder, pg8::GemmProj, true, true>(F.lds + RING_OFF, g, S, E); }
        GRID_BAR();
        REFRESH();
        {
            const int bh = F.vcu >> 2, s4 = F.vcu & 3;
            LAS float* nb = (LAS float*)(F.lds + RING_OFF + attn_body::LDS_NB);
            cumsum_bias(F, bh, nb, (LAS float*)(F.lds + RING_OFF + attn_body::LDS_NB + 8192));
#if PROBE == 4
            attn_body::attn_unit<8>(bh >> 3, bh & 7, 7 - s4, (const attn_body::bf16*)wsb(F, WS_Q), (const attn_body::bf16*)wsb(F, WS_K), (const attn_body::bf16*)wsb(F, WS_V), (attn_body::bf16*)wsb(F, WS_T2), (char*)F.lds + RING_OFF);
            attn_body::attn_unit<8>(bh >> 3, bh & 7, s4, (const attn_body::bf16*)wsb(F, WS_Q), (const attn_body::bf16*)wsb(F, WS_K), (const attn_body::bf16*)wsb(F, WS_V), (attn_body::bf16*)wsb(F, WS_T2), (char*)F.lds + RING_OFF);
#endif
            attn_body::attn_unit<8>(bh >> 3, bh & 7, 7 - s4, (const attn_body::bf16*)wsb(F, WS_Q), (const attn_body::bf16*)wsb(F, WS_K), (const attn_body::bf16*)wsb(F, WS_V), (attn_body::bf16*)wsb(F, WS_Q), (char*)F.lds + RING_OFF);
            attn_body::attn_unit<8>(bh >> 3, bh & 7, s4, (const attn_body::bf16*)wsb(F, WS_Q), (const attn_body::bf16*)wsb(F, WS_K), (const attn_body::bf16*)wsb(F, WS_V), (attn_body::bf16*)wsb(F, WS_Q), (char*)F.lds + RING_OFF);
            REP(5) { pool_diff(F); sgu_unit(F, l, 2 * F.vcu); sgu_unit(F, l, 2 * F.vcu + 1); }
        }
        GRID_BAR();
        REFRESH();
        REP(6) {
            pg8::StaticOrder S; S.init(TOK, D, F.G, c);
            const float* bg = inp(F, 13) + (size_t)l * 3 * D;
            { pg8::GemmP g{wsb(F, WS_DD), wlay(F, l, OW_A), 256, 256, 256}; pg8::EpiStore<0, false, false> E{wsb(F, WS_T2), D, nullptr, 1.f};
              pg8::gemm_phase<pg8::EpiStore<0, false, false>, pg8::StaticOrder, pg8::GemmP, true, true>(F.lds + RING_OFF, g, S, E); }
            { pg8::GemmP g{wsb(F, WS_XB), wlay(F, l, OW_G), D, D, D}; pg8::EpiGate<true> E{wsb(F, WS_T2), wsb(F, WS_MG), bg, SS};
              pg8::gemm_phase<pg8::EpiGate<true>, pg8::StaticOrder, pg8::GemmP, true, true>(F.lds + RING_OFF, g, S, E); }
            { pg8::GemmP g{wsb(F, WS_Q), wlay(F, l, OW_B), 512, 512, 512}; pg8::EpiStore<0, false, false> E{wsb(F, WS_T2), D, nullptr, 1.f};
              pg8::gemm_phase<pg8::EpiStore<0, false, false>, pg8::StaticOrder, pg8::GemmP, true, true>(F.lds + RING_OFF, g, S, E); }
            { pg8::GemmP g{wsb(F, WS_XB), wlay(F, l, OW_G) + (size_t)D * D, D, D, D}; pg8::EpiGate<false> E{wsb(F, WS_T2), wsb(F, WS_MG), bg + D, SS};
              pg8::gemm_phase<pg8::EpiGate<false>, pg8::StaticOrder, pg8::GemmP, true, true>(F.lds + RING_OFF, g, S, E); }
            { pg8::GemmP g{wsb(F, WS_SG), wlay(F, l, OW_C), 256, 256, 256}; pg8::EpiStore<0, false, false> E{wsb(F, WS_T2), D, nullptr, 1.f};
              pg8::gemm_phase<pg8::EpiStore<0, false, false>, pg8::StaticOrder, pg8::GemmP, true, true>(F.lds + RING_OFF, g, S, E); }
            { pg8::GemmP g{wsb(F, WS_XB), wlay(F, l, OW_G) + (size_t)2 * D * D, D, D, D}; pg8::EpiGate<false> E{wsb(F, WS_T2), wsb(F, WS_MG), bg + 2 * D, SS};
              pg8::gemm_phase<pg8::EpiGate<false>, pg8::StaticOrder, pg8::GemmP, true, true>(F.lds + RING_OFF, g, S, E); }
        }
        GRID_BAR();
        REFRESH();
        { pg8::GemmP g{wsb(F, WS_MG), wlay(F, l, OW_OUT), D, D, D}; pg8::StaticOrder S; S.init(TOK, D, F.G, c); pg8::EpiRes E{wsb(F, WS_XB), nullptr, SS};
          pg8::gemm_phase<pg8::EpiRes, pg8::StaticOrder, pg8::GemmP, true, true>(F.lds + RING_OFF, g, S, E); }
        { int kf = 256; asm volatile("" : "+s"(kf));
          pg8::GemmFold g{wsb(F, l == 0 ? WS_XKV0 : WS_XKV1), wlay(F, l, OW_XQ), wlay(F, l, OW_XO), kf}; pg8::StaticOrder S; S.init(64 * 256, 4 * 256, F.G, c); pg8::EpiFold E{wsb(F, WS_WK), wsb(F, WS_VW)};
          pg8::gemm_phase<pg8::EpiFold, pg8::StaticOrder, pg8::GemmFold, true, true>(F.lds + RING_OFF, g, S, E); }
        GRID_BAR();
        REFRESH();
        REP(7) { pg8::GemmBB g{wsb(F, WS_XB), wsb(F, WS_WK), D, D, D}; pg8::StaticOrder S; S.init(TOK, D, F.G, c); pg8::EpiSoftmaxR E{wsb(F, WS_PP), SS};
          pg8::gemm_phase<pg8::EpiSoftmaxR, pg8::StaticOrder, pg8::GemmBB, false, true>(F.lds + RING_OFF, g, S, E); }
        GRID_BAR();
        REFRESH();
        { pg8::GemmBB g{wsb(F, WS_PP), wsb(F, WS_VW), D, D, D}; pg8::StaticOrder S; S.init(TOK, D, F.G, c); pg8::EpiRes E{wsb(F, WS_XB), nullptr, SS};
          pg8::gemm_phase<pg8::EpiRes, pg8::StaticOrder, pg8::GemmBB, true, true>(F.lds + RING_OFF, g, S, E); }
        GRID_BAR();
        REFRESH();
#if PROBE == 10
        { pg8::GemmP g{wsb(F, WS_XB), wlay(F, l, OW_FF1), D, D, D}; pg8::StaticOrder S; S.init(TOK, FF, F.G, c); pg8::EpiNop E{};
          pg8::gemm_phase<pg8::EpiNop, pg8::StaticOrder, pg8::GemmP, true, true>(F.lds + RING_OFF, g, S, E); }
#endif
        REP(8) { pg8::GemmP g{wsb(F, WS_XB), wlay(F, l, OW_FF1), D, D, D}; pg8::StaticOrder S; S.init(TOK, FF, F.G, c); pg8::EpiStore<1, true, false> E{wsb(F, WS_FFH), FF, SS, 1.f};
          pg8::gemm_phase<pg8::EpiStore<1, true, false>, pg8::StaticOrder, pg8::GemmP, true, true>(F.lds + RING_OFF, g, S, E); }
        GRID_BAR();
        REFRESH();
        { pg8::GemmP g{wsb(F, WS_FFH), wlay(F, l, OW_FF2), FF, FF, FF}; pg8::StaticOrder S; S.init(TOK, D, F.G, c); pg8::EpiRes E{wsb(F, WS_XB), (l == DEPTH - 1) ? F.out : nullptr, SS};
          pg8::gemm_phase<pg8::EpiRes, pg8::StaticOrder, pg8::GemmP, true, true>(F.lds + RING_OFF, g, S, E); }
        GRID_BAR();
    }
    REFRESH();
    final_norm(F);
    if (__hip_atomic_load((gu32*)((unsigned*)(F.ctl + CW_BAR) + XB_TMO), RLX_AGENT) != 0u && blockIdx.x == 0 && F.tid < 64) F.out[F.tid] = __builtin_nanf("");
}

extern "C" void kernel_launch(void* const* d_in, const int* in_sizes, int n_in, void* d_out, int out_size, void* d_ws, size_t ws_size, hipStream_t stream) {
    static int grid = 0;
    if (grid == 0) {
        if (n_in != 24 || out_size != TOK * D || ws_size < WS_END) { fprintf(stderr, "kernel_launch: unexpected problem shape (n_in %d, out %d, ws %zu); nothing launched\n", n_in, out_size, ws_size); grid = -1; return; }
        int dev = 0, cus = 0;
        if (hipGetDevice(&dev) != hipSuccess || hipDeviceGetAttribute(&cus, hipDeviceAttributeMultiprocessorCount, dev) != hipSuccess) { grid = -1; return; }
        if (hipFuncSetAttribute((const void*)mega_fwd, hipFuncAttributeMaxDynamicSharedMemorySize, LDS_BYTES) != hipSuccess) { fprintf(stderr, "kernel_launch: hipFuncSetAttribute failed\n"); grid = -1; return; }
        int per_cu = 0;
        if (hipOccupancyMaxActiveBlocksPerMultiprocessor(&per_cu, (const void*)mega_fwd, NWAVES * 64, LDS_BYTES) != hipSuccess || per_cu < 1) fprintf(stderr, "kernel_launch: occupancy query reports %d workgroups per CU\n", per_cu);
        (void)hipGetLastError();
        if (cus != 256) fprintf(stderr, "kernel_launch: built for a 256-CU device, found %d CUs\n", cus);
        grid = NCU;
    }
    if (grid < 0) return;
    (void)in_sizes;
    if (hipMemsetAsync((char*)d_ws + WS_CTL, 0, CTL_ZERO_BYTES, stream) != hipSuccess) return;
    Args a{};
    for (int i = 0; i < 24; ++i) a.in[i] = (const float*)d_in[i];
    a.out = (float*)d_out; a.ws = (unsigned char*)d_ws;
    hipLaunchKernelGGL(mega_fwd, dim3(grid), dim3(NWAVES * 64), LDS_BYTES, stream, a);
}
```
